# Optimizing an MI355X kernel written in HIP

```python
import math
import jax, jax.numpy as jnp
from jax import lax
import numpy as np

D_MODEL = 4096
BATCH = 4
SEQ = 2048
DEPTH = 1

HEAD_DIM = 128
N_HEADS_A = D_MODEL // (2 * HEAD_DIM)
N_KV_A = N_HEADS_A // 4
GROUP_A = N_HEADS_A // N_KV_A
N_HEADS_B = D_MODEL // (2 * HEAD_DIM)
CMP_LEN = 32
CMP_STRIDE = 16
CMP_HIDDEN = 256
SEL_LEN = 64
TOP_N = 16
WIN = 512
DILATIONS = ((128, 1), (512, 4), (2048, 16))
BLK = 128
SEL_CHUNK = 32
ROPE_THETA = 10000.0
EPS = 1e-6
FORCE_BONUS = 1e4
NEG = -1e30
C_IN = (2 * N_HEADS_A * HEAD_DIM + 3 * N_HEADS_A + 6 * N_KV_A * HEAD_DIM
        + 4 * N_HEADS_B * HEAD_DIM)

kernel_name = "hymba_nsa_dilated_hybrid_block"


def rms_norm(x, w):
    xf = x.astype(jnp.float32)
    y = xf * lax.rsqrt(jnp.mean(xf * xf, axis=-1, keepdims=True) + EPS)
    return (y * w.astype(jnp.float32)).astype(x.dtype)


def rope(x, pos):
    half = x.shape[-1] // 2
    inv = ROPE_THETA ** (-jnp.arange(half, dtype=jnp.float32) / half)
    ang = pos.astype(jnp.float32)[:, None, :, None] * inv
    cos, sin = jnp.cos(ang), jnp.sin(ang)
    x1 = x[..., :half].astype(jnp.float32)
    x2 = x[..., half:].astype(jnp.float32)
    return jnp.concatenate([x1 * cos - x2 * sin, x2 * cos + x1 * sin], axis=-1).astype(x.dtype)


def to_heads(t, h):
    b, s, _ = t.shape
    return t.reshape(b, s, h, HEAD_DIM).transpose(0, 2, 1, 3)


def band_attention(q, k, v, max_dist):
    n, hk, g, L, dh = q.shape
    nb = -(-L // BLK)
    lp = nb * BLK
    npv = -(-max_dist // BLK)
    kb_len = (npv + 1) * BLK
    qb = jnp.pad(q, ((0, 0), (0, 0), (0, 0), (0, lp - L), (0, 0))).reshape(n, hk, g, nb, BLK, dh)
    pad_kv = ((0, 0), (0, 0), (npv * BLK, lp - L), (0, 0))
    kp = jnp.pad(k, pad_kv)
    vp = jnp.pad(v, pad_kv)

    def blocks(t):
        return jnp.concatenate(
            [t[:, :, o * BLK:(o + nb) * BLK].reshape(n, hk, nb, BLK, dh) for o in range(npv + 1)], axis=3)

    kb, vb = blocks(kp), blocks(vp)
    s = jnp.einsum('nhgiqd,nhikd->nhgiqk', qb, kb).astype(jnp.float32)
    blk_i = jnp.arange(nb)
    qpos = (blk_i[:, None] * BLK + jnp.arange(BLK)[None, :])[:, :, None]
    kpos = ((blk_i - npv)[:, None] * BLK + jnp.arange(kb_len)[None, :])[:, None, :]
    dist = qpos - kpos
    mask = (dist >= 0) & (dist <= max_dist) & (kpos >= 0)
    s = jnp.where(mask, s, NEG)
    m = jnp.max(s, axis=-1)
    p = jnp.exp(s - m[..., None])
    den = jnp.sum(p, axis=-1)
    num = jnp.einsum('nhgiqk,nhikd->nhgiqd', p, vb.astype(jnp.float32))
    num = num.reshape(n, hk, g, lp, dh)[:, :, :, :L]
    m = m.reshape(n, hk, g, lp)[..., :L]
    den = den.reshape(n, hk, g, lp)[..., :L]
    return num, m, den


def compress(k, pe, w1, w2):
    b, hk, s, dh = k.shape
    r = CMP_LEN // CMP_STRIDE
    nchunk = s // CMP_STRIDE
    kc = k.reshape(b, hk, nchunk, CMP_STRIDE, dh)
    n_c = nchunk - r + 1
    blk = jnp.concatenate([kc[:, :, o:o + n_c] for o in range(r)], axis=3) + pe
    flat = blk.reshape(b, hk, n_c, CMP_LEN * dh)
    return jax.nn.gelu(flat @ w1) @ w2


def nsa_mixer(q, k_cmp, v_cmp, k_slc, v_slc, k_win, v_win, gates, pos,
              pe_k, pe_v, wk1, wk2, wv1, wv2):
    b, _, s_len, dh = q.shape
    scale = dh ** -0.5
    t = jnp.arange(s_len)
    q_raw = q.reshape(b, N_KV_A, GROUP_A, s_len, dh) * scale
    q_rot = rope(q, pos).reshape(b, N_KV_A, GROUP_A, s_len, dh) * scale

    kc = compress(k_cmp, pe_k, wk1, wk2)
    vc = compress(v_cmp, pe_v, wv1, wv2)
    n_c = kc.shape[2]
    sc = jnp.einsum('bhgtd,bhcd->bhgtc', q_raw, kc).astype(jnp.float32)
    c_end = jnp.arange(n_c) * CMP_STRIDE + CMP_LEN - 1
    c_valid = c_end[None, :] <= t[:, None]
    p_cmp = jax.nn.softmax(jnp.where(c_valid, sc, NEG), axis=-1) * c_valid.any(-1)[:, None]
    o_cmp = jnp.einsum('bhgtc,bhcd->bhgtd', p_cmp, vc.astype(jnp.float32))

    n_sel = s_len // SEL_LEN
    k_top = min(TOP_N, n_sel)
    ci = jnp.arange(n_c) * CMP_STRIDE
    sj = jnp.arange(n_sel) * SEL_LEN
    overlap = ((ci[:, None] < sj[None, :] + SEL_LEN) & (ci[:, None] + CMP_LEN > sj[None, :])).astype(jnp.float32)
    imp = jnp.einsum('bhgtc,cj->bhtj', p_cmp, overlap)
    cur = t // SEL_LEN
    jj = jnp.arange(n_sel)[None, :]
    forced = (jj == 0) | (jj == cur[:, None]) | (jj == cur[:, None] - 1)
    imp = jnp.where(forced, imp + FORCE_BONUS, imp)
    imp = jnp.where(sj[None, :] <= t[:, None], imp, -jnp.inf)
    _, idx = lax.top_k(imp, k_top)

    ks = rope(k_slc, pos).reshape(b, N_KV_A, n_sel, SEL_LEN, dh)
    vs = v_slc.reshape(b, N_KV_A, n_sel, SEL_LEN, dh)
    bi = jnp.arange(b)[:, None, None, None]
    hi = jnp.arange(N_KV_A)[None, :, None, None]
    nch = s_len // SEL_CHUNK

    def sel_chunk(args):
        qc, ic, tc = args
        kg = ks[bi, hi, ic].reshape(b, N_KV_A, SEL_CHUNK, k_top * SEL_LEN, dh)
        vg = vs[bi, hi, ic].reshape(b, N_KV_A, SEL_CHUNK, k_top * SEL_LEN, dh)
        kpos = (ic[..., None] * SEL_LEN + jnp.arange(SEL_LEN)).reshape(b, N_KV_A, SEL_CHUNK, k_top * SEL_LEN)
        mask = kpos <= tc[None, None, :, None]
        sc_ = jnp.einsum('bhgcd,bhckd->bhgck', qc, kg).astype(jnp.float32)
        p = jax.nn.softmax(jnp.where(mask[:, :, None], sc_, NEG), axis=-1)
        return jnp.einsum('bhgck,bhckd->bhgcd', p, vg.astype(jnp.float32))

    q_chunks = q_rot.reshape(b, N_KV_A, GROUP_A, nch, SEL_CHUNK, dh).transpose(3, 0, 1, 2, 4, 5)
    i_chunks = idx.reshape(b, N_KV_A, nch, SEL_CHUNK, k_top).transpose(2, 0, 1, 3, 4)
    t_chunks = t.reshape(nch, SEL_CHUNK)
    o_slc = lax.map(sel_chunk, (q_chunks, i_chunks, t_chunks))
    o_slc = o_slc.transpose(1, 2, 3, 0, 4, 5).reshape(b, N_KV_A, GROUP_A, s_len, dh)

    num, _, den = band_attention(q_rot, rope(k_win, pos), v_win, WIN - 1)
    o_win = num / den[..., None]

    o = gates[..., 0:1] * o_cmp + gates[..., 1:2] * o_slc + gates[..., 2:3] * o_win
    return o.reshape(b, N_HEADS_A, s_len, dh)


def dilated_mixer(q, k, v, pos):
    b, h, s_len, dh = q.shape
    q = rope(q, pos) * (dh ** -0.5)
    k = rope(k, pos)
    nums, ms, dens = [], [], []
    for window, d in DILATIONS:
        L = s_len // d

        def to_sub(t):
            return t.reshape(b, h, L, d, dh).transpose(0, 3, 1, 2, 4).reshape(b * d, h, L, dh)

        num, m, den = band_attention(to_sub(q)[:, :, None], to_sub(k), to_sub(v), window // d)
        nums.append(num.reshape(b, d, h, L, dh).transpose(0, 2, 3, 1, 4).reshape(b, h, s_len, dh))
        ms.append(m.reshape(b, d, h, L).transpose(0, 2, 3, 1).reshape(b, h, s_len))
        dens.append(den.reshape(b, d, h, L).transpose(0, 2, 3, 1).reshape(b, h, s_len))
    ms = jnp.stack(ms)
    w = jnp.exp(ms - jnp.max(ms, axis=0, keepdims=True))
    numer = jnp.sum(w[..., None] * jnp.stack(nums), axis=0)
    denom = jnp.sum(w * jnp.stack(dens), axis=0)
    return numer / denom[..., None]


def setup_inputs(seed: int = 0) -> dict:
    key = jax.random.key(seed)
    ks = jax.random.split(key, 14)
    f32 = jnp.float32
    x = jax.random.normal(ks[0], (BATCH, SEQ, D_MODEL), f32)
    offset = jax.random.randint(ks[1], (BATCH, 1), 0, 1024, dtype=jnp.int32)
    positions = (offset + jnp.arange(SEQ, dtype=jnp.int32)[None, :]).astype(jnp.int32)
    pre_norm_w = 1.0 + 0.05 * jax.random.normal(ks[2], (DEPTH, D_MODEL), f32)
    post_norm_w = 1.0 + 0.05 * jax.random.normal(ks[3], (DEPTH, D_MODEL), f32)
    w_in = jax.random.normal(ks[4], (DEPTH, D_MODEL, C_IN), f32) * D_MODEL ** -0.5
    b_gate = 0.01 * jax.random.normal(ks[5], (DEPTH, 3 * N_HEADS_A), f32)
    cmp_pe_k = 0.1 * jax.random.normal(ks[6], (DEPTH, CMP_LEN, HEAD_DIM), f32)
    cmp_pe_v = 0.1 * jax.random.normal(ks[7], (DEPTH, CMP_LEN, HEAD_DIM), f32)
    cmp_wk1 = jax.random.normal(ks[8], (DEPTH, CMP_LEN * HEAD_DIM, CMP_HIDDEN), f32) * (CMP_LEN * HEAD_DIM) ** -0.5
    cmp_wk2 = jax.random.normal(ks[9], (DEPTH, CMP_HIDDEN, HEAD_DIM), f32) * CMP_HIDDEN ** -0.5
    cmp_wv1 = jax.random.normal(ks[10], (DEPTH, CMP_LEN * HEAD_DIM, CMP_HIDDEN), f32) * (CMP_LEN * HEAD_DIM) ** -0.5
    cmp_wv2 = jax.random.normal(ks[11], (DEPTH, CMP_HIDDEN, HEAD_DIM), f32) * CMP_HIDDEN ** -0.5
    mix_width = (N_HEADS_A + N_HEADS_B) * HEAD_DIM
    w_out = jax.random.normal(ks[12], (DEPTH, mix_width, D_MODEL), f32) * mix_width ** -0.5
    return {"x": x, "positions": positions, "pre_norm_w": pre_norm_w, "post_norm_w": post_norm_w,
            "w_in": w_in, "b_gate": b_gate, "cmp_pe_k": cmp_pe_k, "cmp_pe_v": cmp_pe_v,
            "cmp_wk1": cmp_wk1, "cmp_wk2": cmp_wk2, "cmp_wv1": cmp_wv1, "cmp_wv2": cmp_wv2,
            "w_out": w_out}


def reference(x, positions, pre_norm_w, post_norm_w, w_in, b_gate, cmp_pe_k, cmp_pe_v,
              cmp_wk1, cmp_wk2, cmp_wv1, cmp_wv2, w_out):
    b, s_len, _ = x.shape
    wa = N_HEADS_A * HEAD_DIM
    wkv = N_KV_A * HEAD_DIM
    wb = N_HEADS_B * HEAD_DIM
    sizes = [wa, wa, 3 * N_HEADS_A, wkv, wkv, wkv, wkv, wkv, wkv, wb, wb, wb, wb]
    splits = [int(v) for v in np.cumsum(sizes)[:-1]]
    for l in range(DEPTH):
        h = rms_norm(x, pre_norm_w[l])
        proj = h @ w_in[l]
        qa, za, ga, kc, vc, ksl, vsl, kw, vw, qb, kb, vb, zb = jnp.split(proj, splits, axis=-1)
        gates = jax.nn.sigmoid((ga + b_gate[l]).astype(jnp.float32))
        gates = gates.reshape(b, s_len, N_HEADS_A, 3).transpose(0, 2, 1, 3).reshape(b, N_KV_A, GROUP_A, s_len, 3)
        oa = nsa_mixer(to_heads(qa, N_HEADS_A), to_heads(kc, N_KV_A), to_heads(vc, N_KV_A),
                       to_heads(ksl, N_KV_A), to_heads(vsl, N_KV_A), to_heads(kw, N_KV_A),
                       to_heads(vw, N_KV_A), gates, positions,
                       cmp_pe_k[l], cmp_pe_v[l], cmp_wk1[l], cmp_wk2[l], cmp_wv1[l], cmp_wv2[l])
        ob = dilated_mixer(to_heads(qb, N_HEADS_B), to_heads(kb, N_HEADS_B), to_heads(vb, N_HEADS_B), positions)
        oa = oa.transpose(0, 2, 1, 3).reshape(b, s_len, wa)
        ob = ob.transpose(0, 2, 1, 3).reshape(b, s_len, wb)
        mix = jnp.concatenate([oa * jax.nn.silu(za.astype(jnp.float32)),
                               ob * jax.nn.silu(zb.astype(jnp.float32))], axis=-1).astype(x.dtype)
        x = x + rms_norm(mix @ w_out[l], post_norm_w[l])
    return x
```

```cpp
#include <hip/hip_runtime.h>
#include <cstdio>
#include <cstdint>
namespace pg8 {
#define PG8_LAS __attribute__((address_space(3)))
typedef unsigned short bf16_t;
typedef short bf16x8 __attribute__((ext_vector_type(8)));
typedef float f32x4 __attribute__((ext_vector_type(4)));
typedef unsigned u32x4 __attribute__((ext_vector_type(4)));
constexpr int BM = 256, BK = 64, HALF = 128, HTB = HALF * BK * 2  , STAGE_BYTES = 8 * HTB, NXCD = 8, WGM = 8;

__host__ __device__ __forceinline__ int lds_byte(int r, int c) { const int st = (r >> 4) * 2 + (c >> 5), rr = r & 15, cc = c & 31, ob = rr * 64 + cc * 2; return st * 1024 + (ob ^ (((ob >> 9) & 1) << 5)); }
__host__ __device__ __forceinline__ void stage_rc(int b, int& R, int& C) { const int st = b / 1024, sb = b % 1024, swz = sb ^ (((sb >> 9) & 1) << 5); R = (st >> 1) * 16 + swz / 64; C = (st & 1) * 32 + (swz % 64) / 2; }
__host__ __device__ __forceinline__ int perm32(int rho) { const int n = rho >> 4, i = rho & 15; return 8 * (i >> 2) + 4 * n + (i & 3); }

struct Unit { int pm, pn; };
struct Gemm { const bf16_t* A; const bf16_t* Bt; int M, N, K; };

struct StaticOrder {
    int nM, nN, nwg, G, c;
    __host__ __device__ void init(int M, int N, int G_, int c_) { nM = M / BM; nN = N / BM; nwg = nM * nN; G = G_; c = c_; }
    __host__ __device__ bool next(int i, Unit& u) const {
        const long L = (long)i * G + c; if (L >= nwg) return false;
        int wgid = (int)L; { const int q = nwg / NXCD, r = nwg % NXCD, xcd = wgid % NXCD, off = wgid / NXCD; wgid = (xcd < r ? xcd * (q + 1) : r * (q + 1) + (xcd - r) * q) + off; }
        const int nig = WGM * nN, gid = wgid / nig, fm = gid * WGM, gsz = (nM - fm) < WGM ? (nM - fm) : WGM;
        u.pm = fm + ((wgid % nig) % gsz); u.pn = (wgid % nig) / gsz; return true;
    }
    __device__ __forceinline__ void a_ready(const Unit&) const {}
    __device__ __forceinline__ void done(const Unit&) const {}
};

__device__ __forceinline__ unsigned cvt_pk_bf16(float lo, float hi) { unsigned r; asm volatile("v_cvt_pk_bf16_f32 %0, %1, %2" : "=v"(r) : "v"(lo), "v"(hi)); return r; }
typedef float f32x2 __attribute__((ext_vector_type(2)));
__device__ __forceinline__ f32x2 gelu_pk(f32x2 v) {
    const f32x2 av = __builtin_elementwise_abs(v), d = av * 0.2316418882f + 1.0f;
    f32x2 t; t.x = __builtin_amdgcn_rcpf(d.x); t.y = __builtin_amdgcn_rcpf(d.y);
    f32x2 q = t * 0.5307027145f + (-0.7265760135f); q = q * t + 0.7107068705f; q = q * t + (-0.142248368f); q = q * t + 0.127414796f; q = q * t;
    const f32x2 s = (v * v) * (-0.72134752044f);
    f32x2 e; e.x = __builtin_amdgcn_exp2f(s.x); e.y = __builtin_amdgcn_exp2f(s.y);
    const f32x2 m = v * (q * e), r = v - m;
    f32x2 o; o.x = v.x < 0.f ? m.x : r.x; o.y = v.y < 0.f ? m.y : r.y; return o;
}

template <int ACT  > struct EpiBf16 {
    static constexpr bool PERM = true, AFTER_DRAIN = false; static_assert(ACT == 0 || ACT == 1, "EpiBf16: ACT is 0 (none) or 1 (gelu_pk)");
    bf16_t* O; int ldc; const float* bias; int split_cols; size_t split_stride; float scale0;
    __device__ __forceinline__ void operator()(const f32x4 (&acc)[2][2][4][2], const Unit& u, int wr, int wc, int fr, int fq) const {
        const int row0 = u.pm * BM + wr * 64 + fr; int colt = u.pn * BM; bf16_t* base = O;
        float sc = 1.f; if (split_cols) { const int t = colt / split_cols; base += (size_t)t * split_stride; colt -= t * split_cols; if (t == 0) sc = scale0; }
        const int col0 = colt + wc * 32 + 8 * fq, bcol0 = u.pn * BM + wc * 32 + 8 * fq;
        f32x4 bv[2][2];
#pragma unroll
        for (int bj = 0; bj < 2; ++bj)
#pragma unroll
            for (int n = 0; n < 2; ++n) bv[bj][n] = bias ? *(const f32x4*)(bias + bcol0 + bj * HALF + 4 * n) : (f32x4){0.f, 0.f, 0.f, 0.f};
#pragma unroll
        for (int ai = 0; ai < 2; ++ai)
#pragma unroll
            for (int m = 0; m < 4; ++m) { bf16_t* rowp = base + (size_t)(row0 + ai * HALF + m * 16) * ldc + col0;
#pragma unroll
                for (int bj = 0; bj < 2; ++bj) { f32x4 v0 = acc[ai][bj][m][0] + bv[bj][0], v1 = acc[ai][bj][m][1] + bv[bj][1];
                    if (ACT == 1) { f32x2 a = gelu_pk((f32x2){v0[0], v0[1]}), b = gelu_pk((f32x2){v0[2], v0[3]}), c = gelu_pk((f32x2){v1[0], v1[1]}), d = gelu_pk((f32x2){v1[2], v1[3]});
                        v0 = (f32x4){a.x, a.y, b.x, b.y}; v1 = (f32x4){c.x, c.y, d.x, d.y}; }
                    v0 = v0 * sc; v1 = v1 * sc; u32x4 w; w.x = cvt_pk_bf16(v0[0], v0[1]); w.y = cvt_pk_bf16(v0[2], v0[3]); w.z = cvt_pk_bf16(v1[0], v1[1]); w.w = cvt_pk_bf16(v1[2], v1[3]);
                    *(u32x4*)(rowp + bj * HALF) = w; } }
    }
};
struct EpiF32 {
    static constexpr bool PERM = false, AFTER_DRAIN = false;
    float* O; int ldc;
    __device__ __forceinline__ void operator()(const f32x4 (&acc)[2][2][4][2], const Unit& u, int wr, int wc, int fr, int fq) const {
        const int row0 = u.pm * BM + wr * 64 + fr, col0 = u.pn * BM + wc * 32 + 4 * fq;
#pragma unroll
        for (int ai = 0; ai < 2; ++ai)
#pragma unroll
            for (int m = 0; m < 4; ++m) { float* rowp = O + (size_t)(row0 + ai * HALF + m * 16) * ldc + col0;
#pragma unroll
                for (int bj = 0; bj < 2; ++bj)
#pragma unroll
                    for (int n = 0; n < 2; ++n) *(f32x4*)(rowp + bj * HALF + n * 16) = acc[ai][bj][m][n]; }
    }
};

template <class Epi, class Sched, bool ALIGN_EPI = false, bool SP2 = false>
__device__ __forceinline__ void gemm_phase(PG8_LAS unsigned char* lds, const Gemm g, const Sched& S, const Epi& E) {
    const int tid = threadIdx.x, wid = __builtin_amdgcn_readfirstlane(tid >> 6), lane = tid & 63, wr = wid >> 2, wc = wid & 3, fr = lane & 15, fq = lane >> 4;
    const int K = g.K, nt = K / BK;
    unsigned voffA[2], voffB[2];
#pragma unroll
    for (int i = 0; i < 2; ++i) { int R, C; stage_rc(tid * 16 + i * 8192, R, C); const int Rb = Epi::PERM ? ((R & ~31) + perm32(R & 31)) : R;
        voffA[i] = (unsigned)(R * K + C) * 2u; voffB[i] = (unsigned)(Rb * K + C) * 2u; }
    const size_t kstep = (size_t)(BK * 2);
    const size_t hstep = (size_t)HALF * K * 2;
    const size_t tstep = 2 * hstep;
    const unsigned ldsw = (unsigned)wid * 1024u;
    const int aoff = lds_byte(wr * 64 + fr, fq * 8), boff = lds_byte(wc * 32 + fr, fq * 8);
#define PG8_SA(b, h) (((b) * 2 + (h)) * HTB)
#define PG8_SB(b, h) ((4 + (b) * 2 + (h)) * HTB)
#define PG8_STAGE(bufoff, gbase, voff) do { _Pragma("unroll") for (int _i = 0; _i < 2; ++_i) \
        __builtin_amdgcn_global_load_lds((const unsigned*)((const char*)(gbase) + (voff)[_i]), (PG8_LAS unsigned*)(lds + (bufoff) + ldsw + _i * 8192), 16, 0, 0); } while (0)
#define PG8_LDA(dst, b, h) do { _Pragma("unroll") for (int m = 0; m < 4; ++m) _Pragma("unroll") for (int k = 0; k < 2; ++k) dst[m][k] = *(const PG8_LAS bf16x8*)(lds + PG8_SA(b, h) + aoff + m * 2048 + k * 1024); } while (0)
#define PG8_LDB(dst, b, h) do { _Pragma("unroll") for (int n = 0; n < 2; ++n) _Pragma("unroll") for (int k = 0; k < 2; ++k) dst[n][k] = *(const PG8_LAS bf16x8*)(lds + PG8_SB(b, h) + boff + n * 2048 + k * 1024); } while (0)
#define PG8_MMA(ai, bj, At, Bt) do { __builtin_amdgcn_s_setprio(1); _Pragma("unroll") for (int m = 0; m < 4; ++m) _Pragma("unroll") for (int n = 0; n < 2; ++n) _Pragma("unroll") for (int k = 0; k < 2; ++k) \
        acc[ai][bj][m][n] = __builtin_amdgcn_mfma_f32_16x16x32_bf16(Bt[n][k], At[m][k], acc[ai][bj][m][n], 0, 0, 0); __builtin_amdgcn_s_setprio(0); } while (0)
#define PG8_WAIT_V(n) asm volatile("s_waitcnt vmcnt(" #n ")" ::: "memory")
#define PG8_WAIT_L(n) asm volatile("s_waitcnt lgkmcnt(" #n ")" ::: "memory")
#define PG8_BAR __builtin_amdgcn_s_barrier()
#define PG8_SCHED __builtin_amdgcn_sched_barrier(0)
    Unit cur, nxt; int ui = 0;
    if (!S.next(0, cur)) return;
    f32x4 acc[2][2][4][2];
#pragma unroll
    for (int a = 0; a < 2; ++a)
#pragma unroll
        for (int b = 0; b < 2; ++b)
#pragma unroll
            for (int m = 0; m < 4; ++m)
#pragma unroll
                for (int n = 0; n < 2; ++n) acc[a][b][m][n] = (f32x4){0.f, 0.f, 0.f, 0.f};
    bf16x8 At[4][2], B0[2][2], B1[2][2];
    const char* cA = (const char*)g.A + (size_t)cur.pm * tstep; const char* cB = (const char*)g.Bt + (size_t)cur.pn * tstep;
    S.a_ready(cur);
    if constexpr (SP2) {
        PG8_STAGE(PG8_SB(0, 0), cB, voffB); PG8_STAGE(PG8_SB(0, 1), cB + hstep, voffB); PG8_STAGE(PG8_SA(0, 0), cA, voffA); PG8_STAGE(PG8_SA(0, 1), cA + hstep, voffA);
        if (wr == 1) PG8_BAR;
        PG8_WAIT_V(2); PG8_BAR;
        PG8_STAGE(PG8_SB(1, 0), cB + kstep, voffB); PG8_STAGE(PG8_SA(1, 0), cA + kstep, voffA); PG8_STAGE(PG8_SB(1, 1), cB + hstep + kstep, voffB);
        PG8_WAIT_V(6); PG8_BAR;
    } else {
        PG8_STAGE(PG8_SB(0, 0), cB, voffB); PG8_STAGE(PG8_SA(0, 0), cA, voffA); PG8_STAGE(PG8_SB(0, 1), cB + hstep, voffB); PG8_STAGE(PG8_SA(0, 1), cA + hstep, voffA);
        if (wr == 1) PG8_BAR;
        PG8_WAIT_V(4); PG8_BAR;
        PG8_STAGE(PG8_SB(1, 0), cB + kstep, voffB); PG8_STAGE(PG8_SA(1, 0), cA + kstep, voffA); PG8_STAGE(PG8_SB(1, 1), cB + hstep + kstep, voffB);
        PG8_WAIT_V(6); PG8_BAR;
    }
    for (;;) {
        const bool has_next = S.next(ui + 1, nxt);
        const char* nA = has_next ? (const char*)g.A + (size_t)nxt.pm * tstep : cA; const char* nB = has_next ? (const char*)g.Bt + (size_t)nxt.pn * tstep : cB;
        for (int t = 0; t < nt; t += 2) {
            const bool last = (t == nt - 2);
            const char* a1 = cA + (size_t)(t + 1) * kstep;
            const char* a2 = last ? nA : cA + (size_t)(t + 2) * kstep; const char* b2 = last ? nB : cB + (size_t)(t + 2) * kstep;
            const char* a3 = a2 + kstep; const char* b3 = b2 + kstep;
            if (last && has_next) S.a_ready(nxt);
            if constexpr (SP2) {
            PG8_LDB(B0, 0, 0); PG8_LDB(B1, 0, 1); PG8_SCHED; PG8_LDA(At, 0, 0); PG8_STAGE(PG8_SA(1, 1), a1 + hstep, voffA);
            PG8_WAIT_V(8); PG8_WAIT_L(0); PG8_BAR; PG8_MMA(0, 0, At, B0); PG8_MMA(0, 1, At, B1); PG8_BAR; PG8_SCHED;
            PG8_LDA(At, 0, 1); PG8_STAGE(PG8_SB(0, 0), b2, voffB); PG8_STAGE(PG8_SB(0, 1), b2 + hstep, voffB); PG8_STAGE(PG8_SA(0, 0), a2, voffA);
            PG8_WAIT_V(8); PG8_WAIT_L(0); PG8_BAR; PG8_MMA(1, 0, At, B0); PG8_MMA(1, 1, At, B1); PG8_BAR; PG8_SCHED;
            PG8_LDB(B0, 1, 0); PG8_LDB(B1, 1, 1); PG8_SCHED; PG8_LDA(At, 1, 0); PG8_STAGE(PG8_SA(0, 1), a2 + hstep, voffA);
            PG8_WAIT_V(8); PG8_WAIT_L(0); PG8_BAR; PG8_MMA(0, 0, At, B0); PG8_MMA(0, 1, At, B1); PG8_BAR; PG8_SCHED;
            PG8_LDA(At, 1, 1); PG8_STAGE(PG8_SB(1, 0), b3, voffB); PG8_STAGE(PG8_SB(1, 1), b3 + hstep, voffB); PG8_STAGE(PG8_SA(1, 0), a3, voffA);
            PG8_WAIT_V(8); PG8_WAIT_L(0); PG8_BAR; PG8_MMA(1, 0, At, B0); PG8_MMA(1, 1, At, B1); PG8_BAR; PG8_SCHED;
            } else {
            PG8_LDB(B0, 0, 0); PG8_SCHED; PG8_LDA(At, 0, 0); PG8_STAGE(PG8_SA(1, 1), a1 + hstep, voffA);
            PG8_WAIT_L(8); PG8_BAR; PG8_WAIT_L(0); PG8_MMA(0, 0, At, B0); PG8_BAR; PG8_SCHED;
            PG8_LDB(B1, 0, 1); PG8_STAGE(PG8_SB(0, 0), b2, voffB);
            PG8_BAR; PG8_WAIT_L(0); PG8_MMA(0, 1, At, B1); PG8_BAR;
            PG8_LDA(At, 0, 1); PG8_STAGE(PG8_SA(0, 0), a2, voffA);
            PG8_BAR; PG8_WAIT_L(0); PG8_MMA(1, 0, At, B0); PG8_BAR; PG8_SCHED;
            PG8_STAGE(PG8_SB(0, 1), b2 + hstep, voffB);
            PG8_WAIT_V(6); PG8_BAR; PG8_MMA(1, 1, At, B1); PG8_BAR;
            PG8_LDB(B0, 1, 0); PG8_SCHED; PG8_LDA(At, 1, 0); PG8_STAGE(PG8_SA(0, 1), a2 + hstep, voffA);
            PG8_WAIT_L(8); PG8_BAR; PG8_WAIT_L(0); PG8_MMA(0, 0, At, B0); PG8_BAR; PG8_SCHED;
            PG8_LDB(B1, 1, 1); PG8_STAGE(PG8_SB(1, 0), b3, voffB);
            PG8_BAR; PG8_WAIT_L(0); PG8_MMA(0, 1, At, B1); PG8_BAR;
            PG8_LDA(At, 1, 1); PG8_STAGE(PG8_SA(1, 0), a3, voffA);
            PG8_BAR; PG8_WAIT_L(0); PG8_MMA(1, 0, At, B0); PG8_BAR; PG8_SCHED;
            PG8_STAGE(PG8_SB(1, 1), b3 + hstep, voffB);
            PG8_WAIT_V(6); PG8_BAR; PG8_MMA(1, 1, At, B1); PG8_BAR;
            }
        }
        if constexpr (ALIGN_EPI) { if (wr == 0) PG8_BAR; }
        if constexpr (!Epi::AFTER_DRAIN) { E(acc, cur, wr, wc, fr, fq); S.done(cur); }
        if (!has_next) break;
#pragma unroll
        for (int a = 0; a < 2; ++a)
#pragma unroll
            for (int b = 0; b < 2; ++b)
#pragma unroll
                for (int m = 0; m < 4; ++m)
#pragma unroll
                    for (int n = 0; n < 2; ++n) acc[a][b][m][n] = (f32x4){0.f, 0.f, 0.f, 0.f};
        cur = nxt; cA = nA; cB = nB; ++ui;
        if constexpr (ALIGN_EPI) { if (wr == 1) PG8_BAR; }
    }
    PG8_WAIT_V(0);
    if constexpr (!ALIGN_EPI) { if (wr == 0) PG8_BAR; }
    PG8_BAR;
    if constexpr (Epi::AFTER_DRAIN) { E.fused(acc, cur, wr, wc, fr, fq, lds, wid, lane); S.done(cur); }
#undef PG8_SA
#undef PG8_SB
#undef PG8_STAGE
#undef PG8_LDA
#undef PG8_LDB
#undef PG8_MMA
#undef PG8_WAIT_V
#undef PG8_WAIT_L
#undef PG8_BAR
#undef PG8_SCHED
}
}
#define GAS __attribute__((address_space(1)))
#define LAS __attribute__((address_space(3)))
typedef unsigned short bf16;
typedef unsigned v4u __attribute__((ext_vector_type(4)));
typedef float f32x4 __attribute__((ext_vector_type(4)));
typedef short bf16x8 __attribute__((ext_vector_type(8)));
typedef GAS unsigned gu32;
typedef GAS unsigned long long gu64;
#define RLX_AGENT __ATOMIC_RELAXED, __HIP_MEMORY_SCOPE_AGENT
#define LDS_WAIT() asm volatile("s_waitcnt lgkmcnt(0)" ::: "memory")
#define VM_WAIT() asm volatile("s_waitcnt vmcnt(0)" ::: "memory")
__device__ __forceinline__ unsigned long long rt() { return __builtin_amdgcn_s_memrealtime(); }
__device__ __forceinline__ unsigned f2bf(float f) { unsigned u = __builtin_bit_cast(unsigned, f); return (u + 0x7fffu + ((u >> 16) & 1u)) >> 16; }
__device__ __forceinline__ unsigned pk2(float lo, float hi) { return f2bf(lo) | (f2bf(hi) << 16); }

#define XB_TMO      128
#define XB_XCNT(j)  (256  + 64 * (j))
#define XB_XSUB(j)  (1280 + 64 * (j))
#define XB_XGEN(j)  (2304 + 64 * (j))
#define XB_TOP      3328
#define XB_TOPGEN   3392
#define XCD_BAR_WORDS 3456
#define XB_SPIN_CAP (1u << 24)

__device__ __forceinline__ unsigned xb_ld(unsigned* p)              { return __hip_atomic_load(p, __ATOMIC_RELAXED, __HIP_MEMORY_SCOPE_AGENT); }
__device__ __forceinline__ unsigned xb_add(unsigned* p, unsigned v) { return __hip_atomic_fetch_add(p, v, __ATOMIC_RELAXED, __HIP_MEMORY_SCOPE_AGENT); }
__device__ __forceinline__ unsigned xb_xcc_id() { return (unsigned)__builtin_amdgcn_s_getreg((3 << 11) | 20) & 0xFu; }
#define XB_SPIN(cond, bar) do { unsigned _sp = 0; while (cond) { __builtin_amdgcn_s_sleep(1); \
    if ((++_sp & 255u) == 0u) { if (xb_ld(&(bar)[XB_TMO])) break; if (_sp > XB_SPIN_CAP) { atomicAdd(&(bar)[XB_TMO], 1u); break; } } } } while (0)

struct XcdBarrier {
    unsigned* bar; unsigned x;
    volatile LAS unsigned* st;
};

__device__ __forceinline__ XcdBarrier xcd_barrier_post(unsigned* bar, volatile LAS unsigned* st) {
    XcdBarrier b; b.bar = bar; b.x = xb_xcc_id(); b.st = st;
    if (threadIdx.x == 0) (void)xb_add(&bar[XB_XCNT(b.x)], 1u);
    return b;
}
__device__ __forceinline__ void xcd_barrier_complete(unsigned* bar, unsigned x, unsigned& nloc, unsigned& nx) {
    const unsigned G = gridDim.x * gridDim.y * gridDim.z;
    unsigned sum, cnt, mine, sp = 0u;
    for (;;) {
        sum = 0u; cnt = 0u; mine = 0u;
#pragma unroll
        for (unsigned j = 0; j < 16; ++j) { const unsigned c = xb_ld(&bar[XB_XCNT(j)]); sum += c; cnt += (c > 0u) ? 1u : 0u; mine = (j == x) ? c : mine; }
        if (sum == G) break;
        __builtin_amdgcn_s_sleep(1);
        if ((++sp & 255u) == 0u) { if (xb_ld(&bar[XB_TMO])) break; if (sp > XB_SPIN_CAP) { atomicAdd(&bar[XB_TMO], 1u); break; } }
    }
    nloc = mine > 0u ? mine : 1u; nx = cnt > 0u ? cnt : 1u;
}

__device__ __forceinline__ void xcd_barrier(const XcdBarrier& b) {
    asm volatile("s_waitcnt vmcnt(0)" ::: "memory");
    __syncthreads();
    if (threadIdx.x == 0) {
        unsigned* bar = b.bar;
        __builtin_amdgcn_s_waitcnt(0);
        unsigned nloc = b.st[0], nx = b.st[1];
        if (nloc == 0u) { xcd_barrier_complete(bar, b.x, nloc, nx); b.st[0] = nloc; b.st[1] = nx; }
        const unsigned old = xb_add(&bar[XB_XSUB(b.x)], 1u);
        const unsigned gen = old / nloc;
        if (old + 1u == (gen + 1u) * nloc) {
            __builtin_amdgcn_fence(__ATOMIC_RELEASE, "agent");
            asm volatile("s_waitcnt vmcnt(0)" ::: "memory");
            const unsigned og = xb_add(&bar[XB_TOP], 1u);
            const unsigned tg = og / nx;
            if (og + 1u == (tg + 1u) * nx) xb_add(&bar[XB_TOPGEN], 1u);
            else XB_SPIN(xb_ld(&bar[XB_TOPGEN]) == tg, bar);
            __builtin_amdgcn_fence(__ATOMIC_ACQUIRE, "agent");
            xb_add(&bar[XB_XGEN(b.x)], 1u);
            asm volatile("s_waitcnt vmcnt(0)" ::: "memory");
        } else {
            XB_SPIN(xb_ld(&bar[XB_XGEN(b.x)]) == gen, bar);
            __builtin_amdgcn_fence(__ATOMIC_ACQUIRE, "agent");
            asm volatile("s_waitcnt vmcnt(0)" ::: "memory");
        }
    }
    __syncthreads();
}

constexpr int NWAVES = 8;
constexpr int BATCH = 4, SEQ = 2048, DM = 4096, M = BATCH * SEQ;
constexpr int HD = 128, NHA = 16, NKV = 4, GRP = 4, NHB = 16;
constexpr int CIN = 15408, NP = 15616;
constexpr int LDP = NP;
constexpr int C_QA = 0, C_ZA = 2048, C_KC = 4096, C_VC = 4608, C_KSL = 5120, C_VSL = 5632, C_KW = 6144, C_VW = 6656,
              C_QB = 7168, C_KB = 9216, C_VB = 11264, C_ZB = 13312, C_GA = 15360;
constexpr int NCMP = 127, NSEL = 32, TOPN = 16;
constexpr float EPS = 1e-6f;
constexpr float QSCALE = 0.08838834764831845f;

constexpr size_t MiB = 1u << 20;
constexpr size_t WS_CTL = 0, CTL_ZERO_BYTES = 1 * MiB;
constexpr size_t WS_WIN = 2 * MiB;
constexpr size_t WS_WOUT = 124 * MiB;
constexpr size_t WS_HB = 160 * MiB;
constexpr size_t WS_P = 224 * MiB;
constexpr size_t WS_QR = 468 * MiB;
constexpr size_t WS_COS = 500 * MiB;
constexpr size_t WS_SIN = 502 * MiB;
constexpr size_t WS_MIX = 504 * MiB;
constexpr size_t WS_Y = 568 * MiB;
constexpr size_t WS_KCMP = 696 * MiB;
constexpr size_t WS_VCMP = 697 * MiB;
constexpr size_t WS_BIAS1 = 698 * MiB;
constexpr size_t WS_SEL = 699 * MiB;
constexpr size_t WS_OC = 704 * MiB;
constexpr size_t WS_END = 768 * MiB;
constexpr int CW_BAR = 4096;

constexpr int RING_OFF = 0, RING_BYTES = 131072;
constexpr int LDSCTL_OFF = RING_BYTES, MISC_OFF = LDSCTL_OFF + 320;
constexpr int LDS_BYTES = 147456;

__device__ __forceinline__ float bf2f(unsigned short u) { return __builtin_bit_cast(float, (unsigned)u << 16); }
__device__ __forceinline__ float wave_sum(float v) {
#pragma unroll
    for (int o = 1; o < 64; o <<= 1) v += __shfl_xor(v, o);
    return v;
}
__device__ __forceinline__ float wave_max(float v) {
#pragma unroll
    for (int o = 1; o < 64; o <<= 1) v = fmaxf(v, __shfl_xor(v, o));
    return v;
}

struct Args {
    const float* x; const int* pos; const float* pre_w; const float* post_w; const float* w_in; const float* b_gate;
    const float* pe_k; const float* pe_v; const float* wk1; const float* wk2; const float* wv1; const float* wv2; const float* w_out;
    float* out; unsigned char* ws; int ph_lo, ph_hi;
};

struct Ctx {
    LAS unsigned char* lds; int tid, lane, wave, G, bid, gw, NGW;
};

__device__ __forceinline__ void transpose_item(const float* W, int ldw, int K, int k0, int c0, int ncols, bf16* WT, int r0, LAS float* scr, int lane) {
#pragma unroll 8
    for (int i = 0; i < 32; ++i) { const int kk = 2 * i + (lane >> 5), n = lane & 31; scr[kk * 33 + n] = (n < ncols) ? W[(size_t)(k0 + kk) * ldw + c0 + n] : 0.f; }
    LDS_WAIT(); asm volatile("" ::: "memory");
    const int c = lane & 7;
#pragma unroll
    for (int j = 0; j < 4; ++j) { const int n = (lane >> 3) + 8 * j; const LAS float* s = scr + (8 * c) * 33 + n;
        v4u o; o.x = pk2(s[0 * 33], s[1 * 33]); o.y = pk2(s[2 * 33], s[3 * 33]); o.z = pk2(s[4 * 33], s[5 * 33]); o.w = pk2(s[6 * 33], s[7 * 33]);
        if (n < ncols) *(GAS v4u*)(WT + (size_t)(r0 + n) * K + k0 + 8 * c) = o; }
    LDS_WAIT(); asm volatile("" ::: "memory");
}

__device__ __forceinline__ void p0_prologue(const Args& a, const Ctx& c) {
    unsigned char* ws = a.ws;
    bf16* WinT = (bf16*)(ws + WS_WIN); bf16* WoutT = (bf16*)(ws + WS_WOUT); bf16* HB = (bf16*)(ws + WS_HB);
    LAS float* scr = (LAS float*)(c.lds + RING_OFF + c.wave * 16384);
    constexpr int NB_IN = 482, I_IN = 64 * NB_IN, I_OUT = 64 * 128;
    for (int it = c.gw; it < I_IN + I_OUT; it += c.NGW) {
        if (it < I_IN) {
            const int kb = it / NB_IN, nb = it % NB_IN; int c0, r0, nc = 32;
            if (nb < 128) { c0 = nb * 32; r0 = nb * 32; }
            else if (nb < 224) { c0 = 4144 + (nb - 128) * 32; r0 = 4096 + (nb - 128) * 32; }
            else if (nb < 480) { c0 = 7216 + (nb - 224) * 32; r0 = 7168 + (nb - 224) * 32; }
            else { c0 = 4096 + (nb - 480) * 32; r0 = C_GA + (nb - 480) * 32; nc = (nb == 480) ? 32 : 16; }
            transpose_item(a.w_in, CIN, DM, kb * 64, c0, nc, WinT, r0, scr, c.lane);
        } else {
            const int r = it - I_IN, kb = r / 128, nb = r % 128;
            transpose_item(a.w_out, DM, DM, kb * 64, nb * 32, 32, WoutT, nb * 32, scr, c.lane);
        }
    }
    for (int e = c.gw * 64 + c.lane; e < (NP - CIN) * (DM / 8); e += c.NGW * 64)
        *(GAS v4u*)(WinT + (size_t)CIN * DM + (size_t)e * 8) = (v4u){0u, 0u, 0u, 0u};
    for (int m = c.gw; m < M; m += c.NGW) {
        const GAS f32x4* xr = (const GAS f32x4*)(a.x + (size_t)m * DM) + c.lane;
        f32x4 v[16]; float s = 0.f;
#pragma unroll
        for (int j = 0; j < 16; ++j) { v[j] = xr[64 * j]; s += (v[j].x * v[j].x + v[j].y * v[j].y) + (v[j].z * v[j].z + v[j].w * v[j].w); }
        const float rstd = 1.0f / sqrtf(wave_sum(s) * (1.0f / DM) + EPS);
        GAS unsigned long long* o8 = (GAS unsigned long long*)(HB + (size_t)m * DM) + c.lane;
#pragma unroll
        for (int j = 0; j < 16; ++j) { const f32x4 w = ((const GAS f32x4*)a.pre_w)[c.lane + 64 * j];
            o8[64 * j] = (unsigned long long)pk2(v[j].x * rstd * w.x, v[j].y * rstd * w.y) | ((unsigned long long)pk2(v[j].z * rstd * w.z, v[j].w * rstd * w.w) << 32); }
    }
    {
        float* COS = (float*)(ws + WS_COS); float* SIN = (float*)(ws + WS_SIN);
        for (int e = c.gw * 64 + c.lane; e < M * 64; e += c.NGW * 64) {
            const int m = e >> 6, i = e & 63;
            double inv = 1.0; for (int k = 0; k < i; ++k) inv *= 0.8659643233600653;
            const double ang = (double)a.pos[m] * inv;
            const double TWO_PI = 6.283185307179586476925286766559;
            const double n = __builtin_rint(ang / TWO_PI);
            const double r = ang - n * TWO_PI;
            const double r2 = r * r;
            double sn = 0.0, cs = 0.0;
            double ts = r, tc = 1.0;
#pragma unroll
            for (int k = 0; k < 14; ++k) { sn += ts; cs += tc; ts *= -r2 / (double)((2 * k + 2) * (2 * k + 3)); tc *= -r2 / (double)((2 * k + 1) * (2 * k + 2)); }
            COS[e] = (float)cs; SIN[e] = (float)sn;
        }
    }
    {
        float* B1 = (float*)(ws + WS_BIAS1);
        for (int o = c.gw; o < 512; o += c.NGW) {
            const int kv = o >> 8, n = o & 255; const float* pe = kv ? a.pe_v : a.pe_k; const float* w1 = kv ? a.wv1 : a.wk1;
            float s = 0.f;
            for (int i = c.lane; i < 4096; i += 64) s += pe[i] * w1[(size_t)i * 256 + n];
            s = wave_sum(s);
            if (c.lane == 0) B1[o] = s;
        }
    }
}

__device__ __forceinline__ void p2_rope(const Args& a, const Ctx& c) {
    unsigned char* ws = a.ws;
    bf16* P = (bf16*)(ws + WS_P); bf16* QR = (bf16*)(ws + WS_QR);
    const float* COS = (const float*)(ws + WS_COS); const float* SIN = (const float*)(ws + WS_SIN);
    for (int m = c.gw; m < M; m += c.NGW) {
        const float cs = COS[m * 64 + c.lane], sn = SIN[m * 64 + c.lane];
        bf16* row = P + (size_t)m * LDP;
        for (int s = 0; s < 56; ++s) {
            int col; bf16* dst;
            if (s < 16) { col = C_QA + s * 128; dst = QR + (size_t)m * 2048 + s * 128; }
            else if (s < 20) { col = C_KSL + (s - 16) * 128; dst = row + col; }
            else if (s < 24) { col = C_KW + (s - 20) * 128; dst = row + col; }
            else if (s < 40) { col = C_QB + (s - 24) * 128; dst = row + col; }
            else { col = C_KB + (s - 40) * 128; dst = row + col; }
            const float x1 = bf2f(row[col + c.lane]), x2 = bf2f(row[col + 64 + c.lane]);
            dst[c.lane] = (bf16)f2bf(x1 * cs - x2 * sn); dst[64 + c.lane] = (bf16)f2bf(x2 * cs + x1 * sn);
        }
    }
}

__device__ __forceinline__ float gelu_tanh(float x) {
    const float u = 0.7978845608028654f * (x + 0.044715f * x * x * x);
    const float e = __expf(2.0f * u);
    const float th = 1.0f - 2.0f / (e + 1.0f);
    return 0.5f * x * (1.0f + th);
}

__device__ __forceinline__ void p2_compress(const Args& a, const Ctx& c) {
    unsigned char* ws = a.ws;
    const bf16* P = (const bf16*)(ws + WS_P);
    const float* B1 = (const float*)(ws + WS_BIAS1);
    LAS float* As = (LAS float*)(c.lds + RING_OFF);
    LAS float* Gs = (LAS float*)(c.lds + RING_OFF + 32768);
    for (int it = c.bid; it < 2 * 127; it += c.G) {
        const int kv = it / 127, rb = it % 127;
        const float* w1 = kv ? a.wv1 : a.wk1; const float* w2 = kv ? a.wv2 : a.wk2;
        const int ccol = kv ? C_VC : C_KC;
        float* OUT = (float*)(ws + (kv ? WS_VCMP : WS_KCMP));
        const int n = c.tid & 255, half = c.tid >> 8;
        float acc[8];
#pragma unroll
        for (int r = 0; r < 8; ++r) acc[r] = 0.f;
        for (int ich = 0; ich < 8; ++ich) {
            __syncthreads();
#pragma unroll 4
            for (int q = 0; q < 16; ++q) { const int e = c.tid + 512 * q, r = e >> 9, ii = e & 511, i = ich * 512 + ii, j = i >> 7, d = i & 127;
                const int R = rb * 16 + r, b = R / 508, hk = (R / 127) & 3, cc = R % 127;
                As[e] = bf2f(P[(size_t)(b * SEQ + 16 * cc + j) * LDP + ccol + hk * 128 + d]); }
            __syncthreads();
            for (int ii = 0; ii < 512; ++ii) { const float w = w1[(size_t)(ich * 512 + ii) * 256 + n];
#pragma unroll
                for (int r = 0; r < 8; ++r) acc[r] += As[(half * 8 + r) * 512 + ii] * w; }
        }
        const float b1 = B1[kv * 256 + n];
#pragma unroll
        for (int r = 0; r < 8; ++r) Gs[(half * 8 + r) * 256 + n] = gelu_tanh(acc[r] + b1);
        __syncthreads();
        const int d = c.tid & 127, rq = c.tid >> 7;
        float o[4] = {0.f, 0.f, 0.f, 0.f};
        for (int nn = 0; nn < 256; ++nn) { const float w = w2[nn * 128 + d];
#pragma unroll
            for (int r = 0; r < 4; ++r) o[r] += Gs[(rq * 4 + r) * 256 + nn] * w; }
#pragma unroll
        for (int r = 0; r < 4; ++r) { const int R = rb * 16 + rq * 4 + r, bh = R / 127, cc = R % 127; OUT[(size_t)(bh * 128 + cc) * 128 + d] = o[r]; }
        __syncthreads();
    }
}

__device__ __forceinline__ void p3_cmp(const Args& a, const Ctx& c) {
    unsigned char* ws = a.ws;
    const bf16* P = (const bf16*)(ws + WS_P);
    const float* KC = (const float*)(ws + WS_KCMP); const float* VC = (const float*)(ws + WS_VCMP);
    float* OC = (float*)(ws + WS_OC); unsigned* SEL = (unsigned*)(ws + WS_SEL);
    LAS float* KCs = (LAS float*)(c.lds + RING_OFF);
    LAS float* qs = (LAS float*)(c.lds + RING_OFF + 66048 + c.wave * 4096);
    LAS float* ps = qs + 512;
    for (int it = c.bid; it < 16 * 32; it += c.G) {
        const int bh = it >> 5, tch = it & 31, b = bh >> 2, hk = bh & 3;
        __syncthreads();
        for (int e = c.tid; e < 127 * 128; e += 512) KCs[(e >> 7) * 129 + (e & 127)] = KC[(size_t)bh * 128 * 128 + e];
        __syncthreads();
        for (int tt = 0; tt < 8; ++tt) {
            const int t = tch * 64 + c.wave * 8 + tt, m = b * SEQ + t;
            const int ncv = t >= 31 ? (t - 31) / 16 + 1 : 0;
            const int cur = t >> 6;
#pragma unroll
            for (int g = 0; g < 4; ++g) { const bf16* qp = P + (size_t)m * LDP + C_QA + (hk * 4 + g) * 128;
                qs[g * 128 + c.lane] = bf2f(qp[c.lane]) * QSCALE; qs[g * 128 + 64 + c.lane] = bf2f(qp[64 + c.lane]) * QSCALE; }
            LDS_WAIT(); asm volatile("" ::: "memory");
#pragma unroll
            for (int g = 0; g < 4; ++g) {
                float s0 = 0.f, s1 = 0.f; const int c0 = c.lane, c1 = c.lane + 64;
                const int c1c = c1 < 127 ? c1 : 126;
                for (int d = 0; d < 128; ++d) { const float q = qs[g * 128 + d]; s0 += q * KCs[c0 * 129 + d]; s1 += q * KCs[c1c * 129 + d]; }
                const bool v0 = c0 < ncv, v1 = c1 < ncv;
                const float mx = wave_max(fmaxf(v0 ? s0 : -INFINITY, v1 ? s1 : -INFINITY));
                float p0 = v0 ? __expf(s0 - mx) : 0.f, p1 = v1 ? __expf(s1 - mx) : 0.f;
                const float sum = wave_sum(p0 + p1);
                const float inv = ncv > 0 ? 1.0f / sum : 0.f;
                ps[g * 128 + c0] = p0 * inv; ps[g * 128 + c1] = p1 * inv;
            }
            LDS_WAIT(); asm volatile("" ::: "memory");
            {
                float acc[4][2];
#pragma unroll
                for (int g = 0; g < 4; ++g) { acc[g][0] = 0.f; acc[g][1] = 0.f; }
                for (int cc = 0; cc < ncv; ++cc) { const float* vr = VC + ((size_t)bh * 128 + cc) * 128; const float v0 = vr[c.lane], v1 = vr[64 + c.lane];
#pragma unroll
                    for (int g = 0; g < 4; ++g) { const float p = ps[g * 128 + cc]; acc[g][0] += p * v0; acc[g][1] += p * v1; } }
#pragma unroll
                for (int g = 0; g < 4; ++g) { float* op = OC + (size_t)m * 2048 + (hk * 4 + g) * 128; op[c.lane] = acc[g][0]; op[64 + c.lane] = acc[g][1]; }
            }
            {
                const int j = c.lane & 31;
                float imp = 0.f;
#pragma unroll
                for (int g = 0; g < 4; ++g)
#pragma unroll
                    for (int k = -1; k <= 3; ++k) { const int cc = 4 * j + k; if (cc >= 0 && cc < 127) imp += ps[g * 128 + cc]; }
                const bool forced = (j == 0) || (j == cur) || (j == cur - 1);
                float v = forced ? imp + 1e4f : imp;
                if (j > cur) v = -INFINITY;
                int rank = 0;
                for (int jj = 0; jj < 32; ++jj) { const float vo = __shfl(v, jj); rank += (vo > v || (vo == v && jj < j)) ? 1 : 0; }
                const bool sel = (rank < TOPN) && (j <= cur) && (c.lane < 32);
                const unsigned long long bal = __ballot(sel);
                if (c.lane == 0) SEL[bh * SEQ + t] = (unsigned)bal;
            }
            LDS_WAIT(); asm volatile("" ::: "memory");
        }
    }
}

template <int G>
__device__ __forceinline__ void attn_chunk(const bf16* Kb, const bf16* Vb, int base, int step, int count, int t,
                                           const LAS float* qs, LAS float* ps, float (&mrun)[G], float (&lrun)[G], float (&acc)[G][2], int lane) {
    const int kidx = base + step * lane; const bool valid = lane < count && kidx >= 0 && kidx <= t;
    float s[G];
#pragma unroll
    for (int g = 0; g < G; ++g) s[g] = 0.f;
    if (valid) {
        const GAS v4u* kr = (const GAS v4u*)(Kb + (size_t)kidx * LDP);
#pragma unroll 4
        for (int d8 = 0; d8 < 16; ++d8) { const v4u kv = kr[d8]; float kf[8];
            kf[0] = __builtin_bit_cast(float, kv.x << 16); kf[1] = __builtin_bit_cast(float, kv.x & 0xffff0000u);
            kf[2] = __builtin_bit_cast(float, kv.y << 16); kf[3] = __builtin_bit_cast(float, kv.y & 0xffff0000u);
            kf[4] = __builtin_bit_cast(float, kv.z << 16); kf[5] = __builtin_bit_cast(float, kv.z & 0xffff0000u);
            kf[6] = __builtin_bit_cast(float, kv.w << 16); kf[7] = __builtin_bit_cast(float, kv.w & 0xffff0000u);
#pragma unroll
            for (int g = 0; g < G; ++g)
#pragma unroll
                for (int j = 0; j < 8; ++j) s[g] += qs[g * 128 + d8 * 8 + j] * kf[j]; }
    }
#pragma unroll
    for (int g = 0; g < G; ++g) {
        const float mx = wave_max(valid ? s[g] : -INFINITY);
        const float mnew = fmaxf(mrun[g], mx), alpha = __expf(mrun[g] - mnew);
        const float p = valid ? __expf(s[g] - mnew) : 0.f;
        lrun[g] = lrun[g] * alpha + wave_sum(p); acc[g][0] *= alpha; acc[g][1] *= alpha; mrun[g] = mnew; ps[g * 64 + lane] = p;
    }
    LDS_WAIT(); asm volatile("" ::: "memory");
    const int nv = __popcll(__ballot(valid));
    for (int i = 0; i < nv; ++i) { const bf16* vr = Vb + (size_t)(base + step * i) * LDP; const float v0 = bf2f(vr[lane]), v1 = bf2f(vr[64 + lane]);
#pragma unroll
        for (int g = 0; g < G; ++g) { const float p = ps[g * 64 + i]; acc[g][0] += p * v0; acc[g][1] += p * v1; } }
    LDS_WAIT(); asm volatile("" ::: "memory");
}

__device__ __forceinline__ float sigmoidf_(float x) { return 1.0f / (1.0f + __expf(-x)); }

__device__ __forceinline__ void p4_nsa(const Args& a, const Ctx& c) {
    unsigned char* ws = a.ws;
    const bf16* P = (const bf16*)(ws + WS_P); const bf16* QR = (const bf16*)(ws + WS_QR);
    const float* OC = (const float*)(ws + WS_OC); const unsigned* SEL = (const unsigned*)(ws + WS_SEL);
    bf16* MIX = (bf16*)(ws + WS_MIX);
    LAS float* qs = (LAS float*)(c.lds + RING_OFF + c.wave * 4096);
    LAS float* ps = qs + 512;
    for (int it = c.gw; it < 16 * SEQ; it += c.NGW) {
        const int bh = it >> 11, t = it & 2047, b = bh >> 2, hk = bh & 3, m = b * SEQ + t;
#pragma unroll
        for (int g = 0; g < 4; ++g) { const bf16* qp = QR + (size_t)m * 2048 + (hk * 4 + g) * 128;
            qs[g * 128 + c.lane] = bf2f(qp[c.lane]) * QSCALE; qs[g * 128 + 64 + c.lane] = bf2f(qp[64 + c.lane]) * QSCALE; }
        LDS_WAIT(); asm volatile("" ::: "memory");
        const bf16* Pb = P + (size_t)b * SEQ * LDP;
        float osl[4][2], owin[4][2];
        {
            float mr[4], lr[4], acc[4][2];
#pragma unroll
            for (int g = 0; g < 4; ++g) { mr[g] = -1e30f; lr[g] = 0.f; acc[g][0] = 0.f; acc[g][1] = 0.f; }
            const unsigned mask = (unsigned)__builtin_amdgcn_readfirstlane((int)SEL[bh * SEQ + t]);
            for (int j = 0; j < 32; ++j) if ((mask >> j) & 1u)
                attn_chunk<4>(Pb + C_KSL + hk * 128, Pb + C_VSL + hk * 128, 64 * j, 1, 64, t, qs, ps, mr, lr, acc, c.lane);
#pragma unroll
            for (int g = 0; g < 4; ++g) { const float il = 1.0f / lr[g]; osl[g][0] = acc[g][0] * il; osl[g][1] = acc[g][1] * il; }
        }
        {
            float mr[4], lr[4], acc[4][2];
#pragma unroll
            for (int g = 0; g < 4; ++g) { mr[g] = -1e30f; lr[g] = 0.f; acc[g][0] = 0.f; acc[g][1] = 0.f; }
            for (int w = 0; w < 8; ++w) { if (t - 64 * w < 0) break;
                attn_chunk<4>(Pb + C_KW + hk * 128, Pb + C_VW + hk * 128, t - 64 * w, -1, 64, t, qs, ps, mr, lr, acc, c.lane); }
#pragma unroll
            for (int g = 0; g < 4; ++g) { const float il = 1.0f / lr[g]; owin[g][0] = acc[g][0] * il; owin[g][1] = acc[g][1] * il; }
        }
        const bf16* prow = P + (size_t)m * LDP;
#pragma unroll
        for (int g = 0; g < 4; ++g) { const int h = hk * 4 + g;
            const float g0 = sigmoidf_(bf2f(prow[C_GA + h * 3 + 0]) + a.b_gate[h * 3 + 0]);
            const float g1 = sigmoidf_(bf2f(prow[C_GA + h * 3 + 1]) + a.b_gate[h * 3 + 1]);
            const float g2 = sigmoidf_(bf2f(prow[C_GA + h * 3 + 2]) + a.b_gate[h * 3 + 2]);
#pragma unroll
            for (int hf = 0; hf < 2; ++hf) { const int d = c.lane + 64 * hf;
                const float oc = OC[(size_t)m * 2048 + h * 128 + d];
                const float o = g0 * oc + g1 * osl[g][hf] + g2 * owin[g][hf];
                const float z = bf2f(prow[C_ZA + h * 128 + d]);
                MIX[(size_t)m * DM + h * 128 + d] = (bf16)f2bf(o * z * sigmoidf_(z)); } }
    }
}

__device__ __forceinline__ void p4_dilated(const Args& a, const Ctx& c) {
    unsigned char* ws = a.ws;
    const bf16* P = (const bf16*)(ws + WS_P); bf16* MIX = (bf16*)(ws + WS_MIX);
    LAS float* qs = (LAS float*)(c.lds + RING_OFF + c.wave * 4096);
    LAS float* ps = qs + 512;
    for (int it = c.gw; it < BATCH * NHB * SEQ; it += c.NGW) {
        const int bh = it >> 11, t = it & 2047, b = bh >> 4, h = bh & 15, m = b * SEQ + t;
        const bf16* prow = P + (size_t)m * LDP;
        qs[c.lane] = bf2f(prow[C_QB + h * 128 + c.lane]) * QSCALE; qs[64 + c.lane] = bf2f(prow[C_QB + h * 128 + 64 + c.lane]) * QSCALE;
        LDS_WAIT(); asm volatile("" ::: "memory");
        const bf16* Pb = P + (size_t)b * SEQ * LDP; const bf16* Kb = Pb + C_KB + h * 128; const bf16* Vb = Pb + C_VB + h * 128;
        float mr[1] = {-1e30f}, lr[1] = {0.f}, acc[1][2] = {{0.f, 0.f}};
        for (int w = 0; w < 3; ++w) { const int cnt = (w < 2) ? 64 : 1; if (t - 64 * w < 0) break;
            attn_chunk<1>(Kb, Vb, t - 64 * w, -1, cnt, t, qs, ps, mr, lr, acc, c.lane); }
        for (int w = 0; w < 3; ++w) { const int cnt = (w < 2) ? 64 : 1; if (t - 256 * w < 0) break;
            attn_chunk<1>(Kb, Vb, t - 256 * w, -4, cnt, t, qs, ps, mr, lr, acc, c.lane); }
        for (int w = 0; w < 2; ++w) { if (t - 1024 * w < 0) break;
            attn_chunk<1>(Kb, Vb, t - 1024 * w, -16, 64, t, qs, ps, mr, lr, acc, c.lane); }
        const float il = 1.0f / lr[0];
#pragma unroll
        for (int hf = 0; hf < 2; ++hf) { const int d = c.lane + 64 * hf; const float z = bf2f(prow[C_ZB + h * 128 + d]);
            MIX[(size_t)m * DM + 2048 + h * 128 + d] = (bf16)f2bf(acc[0][hf] * il * z * sigmoidf_(z)); }
    }
}

__device__ __forceinline__ void p6_final(const Args& a, const Ctx& c) {
    const float* Y = (const float*)(a.ws + WS_Y);
    for (int m = c.gw; m < M; m += c.NGW) {
        const GAS f32x4* yr = (const GAS f32x4*)(Y + (size_t)m * DM) + c.lane;
        f32x4 v[16]; float s = 0.f;
#pragma unroll
        for (int j = 0; j < 16; ++j) { v[j] = yr[64 * j]; s += (v[j].x * v[j].x + v[j].y * v[j].y) + (v[j].z * v[j].z + v[j].w * v[j].w); }
        const float rstd = 1.0f / sqrtf(wave_sum(s) * (1.0f / DM) + EPS);
        const GAS f32x4* xr = (const GAS f32x4*)(a.x + (size_t)m * DM) + c.lane;
        GAS f32x4* orow = (GAS f32x4*)(a.out + (size_t)m * DM) + c.lane;
#pragma unroll
        for (int j = 0; j < 16; ++j) { const f32x4 w = ((const GAS f32x4*)a.post_w)[c.lane + 64 * j]; const f32x4 xv = xr[64 * j];
            orow[64 * j] = xv + v[j] * rstd * w; }
    }
}

#ifndef MK_SPLIT
#define MK_SPLIT 0
#endif
constexpr int NPHASE = 7;

__global__ void __launch_bounds__(NWAVES * 64, 2) fwd_kernel(Args args) {
    extern __shared__ __attribute__((aligned(16))) unsigned char lds_raw[];
    Ctx c;
    c.lds = (LAS unsigned char*)lds_raw;
    c.tid = threadIdx.x; c.lane = c.tid & 63; c.wave = __builtin_amdgcn_readfirstlane(c.tid >> 6);
    c.G = gridDim.x; c.bid = blockIdx.x; c.gw = c.bid * NWAVES + c.wave; c.NGW = c.G * NWAVES;
    unsigned char* ws = args.ws;
    gu32* ctl = (gu32*)(ws + WS_CTL);
    volatile LAS unsigned* MISC = (volatile LAS unsigned*)(c.lds + MISC_OFF);
    for (int u = c.tid; u < (LDS_BYTES - LDSCTL_OFF) / 4; u += NWAVES * 64) ((LAS unsigned*)(c.lds + LDSCTL_OFF))[u] = 0u;
    __syncthreads();
    XcdBarrier bar; bar.bar = (unsigned*)(ctl + CW_BAR); bar.x = 0; bar.st = nullptr;
    if (!MK_SPLIT) bar = xcd_barrier_post((unsigned*)(ctl + CW_BAR), MISC + 8);
    const int lo = args.ph_lo, hi = args.ph_hi;
#define IN(k) (lo <= (k) && (k) < hi)
#define SEAM(k) do { if (IN(k) && IN((k) + 1)) xcd_barrier(bar); } while (0)

    if (IN(0)) { p0_prologue(args, c); } SEAM(0);
    if (IN(1)) {
        pg8::Gemm g{(const pg8::bf16_t*)(ws + WS_HB), (const pg8::bf16_t*)(ws + WS_WIN), M, NP, DM}; pg8::StaticOrder S; S.init(M, NP, c.G, c.bid);
        pg8::EpiBf16<0> E{(pg8::bf16_t*)(ws + WS_P), NP, nullptr, 0, 0, 1.f};
        pg8::gemm_phase<pg8::EpiBf16<0>, pg8::StaticOrder, true, true>(c.lds + RING_OFF, g, S, E);
    } SEAM(1);
    if (IN(2)) { p2_rope(args, c); p2_compress(args, c); } SEAM(2);
    if (IN(3)) { p3_cmp(args, c); } SEAM(3);
    if (IN(4)) { p4_nsa(args, c); p4_dilated(args, c); } SEAM(4);
    if (IN(5)) {
        pg8::Gemm g{(const pg8::bf16_t*)(ws + WS_MIX), (const pg8::bf16_t*)(ws + WS_WOUT), M, DM, DM}; pg8::StaticOrder S; S.init(M, DM, c.G, c.bid);
        pg8::EpiF32 E{(float*)(ws + WS_Y), DM};
        pg8::gemm_phase<pg8::EpiF32, pg8::StaticOrder, true, true>(c.lds + RING_OFF, g, S, E);
    } SEAM(5);
    if (IN(6)) { p6_final(args, c); }
#undef IN
#undef SEAM
}

extern "C" void kernel_launch(void* const* d_in, const int* in_sizes, int n_in, void* d_out, int out_size, void* d_ws, size_t ws_size, hipStream_t stream) {
    static int grid = 0;
    if (grid == 0) {
        if (n_in != 13 || out_size != M * DM || ws_size < WS_END) { fprintf(stderr, "kernel_launch: unexpected shapes (n_in %d out %d ws %zu)\n", n_in, out_size, ws_size); grid = -1; return; }
        int dev = 0, cus = 0, per_cu = 0;
        if (hipGetDevice(&dev) != hipSuccess || hipDeviceGetAttribute(&cus, hipDeviceAttributeMultiprocessorCount, dev) != hipSuccess) { grid = -1; return; }
        if (hipFuncSetAttribute((const void*)fwd_kernel, hipFuncAttributeMaxDynamicSharedMemorySize, LDS_BYTES) != hipSuccess) { fprintf(stderr, "kernel_launch: hipFuncSetAttribute failed\n"); grid = -1; return; }
        if (hipOccupancyMaxActiveBlocksPerMultiprocessor(&per_cu, (const void*)fwd_kernel, NWAVES * 64, LDS_BYTES) != hipSuccess || per_cu < 1)
            fprintf(stderr, "kernel_launch: occupancy query reports %d\n", per_cu);
        (void)hipGetLastError();
        grid = cus;
    }
    if (grid < 0) return;
    if (hipMemsetAsync((char*)d_ws + WS_CTL, 0, CTL_ZERO_BYTES, stream) != hipSuccess) return;
    Args a{};
    a.x = (const float*)d_in[0]; a.pos = (const int*)d_in[1]; a.pre_w = (const float*)d_in[2]; a.post_w = (const float*)d_in[3];
    a.w_in = (const float*)d_in[4]; a.b_gate = (const float*)d_in[5]; a.pe_k = (const float*)d_in[6]; a.pe_v = (const float*)d_in[7];
    a.wk1 = (const float*)d_in[8]; a.wk2 = (const float*)d_in[9]; a.wv1 = (const float*)d_in[10]; a.wv2 = (const float*)d_in[11]; a.w_out = (const float*)d_in[12];
    a.out = (float*)d_out; a.ws = (unsigned char*)d_ws;
#if MK_SPLIT
    for (int p = 0; p < NPHASE; ++p) { a.ph_lo = p; a.ph_hi = p + 1; hipLaunchKernelGGL(fwd_kernel, dim3(grid), dim3(NWAVES * 64), LDS_BYTES, stream, a); }
#else
    a.ph_lo = 0; a.ph_hi = NPHASE;
    hipLaunchKernelGGL(fwd_kernel, dim3(grid), dim3(NWAVES * 64), LDS_BYTES, stream, a);
#endif
}
```

```cpp
#include <hip/hip_runtime.h>
#include <cstdio>
#include <cstdint>
namespace pg8 {
#define PG8_LAS __attribute__((address_space(3)))
typedef unsigned short bf16_t;
typedef short bf16x8 __attribute__((ext_vector_type(8)));
typedef float f32x4 __attribute__((ext_vector_type(4)));
typedef unsigned u32x4 __attribute__((ext_vector_type(4)));
constexpr int BM = 256, BK = 64, HALF = 128, HTB = HALF * BK * 2  , STAGE_BYTES = 8 * HTB, NXCD = 8, WGM = 8;

__host__ __device__ __forceinline__ int lds_byte(int r, int c) { const int st = (r >> 4) * 2 + (c >> 5), rr = r & 15, cc = c & 31, ob = rr * 64 + cc * 2; return st * 1024 + (ob ^ (((ob >> 9) & 1) << 5)); }
__host__ __device__ __forceinline__ void stage_rc(int b, int& R, int& C) { const int st = b / 1024, sb = b % 1024, swz = sb ^ (((sb >> 9) & 1) << 5); R = (st >> 1) * 16 + swz / 64; C = (st & 1) * 32 + (swz % 64) / 2; }
__host__ __device__ __forceinline__ int perm32(int rho) { const int n = rho >> 4, i = rho & 15; return 8 * (i >> 2) + 4 * n + (i & 3); }

struct Unit { int pm, pn, ko; };
struct Gemm { const bf16_t* A; const bf16_t* Bt; int M, N, K, ld; };

struct StaticOrder {
    int nM, nN, nwg, G, c;
    __host__ __device__ void init(int M, int N, int G_, int c_) { nM = M / BM; nN = N / BM; nwg = nM * nN; G = G_; c = c_; }
    __host__ __device__ bool next(int i, Unit& u) const {
        const long L = (long)i * G + c; if (L >= nwg) return false;
        int wgid = (int)L; { const int q = nwg / NXCD, r = nwg % NXCD, xcd = wgid % NXCD, off = wgid / NXCD; wgid = (xcd < r ? xcd * (q + 1) : r * (q + 1) + (xcd - r) * q) + off; }
        const int nig = WGM * nN, gid = wgid / nig, fm = gid * WGM, gsz = (nM - fm) < WGM ? (nM - fm) : WGM;
        u.pm = fm + ((wgid % nig) % gsz); u.pn = (wgid % nig) / gsz; u.ko = 0; return true;
    }
    __device__ __forceinline__ void a_ready(const Unit&) const {}
    __device__ __forceinline__ void done(const Unit&) const {}
};

__device__ __forceinline__ unsigned cvt_pk_bf16(float lo, float hi) { unsigned r; asm volatile("v_cvt_pk_bf16_f32 %0, %1, %2" : "=v"(r) : "v"(lo), "v"(hi)); return r; }
typedef float f32x2 __attribute__((ext_vector_type(2)));
__device__ __forceinline__ f32x2 gelu_pk(f32x2 v) {
    const f32x2 av = __builtin_elementwise_abs(v), d = av * 0.2316418882f + 1.0f;
    f32x2 t; t.x = __builtin_amdgcn_rcpf(d.x); t.y = __builtin_amdgcn_rcpf(d.y);
    f32x2 q = t * 0.5307027145f + (-0.7265760135f); q = q * t + 0.7107068705f; q = q * t + (-0.142248368f); q = q * t + 0.127414796f; q = q * t;
    const f32x2 s = (v * v) * (-0.72134752044f);
    f32x2 e; e.x = __builtin_amdgcn_exp2f(s.x); e.y = __builtin_amdgcn_exp2f(s.y);
    const f32x2 m = v * (q * e), r = v - m;
    f32x2 o; o.x = v.x < 0.f ? m.x : r.x; o.y = v.y < 0.f ? m.y : r.y; return o;
}

template <int ACT  > struct EpiBf16 {
    static constexpr bool PERM = true, AFTER_DRAIN = false; static_assert(ACT == 0 || ACT == 1, "EpiBf16: ACT is 0 (none) or 1 (gelu_pk)");
    bf16_t* O; int ldc; const float* bias; int split_cols; size_t split_stride; float scale0;
    __device__ __forceinline__ void operator()(const f32x4 (&acc)[2][2][4][2], const Unit& u, int wr, int wc, int fr, int fq) const {
        const int row0 = u.pm * BM + wr * 64 + fr; int colt = u.pn * BM; bf16_t* base = O;
        float sc = 1.f; if (split_cols) { const int t = colt / split_cols; base += (size_t)t * split_stride; colt -= t * split_cols; if (t == 0) sc = scale0; }
        const int col0 = colt + wc * 32 + 8 * fq, bcol0 = u.pn * BM + wc * 32 + 8 * fq;
        f32x4 bv[2][2];
#pragma unroll
        for (int bj = 0; bj < 2; ++bj)
#pragma unroll
            for (int n = 0; n < 2; ++n) bv[bj][n] = bias ? *(const f32x4*)(bias + bcol0 + bj * HALF + 4 * n) : (f32x4){0.f, 0.f, 0.f, 0.f};
#pragma unroll
        for (int ai = 0; ai < 2; ++ai)
#pragma unroll
            for (int m = 0; m < 4; ++m) { bf16_t* rowp = base + (size_t)(row0 + ai * HALF + m * 16) * ldc + col0;
#pragma unroll
                for (int bj = 0; bj < 2; ++bj) { f32x4 v0 = acc[ai][bj][m][0] + bv[bj][0], v1 = acc[ai][bj][m][1] + bv[bj][1];
                    if (ACT == 1) { f32x2 a = gelu_pk((f32x2){v0[0], v0[1]}), b = gelu_pk((f32x2){v0[2], v0[3]}), c = gelu_pk((f32x2){v1[0], v1[1]}), d = gelu_pk((f32x2){v1[2], v1[3]});
                        v0 = (f32x4){a.x, a.y, b.x, b.y}; v1 = (f32x4){c.x, c.y, d.x, d.y}; }
                    v0 = v0 * sc; v1 = v1 * sc; u32x4 w; w.x = cvt_pk_bf16(v0[0], v0[1]); w.y = cvt_pk_bf16(v0[2], v0[3]); w.z = cvt_pk_bf16(v1[0], v1[1]); w.w = cvt_pk_bf16(v1[2], v1[3]);
                    *(u32x4*)(rowp + bj * HALF) = w; } }
    }
};
struct EpiF32 {
    static constexpr bool PERM = false, AFTER_DRAIN = false;
    float* O; int ldc;
    __device__ __forceinline__ void operator()(const f32x4 (&acc)[2][2][4][2], const Unit& u, int wr, int wc, int fr, int fq) const {
        const int row0 = u.pm * BM + wr * 64 + fr, col0 = u.pn * BM + wc * 32 + 4 * fq;
#pragma unroll
        for (int ai = 0; ai < 2; ++ai)
#pragma unroll
            for (int m = 0; m < 4; ++m) { float* rowp = O + (size_t)(row0 + ai * HALF + m * 16) * ldc + col0;
#pragma unroll
                for (int bj = 0; bj < 2; ++bj)
#pragma unroll
                    for (int n = 0; n < 2; ++n) *(f32x4*)(rowp + bj * HALF + n * 16) = acc[ai][bj][m][n]; }
    }
};

struct EpiP {
    static constexpr bool PERM = true, AFTER_DRAIN = false;
    bf16_t* Pm; int ldc; bf16_t* QR; bf16_t* XKV; const float* COS; const float* SIN;
    __device__ __forceinline__ void operator()(const f32x4 (&acc)[2][2][4][2], const Unit& u, int wr, int wc, int fr, int fq) const {
        const int pn = u.pn;
        const bool is_qa = pn < 8, is_rope = is_qa || pn == 20 || pn == 21 || pn == 24 || pn == 25 || (pn >= 28 && pn < 44), is_x = pn >= 16 && pn < 20;
        const int row0 = u.pm * BM + wr * 64 + fr, colw = wc * 32 + 8 * fq;
#pragma unroll
        for (int ai = 0; ai < 2; ++ai)
#pragma unroll
            for (int m = 0; m < 4; ++m) {
                const int row = row0 + ai * HALF + m * 16;
                f32x4 cs = {1.f, 1.f, 1.f, 1.f}, sn = {0.f, 0.f, 0.f, 0.f};
                if (is_rope) { cs = *(const f32x4*)(COS + (size_t)row * 64 + 16 * wc + 4 * fq); sn = *(const f32x4*)(SIN + (size_t)row * 64 + 16 * wc + 4 * fq); }
#pragma unroll
                for (int bj = 0; bj < 2; ++bj) {
                    const f32x4 v0 = acc[ai][bj][m][0], v1 = acc[ai][bj][m][1];
                    u32x4 w;
                    if (!is_rope || is_qa) { w.x = cvt_pk_bf16(v0[0], v0[1]); w.y = cvt_pk_bf16(v0[2], v0[3]); w.z = cvt_pk_bf16(v1[0], v1[1]); w.w = cvt_pk_bf16(v1[2], v1[3]); }
                    if (is_x) { const int hq = (pn - 16) * 2 + bj, kv = hq >> 2, hk = hq & 3, b = row >> 11, tok = row & 2047;
                        *(u32x4*)(XKV + ((size_t)((kv * 16 + b * 4 + hk) * 2048 + tok)) * 128 + colw) = w; }
                    else if (!is_rope) { *(u32x4*)(Pm + (size_t)row * ldc + pn * BM + bj * HALF + colw) = w; }
                    else {
                        if (is_qa) *(u32x4*)(Pm + (size_t)row * ldc + pn * BM + bj * HALF + colw) = w;
                        const f32x4 r0 = v0 * cs - v1 * sn, r1 = v1 * cs + v0 * sn;
                        u32x4 wr_; wr_.x = cvt_pk_bf16(r0[0], r0[1]); wr_.y = cvt_pk_bf16(r0[2], r0[3]); wr_.z = cvt_pk_bf16(r1[0], r1[1]); wr_.w = cvt_pk_bf16(r1[2], r1[3]);
                        if (is_qa) *(u32x4*)(QR + (size_t)row * 2048 + pn * BM + bj * HALF + colw) = wr_;
                        else *(u32x4*)(Pm + (size_t)row * ldc + pn * BM + bj * HALF + colw) = wr_;
                    }
                }
            }
    }
};

struct EpiLR {
    static constexpr bool PERM = false, AFTER_DRAIN = false;
    float* O; int ldc; size_t ks_stride;
    __device__ __forceinline__ void operator()(const f32x4 (&acc)[2][2][4][2], const Unit& u, int wr, int wc, int fr, int fq) const {
        const int row0 = u.pm * BM + wr * 64 + fr, col0 = u.pn * BM + wc * 32 + 4 * fq; float* Ob = O + (size_t)(u.ko >> 8) * ks_stride;
#pragma unroll
        for (int ai = 0; ai < 2; ++ai)
#pragma unroll
            for (int m = 0; m < 4; ++m) { float* rowp = Ob + (size_t)(row0 + ai * HALF + m * 16) * ldc + col0;
#pragma unroll
                for (int bj = 0; bj < 2; ++bj)
#pragma unroll
                    for (int n = 0; n < 2; ++n) *(f32x4*)(rowp + bj * HALF + n * 16) = acc[ai][bj][m][n]; }
    }
};
struct CmpOrder { int c, G;
    __device__ __forceinline__ bool next(int i, Unit& u) const { const int L = i * G + c; if (L >= 256) return false;
        const int ks = L & 7, q = L >> 3, kv = q >> 4, pmi = (q >> 1) & 7, pni = q & 1; u.pm = kv * 8 + pmi; u.pn = kv * 2 + pni; u.ko = ks * 256; return true; }
    __device__ __forceinline__ void a_ready(const Unit&) const {}
    __device__ __forceinline__ void done(const Unit&) const {}
};

template <class Epi, class Sched, bool ALIGN_EPI = false, bool SP2 = false>
__device__ __forceinline__ void gemm_phase(PG8_LAS unsigned char* lds, const Gemm g, const Sched& S, const Epi& E) {
    const int tid = threadIdx.x, wid = __builtin_amdgcn_readfirstlane(tid >> 6), lane = tid & 63, wr = wid >> 2, wc = wid & 3, fr = lane & 15, fq = lane >> 4;
    const int K = g.K, nt = K / BK, ld = g.ld;
    unsigned voffA[2], voffB[2];
#pragma unroll
    for (int i = 0; i < 2; ++i) { int R, C; stage_rc(tid * 16 + i * 8192, R, C); const int Rb = Epi::PERM ? ((R & ~31) + perm32(R & 31)) : R;
        voffA[i] = (unsigned)(R * ld + C) * 2u; voffB[i] = (unsigned)(Rb * ld + C) * 2u; }
    const size_t kstep = (size_t)(BK * 2);
    const size_t hstep = (size_t)HALF * ld * 2;
    const size_t tstep = 2 * hstep;
    const unsigned ldsw = (unsigned)wid * 1024u;
    const int aoff = lds_byte(wr * 64 + fr, fq * 8), boff = lds_byte(wc * 32 + fr, fq * 8);
#define PG8_SA(b, h) (((b) * 2 + (h)) * HTB)
#define PG8_SB(b, h) ((4 + (b) * 2 + (h)) * HTB)
#define PG8_STAGE(bufoff, gbase, voff) do { _Pragma("unroll") for (int _i = 0; _i < 2; ++_i) \
        __builtin_amdgcn_global_load_lds((const unsigned*)((const char*)(gbase) + (voff)[_i]), (PG8_LAS unsigned*)(lds + (bufoff) + ldsw + _i * 8192), 16, 0, 0); } while (0)
#define PG8_LDA(dst, b, h) do { _Pragma("unroll") for (int m = 0; m < 4; ++m) _Pragma("unroll") for (int k = 0; k < 2; ++k) dst[m][k] = *(const PG8_LAS bf16x8*)(lds + PG8_SA(b, h) + aoff + m * 2048 + k * 1024); } while (0)
#define PG8_LDB(dst, b, h) do { _Pragma("unroll") for (int n = 0; n < 2; ++n) _Pragma("unroll") for (int k = 0; k < 2; ++k) dst[n][k] = *(const PG8_LAS bf16x8*)(lds + PG8_SB(b, h) + boff + n * 2048 + k * 1024); } while (0)
#define PG8_MMA(ai, bj, At, Bt) do { __builtin_amdgcn_s_setprio(1); _Pragma("unroll") for (int m = 0; m < 4; ++m) _Pragma("unroll") for (int n = 0; n < 2; ++n) _Pragma("unroll") for (int k = 0; k < 2; ++k) \
        acc[ai][bj][m][n] = __builtin_amdgcn_mfma_f32_16x16x32_bf16(Bt[n][k], At[m][k], acc[ai][bj][m][n], 0, 0, 0); __builtin_amdgcn_s_setprio(0); } while (0)
#define PG8_WAIT_V(n) asm volatile("s_waitcnt vmcnt(" #n ")" ::: "memory")
#define PG8_WAIT_L(n) asm volatile("s_waitcnt lgkmcnt(" #n ")" ::: "memory")
#define PG8_BAR __builtin_amdgcn_s_barrier()
#define PG8_SCHED __builtin_amdgcn_sched_barrier(0)
    Unit cur, nxt; int ui = 0;
    if (!S.next(0, cur)) return;
    f32x4 acc[2][2][4][2];
#pragma unroll
    for (int a = 0; a < 2; ++a)
#pragma unroll
        for (int b = 0; b < 2; ++b)
#pragma unroll
            for (int m = 0; m < 4; ++m)
#pragma unroll
                for (int n = 0; n < 2; ++n) acc[a][b][m][n] = (f32x4){0.f, 0.f, 0.f, 0.f};
    bf16x8 At[4][2], B0[2][2], B1[2][2];
    const char* cA = (const char*)g.A + (size_t)cur.pm * tstep + (size_t)cur.ko * 2; const char* cB = (const char*)g.Bt + (size_t)cur.pn * tstep + (size_t)cur.ko * 2;
    S.a_ready(cur);
    if constexpr (SP2) {
        PG8_STAGE(PG8_SB(0, 0), cB, voffB); PG8_STAGE(PG8_SB(0, 1), cB + hstep, voffB); PG8_STAGE(PG8_SA(0, 0), cA, voffA); PG8_STAGE(PG8_SA(0, 1), cA + hstep, voffA);
        if (wr == 1) PG8_BAR;
        PG8_WAIT_V(2); PG8_BAR;
        PG8_STAGE(PG8_SB(1, 0), cB + kstep, voffB); PG8_STAGE(PG8_SA(1, 0), cA + kstep, voffA); PG8_STAGE(PG8_SB(1, 1), cB + hstep + kstep, voffB);
        PG8_WAIT_V(6); PG8_BAR;
    } else {
        PG8_STAGE(PG8_SB(0, 0), cB, voffB); PG8_STAGE(PG8_SA(0, 0), cA, voffA); PG8_STAGE(PG8_SB(0, 1), cB + hstep, voffB); PG8_STAGE(PG8_SA(0, 1), cA + hstep, voffA);
        if (wr == 1) PG8_BAR;
        PG8_WAIT_V(4); PG8_BAR;
        PG8_STAGE(PG8_SB(1, 0), cB + kstep, voffB); PG8_STAGE(PG8_SA(1, 0), cA + kstep, voffA); PG8_STAGE(PG8_SB(1, 1), cB + hstep + kstep, voffB);
        PG8_WAIT_V(6); PG8_BAR;
    }
    for (;;) {
        const bool has_next = S.next(ui + 1, nxt);
        const char* nA = has_next ? (const char*)g.A + (size_t)nxt.pm * tstep + (size_t)nxt.ko * 2 : cA; const char* nB = has_next ? (const char*)g.Bt + (size_t)nxt.pn * tstep + (size_t)nxt.ko * 2 : cB;
        for (int t = 0; t < nt; t += 2) {
            const bool last = (t == nt - 2);
            const char* a1 = cA + (size_t)(t + 1) * kstep;
            const char* a2 = last ? nA : cA + (size_t)(t + 2) * kstep; const char* b2 = last ? nB : cB + (size_t)(t + 2) * kstep;
            const char* a3 = a2 + kstep; const char* b3 = b2 + kstep;
            if (last && has_next) S.a_ready(nxt);
            if constexpr (SP2) {
            PG8_LDB(B0, 0, 0); PG8_LDB(B1, 0, 1); PG8_SCHED; PG8_LDA(At, 0, 0); PG8_STAGE(PG8_SA(1, 1), a1 + hstep, voffA);
            PG8_WAIT_V(8); PG8_WAIT_L(0); PG8_BAR; PG8_MMA(0, 0, At, B0); PG8_MMA(0, 1, At, B1); PG8_BAR; PG8_SCHED;
            PG8_LDA(At, 0, 1); PG8_STAGE(PG8_SB(0, 0), b2, voffB); PG8_STAGE(PG8_SB(0, 1), b2 + hstep, voffB); PG8_STAGE(PG8_SA(0, 0), a2, voffA);
            PG8_WAIT_V(8); PG8_WAIT_L(0); PG8_BAR; PG8_MMA(1, 0, At, B0); PG8_MMA(1, 1, At, B1); PG8_BAR; PG8_SCHED;
            PG8_LDB(B0, 1, 0); PG8_LDB(B1, 1, 1); PG8_SCHED; PG8_LDA(At, 1, 0); PG8_STAGE(PG8_SA(0, 1), a2 + hstep, voffA);
            PG8_WAIT_V(8); PG8_WAIT_L(0); PG8_BAR; PG8_MMA(0, 0, At, B0); PG8_MMA(0, 1, At, B1); PG8_BAR; PG8_SCHED;
            PG8_LDA(At, 1, 1); PG8_STAGE(PG8_SB(1, 0), b3, voffB); PG8_STAGE(PG8_SB(1, 1), b3 + hstep, voffB); PG8_STAGE(PG8_SA(1, 0), a3, voffA);
            PG8_WAIT_V(8); PG8_WAIT_L(0); PG8_BAR; PG8_MMA(1, 0, At, B0); PG8_MMA(1, 1, At, B1); PG8_BAR; PG8_SCHED;
            } else {
            PG8_LDB(B0, 0, 0); PG8_SCHED; PG8_LDA(At, 0, 0); PG8_STAGE(PG8_SA(1, 1), a1 + hstep, voffA);
            PG8_WAIT_L(8); PG8_BAR; PG8_WAIT_L(0); PG8_MMA(0, 0, At, B0); PG8_BAR; PG8_SCHED;
            PG8_LDB(B1, 0, 1); PG8_STAGE(PG8_SB(0, 0), b2, voffB);
            PG8_BAR; PG8_WAIT_L(0); PG8_MMA(0, 1, At, B1); PG8_BAR;
            PG8_LDA(At, 0, 1); PG8_STAGE(PG8_SA(0, 0), a2, voffA);
            PG8_BAR; PG8_WAIT_L(0); PG8_MMA(1, 0, At, B0); PG8_BAR; PG8_SCHED;
            PG8_STAGE(PG8_SB(0, 1), b2 + hstep, voffB);
            PG8_WAIT_V(6); PG8_BAR; PG8_MMA(1, 1, At, B1); PG8_BAR;
            PG8_LDB(B0, 1, 0); PG8_SCHED; PG8_LDA(At, 1, 0); PG8_STAGE(PG8_SA(0, 1), a2 + hstep, voffA);
            PG8_WAIT_L(8); PG8_BAR; PG8_WAIT_L(0); PG8_MMA(0, 0, At, B0); PG8_BAR; PG8_SCHED;
            PG8_LDB(B1, 1, 1); PG8_STAGE(PG8_SB(1, 0), b3, voffB);
            PG8_BAR; PG8_WAIT_L(0); PG8_MMA(0, 1, At, B1); PG8_BAR;
            PG8_LDA(At, 1, 1); PG8_STAGE(PG8_SA(1, 0), a3, voffA);
            PG8_BAR; PG8_WAIT_L(0); PG8_MMA(1, 0, At, B0); PG8_BAR; PG8_SCHED;
            PG8_STAGE(PG8_SB(1, 1), b3 + hstep, voffB);
            PG8_WAIT_V(6); PG8_BAR; PG8_MMA(1, 1, At, B1); PG8_BAR;
            }
        }
        if constexpr (ALIGN_EPI) { if (wr == 0) PG8_BAR; }
        if constexpr (!Epi::AFTER_DRAIN) { E(acc, cur, wr, wc, fr, fq); S.done(cur); }
        if (!has_next) break;
#pragma unroll
        for (int a = 0; a < 2; ++a)
#pragma unroll
            for (int b = 0; b < 2; ++b)
#pragma unroll
                for (int m = 0; m < 4; ++m)
#pragma unroll
                    for (int n = 0; n < 2; ++n) acc[a][b][m][n] = (f32x4){0.f, 0.f, 0.f, 0.f};
        cur = nxt; cA = nA; cB = nB; ++ui;
        if constexpr (ALIGN_EPI) { if (wr == 1) PG8_BAR; }
    }
    PG8_WAIT_V(0);
    if constexpr (!ALIGN_EPI) { if (wr == 0) PG8_BAR; }
    PG8_BAR;
    if constexpr (Epi::AFTER_DRAIN) { E.fused(acc, cur, wr, wc, fr, fq, lds, wid, lane); S.done(cur); }
#undef PG8_SA
#undef PG8_SB
#undef PG8_STAGE
#undef PG8_LDA
#undef PG8_LDB
#undef PG8_MMA
#undef PG8_WAIT_V
#undef PG8_WAIT_L
#undef PG8_BAR
#undef PG8_SCHED
}
}
#define GAS __attribute__((address_space(1)))
#define LAS __attribute__((address_space(3)))
typedef unsigned short bf16;
typedef unsigned v4u __attribute__((ext_vector_type(4)));
typedef float f32x4 __attribute__((ext_vector_type(4)));
typedef short bf16x8 __attribute__((ext_vector_type(8)));
typedef GAS unsigned gu32;
typedef GAS unsigned long long gu64;
#define RLX_AGENT __ATOMIC_RELAXED, __HIP_MEMORY_SCOPE_AGENT
#define LDS_WAIT() asm volatile("s_waitcnt lgkmcnt(0)" ::: "memory")
#define VM_WAIT() asm volatile("s_waitcnt vmcnt(0)" ::: "memory")
__device__ __forceinline__ unsigned long long rt() { return __builtin_amdgcn_s_memrealtime(); }
__device__ __forceinline__ unsigned f2bf(float f) { unsigned u = __builtin_bit_cast(unsigned, f); return (u + 0x7fffu + ((u >> 16) & 1u)) >> 16; }
__device__ __forceinline__ unsigned pk2(float lo, float hi) { return f2bf(lo) | (f2bf(hi) << 16); }

#define XB_TMO      128
#define XB_XCNT(j)  (256  + 64 * (j))
#define XB_XSUB(j)  (1280 + 64 * (j))
#define XB_XGEN(j)  (2304 + 64 * (j))
#define XB_TOP      3328
#define XB_TOPGEN   3392
#define XCD_BAR_WORDS 3456
#define XB_SPIN_CAP (1u << 24)

__device__ __forceinline__ unsigned xb_ld(unsigned* p)              { return __hip_atomic_load(p, __ATOMIC_RELAXED, __HIP_MEMORY_SCOPE_AGENT); }
__device__ __forceinline__ unsigned xb_add(unsigned* p, unsigned v) { return __hip_atomic_fetch_add(p, v, __ATOMIC_RELAXED, __HIP_MEMORY_SCOPE_AGENT); }
__device__ __forceinline__ unsigned xb_xcc_id() { return (unsigned)__builtin_amdgcn_s_getreg((3 << 11) | 20) & 0xFu; }
#define XB_SPIN(cond, bar) do { unsigned _sp = 0; while (cond) { __builtin_amdgcn_s_sleep(1); \
    if ((++_sp & 255u) == 0u) { if (xb_ld(&(bar)[XB_TMO])) break; if (_sp > XB_SPIN_CAP) { atomicAdd(&(bar)[XB_TMO], 1u); break; } } } } while (0)

struct XcdBarrier {
    unsigned* bar; unsigned x;
    volatile LAS unsigned* st;
};

__device__ __forceinline__ XcdBarrier xcd_barrier_post(unsigned* bar, volatile LAS unsigned* st) {
    XcdBarrier b; b.bar = bar; b.x = xb_xcc_id(); b.st = st;
    if (threadIdx.x == 0) (void)xb_add(&bar[XB_XCNT(b.x)], 1u);
    return b;
}
__device__ __forceinline__ void xcd_barrier_complete(unsigned* bar, unsigned x, unsigned& nloc, unsigned& nx) {
    const unsigned G = gridDim.x * gridDim.y * gridDim.z;
    unsigned sum, cnt, mine, sp = 0u;
    for (;;) {
        sum = 0u; cnt = 0u; mine = 0u;
#pragma unroll
        for (unsigned j = 0; j < 16; ++j) { const unsigned c = xb_ld(&bar[XB_XCNT(j)]); sum += c; cnt += (c > 0u) ? 1u : 0u; mine = (j == x) ? c : mine; }
        if (sum == G) break;
        __builtin_amdgcn_s_sleep(1);
        if ((++sp & 255u) == 0u) { if (xb_ld(&bar[XB_TMO])) break; if (sp > XB_SPIN_CAP) { atomicAdd(&bar[XB_TMO], 1u); break; } }
    }
    nloc = mine > 0u ? mine : 1u; nx = cnt > 0u ? cnt : 1u;
}

__device__ __forceinline__ void xcd_barrier(const XcdBarrier& b) {
    asm volatile("s_waitcnt vmcnt(0)" ::: "memory");
    __syncthreads();
    if (threadIdx.x == 0) {
        unsigned* bar = b.bar;
        __builtin_amdgcn_s_waitcnt(0);
        unsigned nloc = b.st[0], nx = b.st[1];
        if (nloc == 0u) { xcd_barrier_complete(bar, b.x, nloc, nx); b.st[0] = nloc; b.st[1] = nx; }
        const unsigned old = xb_add(&bar[XB_XSUB(b.x)], 1u);
        const unsigned gen = old / nloc;
        if (old + 1u == (gen + 1u) * nloc) {
            __builtin_amdgcn_fence(__ATOMIC_RELEASE, "agent");
            asm volatile("s_waitcnt vmcnt(0)" ::: "memory");
            const unsigned og = xb_add(&bar[XB_TOP], 1u);
            const unsigned tg = og / nx;
            if (og + 1u == (tg + 1u) * nx) xb_add(&bar[XB_TOPGEN], 1u);
            else XB_SPIN(xb_ld(&bar[XB_TOPGEN]) == tg, bar);
            __builtin_amdgcn_fence(__ATOMIC_ACQUIRE, "agent");
            xb_add(&bar[XB_XGEN(b.x)], 1u);
            asm volatile("s_waitcnt vmcnt(0)" ::: "memory");
        } else {
            XB_SPIN(xb_ld(&bar[XB_XGEN(b.x)]) == gen, bar);
            __builtin_amdgcn_fence(__ATOMIC_ACQUIRE, "agent");
            asm volatile("s_waitcnt vmcnt(0)" ::: "memory");
        }
    }
    __syncthreads();
}

constexpr int NWAVES = 8;
constexpr int BATCH = 4, SEQ = 2048, DM = 4096, M = BATCH * SEQ;
constexpr int HD = 128, NHA = 16, NKV = 4, GRP = 4, NHB = 16;
constexpr int CIN = 15408, NP = 15616;
constexpr int LDP = NP;
constexpr int C_QA = 0, C_ZA = 2048, C_KC = 4096, C_VC = 4608, C_KSL = 5120, C_VSL = 5632, C_KW = 6144, C_VW = 6656,
              C_QB = 7168, C_KB = 9216, C_VB = 11264, C_ZB = 13312, C_GA = 15360;
constexpr int NCMP = 127, NSEL = 32, TOPN = 16;
constexpr float EPS = 1e-6f;
constexpr float QSCALE = 0.08838834764831845f;

constexpr size_t MiB = 1u << 20;
constexpr size_t WS_CTL = 0, CTL_ZERO_BYTES = 1 * MiB;
constexpr size_t WS_WIN = 2 * MiB;
constexpr size_t WS_WOUT = 124 * MiB;
constexpr size_t WS_HB = 160 * MiB;
constexpr size_t WS_P = 224 * MiB;
constexpr size_t WS_QR = 468 * MiB;
constexpr size_t WS_COS = 500 * MiB;
constexpr size_t WS_SIN = 502 * MiB;
constexpr size_t WS_MIX = 504 * MiB;
constexpr size_t WS_Y = 568 * MiB;
constexpr size_t WS_KCMP = 696 * MiB;
constexpr size_t WS_VCMP = 697 * MiB;
constexpr size_t WS_BIAS1 = 698 * MiB;
constexpr size_t WS_SEL = 699 * MiB;
constexpr size_t WS_OC = 704 * MiB;
constexpr size_t WS_OS = 768 * MiB;
constexpr size_t WS_XKV = 832 * MiB;
constexpr size_t WS_WLR = 848 * MiB;
constexpr size_t WS_KCB = 852 * MiB;
constexpr size_t WS_VCB = 853 * MiB;
constexpr size_t WS_LR = WS_Y;
constexpr size_t WS_END = 854 * MiB;
constexpr int CW_BAR = 4096;

constexpr int RING_OFF = 0, RING_BYTES = 131072;
constexpr int LDSCTL_OFF = RING_BYTES, MISC_OFF = LDSCTL_OFF + 320;
constexpr int LDS_BYTES = 147456;

__device__ __forceinline__ float bf2f(unsigned short u) { return __builtin_bit_cast(float, (unsigned)u << 16); }
__device__ __forceinline__ float wave_sum(float v) {
#pragma unroll
    for (int o = 1; o < 64; o <<= 1) v += __shfl_xor(v, o);
    return v;
}
__device__ __forceinline__ float wave_max(float v) {
#pragma unroll
    for (int o = 1; o < 64; o <<= 1) v = fmaxf(v, __shfl_xor(v, o));
    return v;
}

struct Args {
    const float* x; const int* pos; const float* pre_w; const float* post_w; const float* w_in; const float* b_gate;
    const float* pe_k; const float* pe_v; const float* wk1; const float* wk2; const float* wv1; const float* wv2; const float* w_out;
    float* out; unsigned char* ws; int ph_lo, ph_hi;
};

struct Ctx {
    LAS unsigned char* lds; int tid, lane, wave, G, bid, gw, NGW;
};

__host__ __device__ __forceinline__ int rope_phi(int d) { const int dd = d & 63; return 32 * (dd >> 4) + 8 * ((dd >> 2) & 3) + 4 * (d >> 6) + (dd & 3); }
__device__ __forceinline__ void transpose_item(const float* W, int ldw, int K, int k0, int c0, int ncols, bf16* WT, int r0, LAS float* scr, int lane, bool perm = false) {
#pragma unroll 8
    for (int i = 0; i < 32; ++i) { const int kk = 2 * i + (lane >> 5), n = lane & 31; scr[kk * 33 + n] = (n < ncols) ? W[(size_t)(k0 + kk) * ldw + c0 + n] : 0.f; }
    LDS_WAIT(); asm volatile("" ::: "memory");
    const int c = lane & 7;
#pragma unroll
    for (int j = 0; j < 4; ++j) { const int n = (lane >> 3) + 8 * j; const LAS float* s = scr + (8 * c) * 33 + n;
        v4u o; o.x = pk2(s[0 * 33], s[1 * 33]); o.y = pk2(s[2 * 33], s[3 * 33]); o.z = pk2(s[4 * 33], s[5 * 33]); o.w = pk2(s[6 * 33], s[7 * 33]);
        const int drow = perm ? (r0 & ~127) + rope_phi((r0 & 127) + n) : r0 + n;
        if (n < ncols) *(GAS v4u*)(WT + (size_t)drow * K + k0 + 8 * c) = o; }
    LDS_WAIT(); asm volatile("" ::: "memory");
}

__device__ __forceinline__ void p0_transposes(const Args& a, const Ctx& c, int it0, int it1, int widx, int nw) {
    unsigned char* ws = a.ws;
    bf16* WinT = (bf16*)(ws + WS_WIN); bf16* WoutT = (bf16*)(ws + WS_WOUT);
    LAS float* scr = (LAS float*)(c.lds + RING_OFF + c.wave * 16384);
    constexpr int NB_IN = 482, I_IN = 64 * NB_IN, I_OUT = 64 * 128, I_LR = 4 * 32 * 8, I_ALL = I_IN + I_OUT + I_LR;
    bf16* WLR = (bf16*)(ws + WS_WLR);
    struct TItem { const float* src; bf16* dst; int ldw, K, ncols; bool perm; int r0; };
    auto decode = [&](int it) -> TItem {
        TItem t;
        if (it < I_IN) {
            const int kb = it / NB_IN, nb = it % NB_IN; int c0, r0, nc = 32;
            if (nb < 128) { c0 = nb * 32; r0 = nb * 32; }
            else if (nb < 224) { c0 = 4144 + (nb - 128) * 32; r0 = 4096 + (nb - 128) * 32; }
            else if (nb < 480) { c0 = 7216 + (nb - 224) * 32; r0 = 7168 + (nb - 224) * 32; }
            else { c0 = 4096 + (nb - 480) * 32; r0 = C_GA + (nb - 480) * 32; nc = (nb == 480) ? 32 : 16; }
            t.perm = (r0 < 2048) || (r0 >= C_KSL && r0 < C_VSL) || (r0 >= C_KW && r0 < C_VW) || (r0 >= C_QB && r0 < C_VB);
            t.src = a.w_in + (size_t)(kb * 64) * CIN + c0; t.ldw = CIN; t.K = DM; t.ncols = nc; t.dst = WinT + kb * 64; t.r0 = r0;
        } else if (it < I_IN + I_OUT) {
            const int r = it - I_IN, kb = r / 128, nb = r % 128;
            t.perm = false; t.src = a.w_out + (size_t)(kb * 64) * DM + nb * 32; t.ldw = DM; t.K = DM; t.ncols = 32; t.dst = WoutT + kb * 64; t.r0 = nb * 32;
        } else {
            const int r = it - I_IN - I_OUT, part = r >> 8, kb = (r >> 3) & 31, nb = r & 7;
            t.perm = false; t.src = ((part >> 1) ? a.wv1 : a.wk1) + (size_t)((part & 1) * 2048 + kb * 64) * 256 + nb * 32; t.ldw = 256; t.K = 2048; t.ncols = 32;
            t.dst = WLR + kb * 64; t.r0 = part * 256 + nb * 32;
        }
        return t;
    };
    {
        const int kr = c.lane >> 3, nq = (c.lane & 7) * 4;
        f32x4 v[8];
        int it = it0 + widx; bool have = it < it1; TItem cur{};
        if (have) { cur = decode(it);
#pragma unroll
            for (int i = 0; i < 8; ++i) v[i] = (nq < cur.ncols) ? __builtin_nontemporal_load((const GAS f32x4*)(cur.src + (size_t)(8 * i + kr) * cur.ldw + nq)) : (f32x4){0.f, 0.f, 0.f, 0.f}; }
        while (have) {
#pragma unroll
            for (int i = 0; i < 8; ++i) { LAS float* d = scr + (8 * i + kr) * 33 + nq; d[0] = v[i].x; d[1] = v[i].y; d[2] = v[i].z; d[3] = v[i].w; }
            const int nit = it + nw; const bool hn = nit < it1; TItem nx{};
            if (hn) { nx = decode(nit);
#pragma unroll
                for (int i = 0; i < 8; ++i) v[i] = (nq < nx.ncols) ? __builtin_nontemporal_load((const GAS f32x4*)(nx.src + (size_t)(8 * i + kr) * nx.ldw + nq)) : (f32x4){0.f, 0.f, 0.f, 0.f}; }
            LDS_WAIT(); asm volatile("" ::: "memory");
            const int cc = c.lane & 7;
#pragma unroll
            for (int j = 0; j < 4; ++j) { const int n = (c.lane >> 3) + 8 * j; const LAS float* sp = scr + (8 * cc) * 33 + n;
                v4u o; o.x = pk2(sp[0 * 33], sp[1 * 33]); o.y = pk2(sp[2 * 33], sp[3 * 33]); o.z = pk2(sp[4 * 33], sp[5 * 33]); o.w = pk2(sp[6 * 33], sp[7 * 33]);
                const int drow = cur.perm ? (cur.r0 & ~127) + rope_phi((cur.r0 & 127) + n) : cur.r0 + n;
                if (n < cur.ncols) *(GAS v4u*)(cur.dst + (size_t)drow * cur.K + 8 * cc) = o; }
            LDS_WAIT(); asm volatile("" ::: "memory");
            it = nit; have = hn; cur = nx;
        }
    }
}
constexpr int TI_IN = 64 * 482, TI_ALL = TI_IN + 64 * 128 + 4 * 32 * 8;

__device__ __forceinline__ void p0_prologue(const Args& a, const Ctx& c) {
    unsigned char* ws = a.ws;
    bf16* WinT = (bf16*)(ws + WS_WIN); bf16* HB = (bf16*)(ws + WS_HB);
    p0_transposes(a, c, 0, TI_IN, c.gw, c.NGW);
    for (int e = c.gw * 64 + c.lane; e < (NP - CIN) * (DM / 8); e += c.NGW * 64)
        *(GAS v4u*)(WinT + (size_t)CIN * DM + (size_t)e * 8) = (v4u){0u, 0u, 0u, 0u};
    for (int m = c.gw; m < M; m += c.NGW) {
        const GAS f32x4* xr = (const GAS f32x4*)(a.x + (size_t)m * DM) + c.lane;
        f32x4 v[16]; float s = 0.f;
#pragma unroll
        for (int j = 0; j < 16; ++j) { v[j] = __builtin_nontemporal_load(xr + 64 * j); s += (v[j].x * v[j].x + v[j].y * v[j].y) + (v[j].z * v[j].z + v[j].w * v[j].w); }
        const float rstd = 1.0f / sqrtf(wave_sum(s) * (1.0f / DM) + EPS);
        GAS unsigned long long* o8 = (GAS unsigned long long*)(HB + (size_t)m * DM) + c.lane;
#pragma unroll
        for (int j = 0; j < 16; ++j) { const f32x4 w = ((const GAS f32x4*)a.pre_w)[c.lane + 64 * j];
            o8[64 * j] = (unsigned long long)pk2(v[j].x * rstd * w.x, v[j].y * rstd * w.y) | ((unsigned long long)pk2(v[j].z * rstd * w.z, v[j].w * rstd * w.w) << 32); }
    }
    {
        float* COS = (float*)(ws + WS_COS); float* SIN = (float*)(ws + WS_SIN);
        for (int e = c.gw * 64 + c.lane; e < M * 64; e += c.NGW * 64) {
            const int m = e >> 6, i = e & 63;
            double inv = 1.0; for (int k = 0; k < i; ++k) inv *= 0.8659643233600653;
            const double ang = (double)a.pos[m] * inv;
            const double TWO_PI = 6.283185307179586476925286766559;
            const double n = __builtin_rint(ang / TWO_PI);
            const double r = ang - n * TWO_PI;
            const double r2 = r * r;
            double sn = 0.0, cs = 0.0;
            double ts = r, tc = 1.0;
#pragma unroll
            for (int k = 0; k < 14; ++k) { sn += ts; cs += tc; ts *= -r2 / (double)((2 * k + 2) * (2 * k + 3)); tc *= -r2 / (double)((2 * k + 1) * (2 * k + 2)); }
            COS[e] = (float)cs; SIN[e] = (float)sn;
        }
    }
    {
        float* BP = (float*)(ws + WS_BIAS1);
        for (int o = c.gw; o < 128; o += c.NGW) {
            const int kv = o >> 6, ch = o & 63; const float* pe = (kv ? a.pe_v : a.pe_k) + ch * 64; const float* w1 = (kv ? a.wv1 : a.wk1) + (size_t)ch * 64 * 256;
            float s0 = 0.f, s1 = 0.f, s2 = 0.f, s3 = 0.f;
            for (int i = 0; i < 64; ++i) { const float p = pe[i]; const float* wr = w1 + i * 256 + c.lane; s0 += p * wr[0]; s1 += p * wr[64]; s2 += p * wr[128]; s3 += p * wr[192]; }
            float* d = BP + (size_t)o * 256 + c.lane; d[0] = s0; d[64] = s1; d[128] = s2; d[192] = s3;
        }
    }
}

__device__ __forceinline__ float gelu_tanh(float x) {
    const float u = 0.7978845608028654f * (x + 0.044715f * x * x * x);
    const float e = __expf(2.0f * u);
    const float th = 1.0f - 2.0f / (e + 1.0f);
    return 0.5f * x * (1.0f + th);
}

__device__ __forceinline__ void p2c_stage2(const Args& a, const Ctx& c) {
    unsigned char* ws = a.ws;
    const float* LR = (const float*)(ws + WS_LR); const float* B1 = (const float*)(ws + WS_BIAS1);
    LAS float* Gs = (LAS float*)(c.lds + RING_OFF);
    bf16* KCB = (bf16*)(ws + WS_KCB); bf16* VCB = (bf16*)(ws + WS_VCB);
    for (int e = c.gw * 64 + c.lane; e < 2 * 16 * 128; e += c.NGW * 64) { bf16* dst = (e >> 11) ? VCB : KCB; dst[(size_t)((e >> 7) & 15) * 128 * 128 + 127 * 128 + (e & 127)] = 0; }
    for (int it = c.bid; it < 2 * 127; it += c.G) {
        const int kv = it / 127, rb = it % 127;
        const float* w2 = kv ? a.wv2 : a.wk2;
        float* OUT = (float*)(ws + (kv ? WS_VCMP : WS_KCMP)); bf16* OUTB = kv ? VCB : KCB;
        const int n = c.tid & 255, half = c.tid >> 8;
        float b1 = 0.f;
        for (int ch = 0; ch < 64; ++ch) b1 += B1[(size_t)(kv * 64 + ch) * 256 + n];
        __syncthreads();
#pragma unroll
        for (int r = 0; r < 8; ++r) { const int R = rb * 16 + half * 8 + r, bh = R / 127, cc = R % 127; const size_t rowL = (size_t)kv * 2048 + bh * 128 + cc;
            float h = b1;
#pragma unroll
            for (int ks = 0; ks < 8; ++ks) { const float* p = LR + (size_t)ks * 4096 * 1024 + rowL * 1024 + kv * 512 + n; h += p[0] + p[1024 + 256]; }
            Gs[(half * 8 + r) * 256 + n] = gelu_tanh(h); }
        __syncthreads();
        const int d = c.tid & 127, rq = c.tid >> 7;
        float o[4] = {0.f, 0.f, 0.f, 0.f};
        for (int nn = 0; nn < 256; ++nn) { const float w = w2[nn * 128 + d];
#pragma unroll
            for (int r = 0; r < 4; ++r) o[r] += Gs[(rq * 4 + r) * 256 + nn] * w; }
#pragma unroll
        for (int r = 0; r < 4; ++r) { const int R = rb * 16 + rq * 4 + r, bh = R / 127, cc = R % 127; const int dd = kv ? d : rope_phi(d);
            OUT[(size_t)(bh * 128 + cc) * 128 + dd] = o[r]; OUTB[(size_t)(bh * 128 + cc) * 128 + dd] = (bf16)f2bf(o[r]); }
    }
}

namespace fa {
typedef short s16x4 __attribute__((ext_vector_type(4)));
typedef float f32x16 __attribute__((ext_vector_type(16)));
typedef unsigned u32x4 __attribute__((ext_vector_type(4)));
constexpr int KVBLK = 64, SHM_K = KVBLK * 128 * 2, SHM_V = SHM_K;
constexpr int A_V = 0, A_K = 2 * SHM_V, A_WS = 2 * SHM_V + 2 * SHM_K;
constexpr float SCALE = 0.08838834764831845f, THR = 8.f;
constexpr float C2 = 1.4426950408889634f * SCALE;
constexpr float DBL = 1.0f / C2;
#define FA_KSWZ(row, colB) ((row) * 256 + ((colB) ^ (((row) & 7) << 4)))
#define FA_SBAR() __builtin_amdgcn_sched_barrier(0)
__device__ __forceinline__ int v_st(int k, int c) { const int kk = (k & ~0xC) | ((k & 4) << 1) | ((k & 8) >> 1); return ((kk >> 3) * 4 + (c >> 5)) * 512 + ((kk & 7) * 32 + (c & 31)) * 2; }
__device__ __forceinline__ int v_rd_base(int lane) { return ((lane & 3) << 3) | (((lane >> 2) & 3) << 6) | (((lane >> 4) & 1) << 5) | (((lane >> 5) & 1) << 8); }
constexpr int v_rd_off(int d0, int ks, int half) { return d0 * 512 + ks * 4096 + half * 2048; }
__device__ __forceinline__ int crow(int r, int hi) { return (r & 3) + 8 * (r >> 2) + 4 * hi; }
__device__ __forceinline__ unsigned cvtpk(float lo, float hi) { unsigned r; asm volatile("v_cvt_pk_bf16_f32 %0, %1, %2" : "=v"(r) : "v"(lo), "v"(hi)); return r; }

__device__ __forceinline__ void mask_tile(f32x16& p0, f32x16& p1, int dq, unsigned W) {
    const float NEG = -__builtin_inff();
#pragma unroll
    for (int r = 0; r < 16; ++r) {
        const int c = (r & 3) + 8 * (r >> 2);
        if ((unsigned)(dq - c) >= W) p0[r] = NEG;
        if ((unsigned)(dq - c - 32) >= W) p1[r] = NEG;
    }
}
__device__ __forceinline__ void mask_dil(f32x16& p0, f32x16& p1, int dq) {
    const float NEG = -__builtin_inff();
#pragma unroll
    for (int r = 0; r < 16; ++r) {
        const int c = (r & 3) + 8 * (r >> 2);
        { const int dl = dq - c; const bool nr = (unsigned)dl <= 128u, m4 = dl >= 0 && (dl & 3) == 0; const float v = p0[r];
          p0[r] = nr ? (m4 ? v + DBL : v) : (m4 ? v : NEG); }
        { const int dl = dq - c - 32; const bool nr = (unsigned)dl <= 128u, m4 = dl >= 0 && (dl & 3) == 0; const float v = p1[r];
          p1[r] = nr ? (m4 ? v + DBL : v) : (m4 ? v : NEG); }
    }
}
__device__ __forceinline__ void partialSM(f32x16& p0, f32x16& p1, float& m_reg, float& mn, float& alpha, bool drop) {
    float pmax = p0[0];
#pragma unroll
    for (int r = 1; r < 16; ++r) pmax = fmaxf(pmax, p0[r]);
#pragma unroll
    for (int r = 0; r < 16; ++r) pmax = fmaxf(pmax, p1[r]);
    { auto rr = __builtin_amdgcn_permlane32_swap(__float_as_uint(pmax), __float_as_uint(pmax), false, false);
      pmax = fmaxf(__uint_as_float(rr[0]), __uint_as_float(rr[1])); }
    if (drop) pmax = -__builtin_inff();
    if (__builtin_expect(__all((pmax - m_reg) * SCALE <= THR), 1)) { mn = m_reg; alpha = 1.f; }
    else { mn = fmaxf(m_reg, pmax); alpha = __builtin_amdgcn_exp2f((m_reg - mn) * C2); m_reg = mn; }
    const float mnL = drop ? -__builtin_inff() : -mn * C2;
#pragma unroll
    for (int r = 0; r < 16; ++r) p0[r] = fmaf(p0[r], C2, mnL);
#pragma unroll
    for (int r = 0; r < 16; ++r) p1[r] = fmaf(p1[r], C2, mnL);
#pragma unroll
    for (int r = 0; r < 16; ++r) p0[r] = __builtin_amdgcn_exp2f(p0[r]);
}
__device__ __forceinline__ void finishSM(f32x16& p0, f32x16& p1, float alpha, float& l_reg, bf16x8& pa0, bf16x8& pa1, bf16x8& pa2, bf16x8& pa3) {
#pragma unroll
    for (int r = 0; r < 16; ++r) p1[r] = __builtin_amdgcn_exp2f(p1[r]);
    float ps = 0;
#pragma unroll
    for (int r = 0; r < 16; ++r) ps += p0[r];
#pragma unroll
    for (int r = 0; r < 16; ++r) ps += p1[r];
    { auto rr = __builtin_amdgcn_permlane32_swap(__float_as_uint(ps), __float_as_uint(ps), false, false);
      ps = __uint_as_float(rr[0]) + __uint_as_float(rr[1]); }
    l_reg = l_reg * alpha + ps;
#define FA_PK4(P, B_, OUT) do { unsigned a0 = cvtpk(P[B_+0], P[B_+1]), a1 = cvtpk(P[B_+2], P[B_+3]);                          \
        unsigned b0 = cvtpk(P[B_+4], P[B_+5]), b1 = cvtpk(P[B_+6], P[B_+7]);                                             \
        auto r0 = __builtin_amdgcn_permlane32_swap(a0, b0, false, false); auto r1 = __builtin_amdgcn_permlane32_swap(a1, b1, false, false); \
        u32x4 w = {r0[0], r1[0], r0[1], r1[1]}; OUT = __builtin_bit_cast(bf16x8, w); } while (0)
    FA_PK4(p0, 0, pa0); FA_PK4(p0, 8, pa1); FA_PK4(p1, 0, pa2); FA_PK4(p1, 8, pa3);
#undef FA_PK4
}
__device__ __forceinline__ void pack_p(const f32x16& p0, const f32x16& p1, bf16x8& pa0, bf16x8& pa1, bf16x8& pa2, bf16x8& pa3) {
#define FA_PK4(P, B_, OUT) do { unsigned a0 = cvtpk(P[B_+0], P[B_+1]), a1 = cvtpk(P[B_+2], P[B_+3]);                          \
        unsigned b0 = cvtpk(P[B_+4], P[B_+5]), b1 = cvtpk(P[B_+6], P[B_+7]);                                             \
        auto r0 = __builtin_amdgcn_permlane32_swap(a0, b0, false, false); auto r1 = __builtin_amdgcn_permlane32_swap(a1, b1, false, false); \
        u32x4 w = {r0[0], r1[0], r0[1], r1[1]}; OUT = __builtin_bit_cast(bf16x8, w); } while (0)
    FA_PK4(p0, 0, pa0); FA_PK4(p0, 8, pa1); FA_PK4(p1, 0, pa2); FA_PK4(p1, 8, pa3);
#undef FA_PK4
}
template <int KB>
__device__ __forceinline__ void qkt(f32x16& p0, f32x16& p1, const LAS char* K_lds, int r32, int hi, const bf16x8 (&qr)[8]) {
#pragma unroll
    for (int r = 0; r < 16; ++r) { p0[r] = 0.f; p1[r] = 0.f; }
    const LAS char* kb[4];
#pragma unroll
    for (int dd = 0; dd < 4; ++dd) kb[dd] = K_lds + KB * SHM_K + FA_KSWZ(r32, (dd * 16 + hi * 8) * 2);
#pragma unroll
    for (int d0 = 0; d0 < 8; ++d0) { const LAS char* a = kb[d0 & 3] + (d0 >> 2) * 128;
        const bf16x8 b0 = *(const LAS bf16x8*)a;
        const bf16x8 b1 = *(const LAS bf16x8*)(a + 32 * 256);
        p0 = __builtin_amdgcn_mfma_f32_32x32x16_bf16(b0, qr[d0], p0, 0, 0, 0);
        p1 = __builtin_amdgcn_mfma_f32_32x32x16_bf16(b1, qr[d0], p1, 0, 0, 0); }
}
template <int VB>
__device__ __forceinline__ void pv_tile(f32x16 (&o)[4], int vb0, bf16x8 pa0, bf16x8 pa1, bf16x8 pa2, bf16x8 pa3) {
#define FA_TRRD(dst, off) asm volatile("ds_read_b64_tr_b16 %0, %1 offset:%2" : "=&v"(dst) : "v"(vb0), "i"(off) : "memory")
#define FA_PV_D0(d0) do { s16x4 l0, l1, l2, l3, h0, h1, h2, h3; constexpr int b_ = A_V + VB * SHM_V + v_rd_off(d0, 0, 0); \
        FA_TRRD(l0, b_); FA_TRRD(h0, b_ + 2048); FA_TRRD(l1, b_ + 4096); FA_TRRD(h1, b_ + 6144); FA_TRRD(l2, b_ + 8192); FA_TRRD(h2, b_ + 10240); FA_TRRD(l3, b_ + 12288); FA_TRRD(h3, b_ + 14336); \
        asm volatile("s_waitcnt lgkmcnt(0)" ::: "memory"); FA_SBAR(); \
        o[d0] = __builtin_amdgcn_mfma_f32_32x32x16_bf16(pa0, (bf16x8){l0[0], l0[1], l0[2], l0[3], h0[0], h0[1], h0[2], h0[3]}, o[d0], 0, 0, 0);   \
        o[d0] = __builtin_amdgcn_mfma_f32_32x32x16_bf16(pa1, (bf16x8){l1[0], l1[1], l1[2], l1[3], h1[0], h1[1], h1[2], h1[3]}, o[d0], 0, 0, 0);   \
        o[d0] = __builtin_amdgcn_mfma_f32_32x32x16_bf16(pa2, (bf16x8){l2[0], l2[1], l2[2], l2[3], h2[0], h2[1], h2[2], h2[3]}, o[d0], 0, 0, 0);   \
        o[d0] = __builtin_amdgcn_mfma_f32_32x32x16_bf16(pa3, (bf16x8){l3[0], l3[1], l3[2], l3[3], h3[0], h3[1], h3[2], h3[3]}, o[d0], 0, 0, 0); } while (0)
    FA_PV_D0(0); FA_PV_D0(1); FA_PV_D0(2); FA_PV_D0(3);
#undef FA_PV_D0
#undef FA_TRRD
}

__device__ __forceinline__ void mask_half(f32x16& p, int dq, unsigned W) {
    const float NEG = -__builtin_inff();
#pragma unroll
    for (int r = 0; r < 16; ++r) { const int c = (r & 3) + 8 * (r >> 2); if ((unsigned)(dq - c) >= W) p[r] = NEG; }
}
__device__ __forceinline__ void mask_dil_half(f32x16& p, int dq) {
    const float NEG = -__builtin_inff();
#pragma unroll
    for (int r = 0; r < 16; ++r) { const int c = (r & 3) + 8 * (r >> 2); const int dl = dq - c; const bool nr = (unsigned)dl <= 128u, m4 = dl >= 0 && (dl & 3) == 0; const float v = p[r];
        p[r] = nr ? (m4 ? v + DBL : v) : (m4 ? v : NEG); }
}
template <int KB, int H>
__device__ __forceinline__ void qk_half(f32x16& p, const LAS char* K_lds, int r32, int hi, const bf16x8 (&qr)[8]) {
#pragma unroll
    for (int r = 0; r < 16; ++r) p[r] = 0.f;
    const LAS char* kb[4];
#pragma unroll
    for (int dd = 0; dd < 4; ++dd) kb[dd] = K_lds + KB * SHM_K + H * 32 * 256 + FA_KSWZ(r32, (dd * 16 + hi * 8) * 2);
#pragma unroll
    for (int d0 = 0; d0 < 8; ++d0) { const bf16x8 b0 = *(const LAS bf16x8*)(kb[d0 & 3] + (d0 >> 2) * 128); p = __builtin_amdgcn_mfma_f32_32x32x16_bf16(b0, qr[d0], p, 0, 0, 0); }
}
template <int KB, int H>
__device__ __forceinline__ void k_reads(const LAS char* K_lds, int r32, int hi, bf16x8 (&kf)[8]) {
    const unsigned a0 = (unsigned)(uintptr_t)(K_lds + KB * SHM_K + FA_KSWZ(r32, (0 * 16 + hi * 8) * 2)), a1 = (unsigned)(uintptr_t)(K_lds + KB * SHM_K + FA_KSWZ(r32, (1 * 16 + hi * 8) * 2)),
                   a2 = (unsigned)(uintptr_t)(K_lds + KB * SHM_K + FA_KSWZ(r32, (2 * 16 + hi * 8) * 2)), a3 = (unsigned)(uintptr_t)(K_lds + KB * SHM_K + FA_KSWZ(r32, (3 * 16 + hi * 8) * 2));
#define FA_KRD(dst, ad, off) asm volatile("ds_read_b128 %0, %1 offset:%2" : "=&v"(dst) : "v"(ad), "i"(off) : "memory")
    FA_KRD(kf[0], a0, H * 8192); FA_KRD(kf[1], a1, H * 8192); FA_KRD(kf[2], a2, H * 8192); FA_KRD(kf[3], a3, H * 8192);
    FA_KRD(kf[4], a0, H * 8192 + 128); FA_KRD(kf[5], a1, H * 8192 + 128); FA_KRD(kf[6], a2, H * 8192 + 128); FA_KRD(kf[7], a3, H * 8192 + 128);
#undef FA_KRD
}
__device__ __forceinline__ void qk_mma(f32x16& p, const bf16x8 (&kf)[8], const bf16x8 (&qr)[8]) {
#pragma unroll
    for (int r = 0; r < 16; ++r) p[r] = 0.f;
#pragma unroll
    for (int d0 = 0; d0 < 8; ++d0) p = __builtin_amdgcn_mfma_f32_32x32x16_bf16(kf[d0], qr[d0], p, 0, 0, 0);
}
__device__ __forceinline__ float sm_max(const f32x16& p, float& m_reg, bool drop, float& mnL) {
    float pmax = p[0];
#pragma unroll
    for (int r = 1; r < 16; ++r) pmax = fmaxf(pmax, p[r]);
    { auto rr = __builtin_amdgcn_permlane32_swap(__float_as_uint(pmax), __float_as_uint(pmax), false, false); pmax = fmaxf(__uint_as_float(rr[0]), __uint_as_float(rr[1])); }
    if (drop) pmax = -__builtin_inff();
    const bool keep = __all((pmax - m_reg) * SCALE <= THR);
    const float mn = keep ? m_reg : fmaxf(m_reg, pmax);
    const float alpha = __builtin_amdgcn_exp2f((m_reg - mn) * C2);
    m_reg = mn; mnL = drop ? -__builtin_inff() : -mn * C2;
    return alpha;
}
__device__ __forceinline__ void sm_exp(f32x16& p, float mnL, float alpha, float& l_reg, bf16x8& paA, bf16x8& paB) {
    float ps = 0.f;
#pragma unroll
    for (int r = 0; r < 16; ++r) { p[r] = __builtin_amdgcn_exp2f(fmaf(p[r], C2, mnL)); ps += p[r]; }
    { auto rr = __builtin_amdgcn_permlane32_swap(__float_as_uint(ps), __float_as_uint(ps), false, false); ps = __uint_as_float(rr[0]) + __uint_as_float(rr[1]); }
    l_reg = l_reg * alpha + ps;
#define FA_PK4(P, B_, OUT) do { unsigned a0 = cvtpk(P[B_+0], P[B_+1]), a1 = cvtpk(P[B_+2], P[B_+3]);                          \
        unsigned b0 = cvtpk(P[B_+4], P[B_+5]), b1 = cvtpk(P[B_+6], P[B_+7]);                                             \
        auto r0 = __builtin_amdgcn_permlane32_swap(a0, b0, false, false); auto r1 = __builtin_amdgcn_permlane32_swap(a1, b1, false, false); \
        u32x4 w = {r0[0], r1[0], r0[1], r1[1]}; OUT = __builtin_bit_cast(bf16x8, w); } while (0)
    FA_PK4(p, 0, paA); FA_PK4(p, 8, paB);
#undef FA_PK4
}
template <int VB, int H, int D0A = 0, int D0B = 4>
__device__ __forceinline__ void pv_reads(int vb0, s16x4 (&vl)[8], s16x4 (&vh)[8]) {
#define FA_TRRD(dst, off) asm volatile("ds_read_b64_tr_b16 %0, %1 offset:%2" : "=&v"(dst) : "v"(vb0), "i"(off) : "memory")
#define FA_RD_D0(d0) do { constexpr int b_ = A_V + VB * SHM_V + v_rd_off(d0, 2 * H, 0); \
        FA_TRRD(vl[2 * d0], b_); FA_TRRD(vh[2 * d0], b_ + 2048); FA_TRRD(vl[2 * d0 + 1], b_ + 4096); FA_TRRD(vh[2 * d0 + 1], b_ + 6144); } while (0)
    if constexpr (D0A <= 0 && 0 < D0B) FA_RD_D0(0); if constexpr (D0A <= 1 && 1 < D0B) FA_RD_D0(1); if constexpr (D0A <= 2 && 2 < D0B) FA_RD_D0(2); if constexpr (D0A <= 3 && 3 < D0B) FA_RD_D0(3);
#undef FA_RD_D0
#undef FA_TRRD
}
__device__ __forceinline__ void pv_mma(f32x16 (&o)[4], const s16x4 (&vl)[8], const s16x4 (&vh)[8], bf16x8 paA, bf16x8 paB) {
#pragma unroll
    for (int d0 = 0; d0 < 4; ++d0) {
        o[d0] = __builtin_amdgcn_mfma_f32_32x32x16_bf16(paA, (bf16x8){vl[2 * d0][0], vl[2 * d0][1], vl[2 * d0][2], vl[2 * d0][3], vh[2 * d0][0], vh[2 * d0][1], vh[2 * d0][2], vh[2 * d0][3]}, o[d0], 0, 0, 0);
        o[d0] = __builtin_amdgcn_mfma_f32_32x32x16_bf16(paB, (bf16x8){vl[2 * d0 + 1][0], vl[2 * d0 + 1][1], vl[2 * d0 + 1][2], vl[2 * d0 + 1][3], vh[2 * d0 + 1][0], vh[2 * d0 + 1][1], vh[2 * d0 + 1][2], vh[2 * d0 + 1][3]}, o[d0], 0, 0, 0); }
}

struct St { float m, l; f32x16 o[4]; };
__device__ __forceinline__ void st_init(St& S) { S.m = -1e30f; S.l = 0.f;
#pragma unroll
    for (int d = 0; d < 4; ++d)
#pragma unroll
        for (int r = 0; r < 16; ++r) S.o[d][r] = 0.f; }

struct MaskWin { int qlo, qm;
    __device__ __forceinline__ bool act(int t) const { const int kb = t * 64; return kb <= qlo + 31 && kb + 63 >= qlo - 511; }
    __device__ __forceinline__ void apply(f32x16& p0, f32x16& p1, int t) const { const int kb = t * 64; if (kb + 63 > qlo || kb <= qlo + 31 - 512) mask_tile(p0, p1, qm - kb, 512u); }
    __device__ __forceinline__ bool needs_mask(int t) const { const int kb = t * 64; return kb + 63 > qlo || kb <= qlo + 31 - 512; }
    __device__ __forceinline__ void apply_half(f32x16& p, int t, int H) const { mask_half(p, qm - t * 64 - 32 * H, 512u); }
    __device__ __forceinline__ bool drop(int) const { return false; } };
struct MaskSel { int qlo, qm; unsigned selw;
    __device__ __forceinline__ bool act(int t) const { return t * 64 <= qlo + 31; }
    __device__ __forceinline__ void apply(f32x16& p0, f32x16& p1, int t) const { const int kb = t * 64; if (kb + 63 > qlo) mask_tile(p0, p1, qm - kb, 0x40000000u); }
    __device__ __forceinline__ bool needs_mask(int t) const { return t * 64 + 63 > qlo; }
    __device__ __forceinline__ void apply_half(f32x16& p, int t, int H) const { mask_half(p, qm - t * 64 - 32 * H, 0x40000000u); }
    __device__ __forceinline__ bool drop(int t) const { return ((selw >> t) & 1u) == 0u; } };
struct MaskDilA { int plo, pm;
    __device__ __forceinline__ bool act(int t) const { return t * 64 <= plo + 31; }
    __device__ __forceinline__ void apply(f32x16& p0, f32x16& p1, int t) const { mask_dil(p0, p1, pm - t * 64); }
    __device__ __forceinline__ bool needs_mask(int) const { return true; }
    __device__ __forceinline__ void apply_half(f32x16& p, int t, int H) const { mask_dil_half(p, pm - t * 64 - 32 * H); }
    __device__ __forceinline__ bool drop(int) const { return false; } };
struct MaskDilB { int tlo, tm;
    __device__ __forceinline__ bool act(int t) const { const int kb = t * 64; return kb <= tlo + 124 && kb + 63 >= tlo - 128; }
    __device__ __forceinline__ void apply(f32x16& p0, f32x16& p1, int t) const { mask_tile(p0, p1, tm - t * 64, 129u); }
    __device__ __forceinline__ bool needs_mask(int) const { return true; }
    __device__ __forceinline__ void apply_half(f32x16& p, int t, int H) const { mask_half(p, tm - t * 64 - 32 * H, 129u); }
    __device__ __forceinline__ bool drop(int) const { return false; } };

template <class MK>
__device__ __forceinline__ void attn_pass(St& S, const bf16x8 (&qr)[8], const bf16* Kg, const bf16* Vg, int pitch, int t0, int t1, LAS char* lds, const MK& mk, int tid, int wid, int lane) {
    if (t0 >= t1) return;
    const int r32 = lane & 31, hi = lane >> 5;
    const int sr = tid >> 4, sc = (tid & 15) * 8;
    const int kws = FA_KSWZ(sr, sc * 2), vst0 = v_st(sr, sc), vst1 = v_st(32 + sr, sc);
    LAS char* V_lds = lds + A_V; LAS char* K_lds = lds + A_K;
    LAS float* al_l = (LAS float*)(lds + A_WS) + wid * 64 + 32;
    const int vb0 = (int)(unsigned)(uintptr_t)lds + v_rd_base(lane);
    bf16x8 st_k0, st_k1, st_v0, st_v1;
    const unsigned lo_ = (unsigned)(sr * pitch + sc);
#define FA_SLOAD(t) do { const bf16* kt_ = Kg + (size_t)((t) * 64) * pitch; const bf16* vt_ = Vg + (size_t)((t) * 64) * pitch; \
        st_k0 = *(const GAS bf16x8*)(kt_ + lo_); st_k1 = *(const GAS bf16x8*)(kt_ + (size_t)32 * pitch + lo_); \
        st_v0 = *(const GAS bf16x8*)(vt_ + lo_); st_v1 = *(const GAS bf16x8*)(vt_ + (size_t)32 * pitch + lo_); } while (0)
#define FA_SWRITE(bf) do { *(LAS bf16x8*)(K_lds + (bf) * SHM_K + kws) = st_k0; *(LAS bf16x8*)(K_lds + (bf) * SHM_K + kws + 32 * 256) = st_k1; \
        *(LAS bf16x8*)(V_lds + (bf) * SHM_V + vst0) = st_v0; *(LAS bf16x8*)(V_lds + (bf) * SHM_V + vst1) = st_v1; } while (0)
#define FA_RESC(al_) do { if (__any((al_) < 1.f)) { if (hi == 0) al_l[r32] = (al_); asm volatile("s_waitcnt lgkmcnt(0)" ::: "memory"); \
            _Pragma("unroll") for (int d_ = 0; d_ < 4; ++d_) _Pragma("unroll") for (int r = 0; r < 16; ++r) S.o[d_][r] *= al_l[crow(r, hi)]; \
            asm volatile("s_waitcnt lgkmcnt(0)" ::: "memory"); } } while (0)
#define FA_LWAIT() do { asm volatile("s_waitcnt lgkmcnt(0)" ::: "memory"); FA_SBAR(); } while (0)
#define FA_BODY(t, B) do { f32x16 p0, p1; bf16x8 pa0, pa1, pa2, pa3; float mnL0, mnL1; const bool dr_ = mk.drop(t), nm_ = mk.needs_mask(t); \
            { bf16x8 kfa[8], kfb[8]; k_reads<B, 0>(K_lds, r32, hi, kfa); FA_LWAIT(); \
              k_reads<B, 1>(K_lds, r32, hi, kfb); qk_mma(p0, kfa, qr); FA_LWAIT(); \
              if (nm_) mk.apply_half(p0, (t), 0); \
              s16x4 vl[8], vh[8]; pv_reads<B, 0, 0, 2>(vb0, vl, vh); \
              qk_mma(p1, kfb, qr); const float al0 = sm_max(p0, S.m, dr_, mnL0); sm_exp(p0, mnL0, al0, S.l, pa0, pa1); \
              FA_SBAR(); pv_reads<B, 0, 2, 4>(vb0, vl, vh); FA_LWAIT(); FA_RESC(al0); FA_SBAR(); \
              if (nm_) mk.apply_half(p1, (t), 1); \
              pv_mma(S.o, vl, vh, pa0, pa1); const float al1 = sm_max(p1, S.m, dr_, mnL1); sm_exp(p1, mnL1, al1, S.l, pa2, pa3); \
              FA_SBAR(); FA_RESC(al1); \
              pv_reads<B, 1>(vb0, vl, vh); FA_LWAIT(); \
              pv_mma(S.o, vl, vh, pa2, pa3); } } while (0)
#define FA_STEP(t, B) do { const bool more_ = (t) + 1 < t1; \
        if (more_) FA_SLOAD((t) + 1); \
        if (mk.act(t)) { FA_BODY(t, B); } \
        if (more_) { asm volatile("s_waitcnt vmcnt(0)" ::: "memory"); FA_SWRITE((B) ^ 1); } \
        __syncthreads(); } while (0)
    FA_SLOAD(t0); asm volatile("s_waitcnt vmcnt(0)" ::: "memory"); FA_SWRITE(0); __syncthreads();
    for (int t = t0; t < t1; t += 2) {
        FA_STEP(t, 0);
        if (t + 1 < t1) FA_STEP(t + 1, 1);
    }
#undef FA_STEP
#undef FA_BODY
#undef FA_LWAIT
#undef FA_RESC
#undef FA_SWRITE
#undef FA_SLOAD
}
__device__ __forceinline__ void row_factors(float f, float (&rli)[16], LAS char* lds, int wid, int r32, int hi) {
    LAS float* li_l = (LAS float*)(lds + A_WS) + wid * 64;
    if (hi == 0) li_l[r32] = f;
    asm volatile("s_waitcnt lgkmcnt(0)" ::: "memory");
#pragma unroll
    for (int r = 0; r < 16; ++r) rli[r] = li_l[crow(r, hi)];
    asm volatile("s_waitcnt lgkmcnt(0)" ::: "memory");
}
template <int HALF>
__device__ __forceinline__ void stage_half(const f32x16 (&o)[4], const float (&rli)[16], LAS float* st, int r32, int hi, int lane, f32x4 (&lo)[4], f32x4 (&hh)[4]) {
    asm volatile("s_waitcnt lgkmcnt(0)" ::: "memory");
#pragma unroll
    for (int r = 0; r < 16; ++r) { const int row = crow(r, hi); st[row * 68 + r32] = o[2 * HALF][r] * rli[r]; st[row * 68 + 32 + r32] = o[2 * HALF + 1][r] * rli[r]; }
    asm volatile("s_waitcnt lgkmcnt(0)" ::: "memory");
#pragma unroll
    for (int q = 0; q < 4; ++q) { const int idx = q * 64 + lane; const LAS float* p = st + (idx >> 3) * 68 + 8 * (idx & 7); lo[q] = *(const LAS f32x4*)p; hh[q] = *(const LAS f32x4*)(p + 4); }
    asm volatile("s_waitcnt lgkmcnt(0)" ::: "memory");
}
__device__ __forceinline__ float bflo(unsigned w) { return __builtin_bit_cast(float, w << 16); }
__device__ __forceinline__ float bfhi(unsigned w) { return __builtin_bit_cast(float, w & 0xffff0000u); }
__device__ __forceinline__ float silu_mul(float v, float z) { return v * z / (1.0f + __expf(-z)); }
}

__device__ __forceinline__ float sigm(float x) { return 1.0f / (1.0f + __expf(-x)); }

__device__ __forceinline__ void nsa_block(const Args& a, const Ctx& c, int b, int h, int qb) {
    unsigned char* ws = a.ws;
    const bf16* P = (const bf16*)(ws + WS_P); const bf16* QR = (const bf16*)(ws + WS_QR);
    const bf16* OC = (const bf16*)(ws + WS_OC); bf16* OS = (bf16*)(ws + WS_OS); const unsigned* SEL = (const unsigned*)(ws + WS_SEL);
    bf16* MIX = (bf16*)(ws + WS_MIX);
    LAS char* lds = (LAS char*)(c.lds + RING_OFF);
    int lane = c.lane, tid = c.tid; asm volatile("" : "+v"(lane), "+v"(tid));
    const int hk = h >> 2, r32 = lane & 31, hi = lane >> 5;
    const int qlo = qb * 256 + c.wave * 32, t_row = qlo + r32, m0 = b * SEQ + qlo;
    bf16x8 qr[8];
    { const bf16* qb_ = QR + (size_t)m0 * 2048 + h * 128; const unsigned lq = (unsigned)(r32 * 2048 + hi * 8);
#pragma unroll
      for (int d0 = 0; d0 < 8; ++d0) qr[d0] = *(const GAS bf16x8*)(qb_ + lq + d0 * 16); }
    const bf16* Pb = P + (size_t)b * SEQ * LDP;
    const bf16* grow = P + (size_t)m0 * LDP + C_GA + h * 3;

    {
        fa::St S; fa::st_init(S);
        fa::MaskSel mk{qlo, t_row - 4 * hi, (SEL + (b * 4 + hk) * SEQ + qlo)[r32]};
        fa::attn_pass(S, qr, Pb + C_KSL + hk * 128, Pb + C_VSL + hk * 128, LDP, 0, 4 * qb + 4, lds, mk, tid, c.wave, lane);
        const float g1 = sigm(bf2f(grow[(unsigned)(r32 * LDP + 1)]) + a.b_gate[h * 3 + 1]);
        float rli[16]; fa::row_factors(g1 / S.l, rli, lds, c.wave, r32, hi);
        __syncthreads();
        LAS float* st = (LAS float*)lds + c.wave * 2176;
#define SEL_HALF(HF) do { f32x4 lo[4], hh[4]; fa::stage_half<HF>(S.o, rli, st, r32, hi, lane, lo, hh); \
        _Pragma("unroll") for (int q = 0; q < 4; ++q) { const int idx = q * 64 + lane; bf16* ob = OS + (size_t)(m0 + (idx >> 3)) * 2048 + h * 128 + HF * 64 + 8 * (idx & 7); \
            { v4u w_; w_.x = fa::cvtpk(lo[q][0], lo[q][1]); w_.y = fa::cvtpk(lo[q][2], lo[q][3]); w_.z = fa::cvtpk(hh[q][0], hh[q][1]); w_.w = fa::cvtpk(hh[q][2], hh[q][3]); *(GAS v4u*)ob = w_; } } } while (0)
        SEL_HALF(0); SEL_HALF(1);
#undef SEL_HALF
        __syncthreads();
    }
    {
        fa::St S; fa::st_init(S);
        fa::MaskWin mk{qlo, t_row - 4 * hi};
        const int t0 = 4 * qb - 8 > 0 ? 4 * qb - 8 : 0;
        fa::attn_pass(S, qr, Pb + C_KW + hk * 128, Pb + C_VW + hk * 128, LDP, t0, 4 * qb + 4, lds, mk, tid, c.wave, lane);
        const float g2 = sigm(bf2f(grow[(unsigned)(r32 * LDP + 2)]) + a.b_gate[h * 3 + 2]);
        float rli[16]; fa::row_factors(g2 / S.l, rli, lds, c.wave, r32, hi);
        __syncthreads();
        LAS float* st = (LAS float*)lds + c.wave * 2176;
#define WIN_HALF(HF) do { f32x4 lo[4], hh[4]; fa::stage_half<HF>(S.o, rli, st, r32, hi, lane, lo, hh); \
        v4u zz[4], cc_[4], ss_[4]; \
        _Pragma("unroll") for (int q = 0; q < 4; ++q) { const int idx = q * 64 + lane; const size_t mr = (size_t)(m0 + (idx >> 3)); const int gcol = h * 128 + HF * 64 + 8 * (idx & 7); \
            zz[q] = *(const GAS v4u*)(P + mr * LDP + C_ZA + gcol); cc_[q] = *(const GAS v4u*)(OC + mr * 2048 + gcol); ss_[q] = *(const GAS v4u*)(OS + mr * 2048 + gcol); } \
        _Pragma("unroll") for (int q = 0; q < 4; ++q) { const int idx = q * 64 + lane; const size_t mr = (size_t)(m0 + (idx >> 3)); const int gcol = h * 128 + HF * 64 + 8 * (idx & 7); \
            const f32x4 c0 = {fa::bflo(cc_[q].x), fa::bfhi(cc_[q].x), fa::bflo(cc_[q].y), fa::bfhi(cc_[q].y)}, c1 = {fa::bflo(cc_[q].z), fa::bfhi(cc_[q].z), fa::bflo(cc_[q].w), fa::bfhi(cc_[q].w)}; \
            const f32x4 s0 = {fa::bflo(ss_[q].x), fa::bfhi(ss_[q].x), fa::bflo(ss_[q].y), fa::bfhi(ss_[q].y)}, s1 = {fa::bflo(ss_[q].z), fa::bfhi(ss_[q].z), fa::bflo(ss_[q].w), fa::bfhi(ss_[q].w)}; \
            const f32x4 a0 = lo[q] + c0 + s0, a1 = hh[q] + c1 + s1; v4u w; \
            w.x = fa::cvtpk(fa::silu_mul(a0[0], fa::bflo(zz[q].x)), fa::silu_mul(a0[1], fa::bfhi(zz[q].x))); w.y = fa::cvtpk(fa::silu_mul(a0[2], fa::bflo(zz[q].y)), fa::silu_mul(a0[3], fa::bfhi(zz[q].y))); \
            w.z = fa::cvtpk(fa::silu_mul(a1[0], fa::bflo(zz[q].z)), fa::silu_mul(a1[1], fa::bfhi(zz[q].z))); w.w = fa::cvtpk(fa::silu_mul(a1[2], fa::bflo(zz[q].w)), fa::silu_mul(a1[3], fa::bfhi(zz[q].w))); \
            *(GAS v4u*)(MIX + mr * DM + gcol) = w; } } while (0)
        WIN_HALF(0); WIN_HALF(1);
#undef WIN_HALF
        __syncthreads();
    }
}
__device__ __forceinline__ void p4_nsa_mfma(const Args& a, const Ctx& c) {
    for (int it = c.bid; it < 256; it += c.G) {
        const int x = it & 7, y = it >> 3, grp = 2 * x + (y >> 4), idx = y & 15;
        const int b = grp >> 2, hk = grp & 3, g = idx >> 2, pr = idx & 3, h = hk * 4 + g;
        nsa_block(a, c, b, h, pr);
        nsa_block(a, c, b, h, 7 - pr);
    }
}

__device__ __forceinline__ void dil_block(const Args& a, const Ctx& c, int b, int h, int r4, int pb) {
    unsigned char* ws = a.ws;
    const bf16* P = (const bf16*)(ws + WS_P); bf16* MIX = (bf16*)(ws + WS_MIX);
    LAS char* lds = (LAS char*)(c.lds + RING_OFF);
    int lane = c.lane, tid = c.tid; asm volatile("" : "+v"(lane), "+v"(tid));
    const int r32 = lane & 31, hi = lane >> 5;
    const int plo = pb * 256 + c.wave * 32, p_row = plo + r32, tok = 4 * p_row + r4, mrow0 = b * SEQ + 4 * plo + r4;
    bf16x8 qr[8];
    { const bf16* qb_ = P + (size_t)mrow0 * LDP + C_QB + h * 128; const unsigned lq = (unsigned)(r32 * 4 * LDP + hi * 8);
#pragma unroll
      for (int d0 = 0; d0 < 8; ++d0) qr[d0] = *(const GAS bf16x8*)(qb_ + lq + d0 * 16); }
    const bf16* Pb = P + (size_t)b * SEQ * LDP;
    fa::St S; fa::st_init(S);
    {   fa::MaskDilA mk{plo, p_row - 4 * hi};
        fa::attn_pass(S, qr, Pb + (size_t)r4 * LDP + C_KB + h * 128, Pb + (size_t)r4 * LDP + C_VB + h * 128, 4 * LDP, 0, 4 * pb + 4, lds, mk, tid, c.wave, lane); }
    {   const int tmin = 1024 * pb + r4, tmax = 1024 * pb + 1020 + r4;
        const int t0 = tmin - 128 > 0 ? (tmin - 128) >> 6 : 0, t1 = (tmax >> 6) + 1;
        fa::MaskDilB mk{4 * plo + r4, tok - 4 * hi};
        fa::attn_pass(S, qr, Pb + C_KB + h * 128, Pb + C_VB + h * 128, LDP, t0, t1, lds, mk, tid, c.wave, lane); }
    float rli[16]; fa::row_factors(1.0f / S.l, rli, lds, c.wave, r32, hi);
    __syncthreads();
    LAS float* st = (LAS float*)lds + c.wave * 2176;
#define DIL_HALF(HF) do { f32x4 lo[4], hh[4]; fa::stage_half<HF>(S.o, rli, st, r32, hi, lane, lo, hh); \
        v4u zz[4]; \
        _Pragma("unroll") for (int q = 0; q < 4; ++q) { const int idx = q * 64 + lane; const size_t mr = (size_t)(mrow0 + 4 * (idx >> 3)); const int gcol = h * 128 + HF * 64 + 8 * (idx & 7); \
            zz[q] = *(const GAS v4u*)(P + mr * LDP + C_ZB + gcol); } \
        _Pragma("unroll") for (int q = 0; q < 4; ++q) { const int idx = q * 64 + lane; const size_t mr = (size_t)(mrow0 + 4 * (idx >> 3)); const int gcol = h * 128 + HF * 64 + 8 * (idx & 7); \
            const f32x4 a0 = lo[q], a1 = hh[q]; v4u w; \
            w.x = fa::cvtpk(fa::silu_mul(a0[0], fa::bflo(zz[q].x)), fa::silu_mul(a0[1], fa::bfhi(zz[q].x))); w.y = fa::cvtpk(fa::silu_mul(a0[2], fa::bflo(zz[q].y)), fa::silu_mul(a0[3], fa::bfhi(zz[q].y))); \
            w.z = fa::cvtpk(fa::silu_mul(a1[0], fa::bflo(zz[q].z)), fa::silu_mul(a1[1], fa::bfhi(zz[q].z))); w.w = fa::cvtpk(fa::silu_mul(a1[2], fa::bflo(zz[q].w)), fa::silu_mul(a1[3], fa::bfhi(zz[q].w))); \
            *(GAS v4u*)(MIX + mr * DM + 2048 + gcol) = w; } } while (0)
    DIL_HALF(0); DIL_HALF(1);
#undef DIL_HALF
    __syncthreads();
}
__device__ __forceinline__ void p4_dil_mfma(const Args& a, const Ctx& c) {
    for (int it = c.bid; it < 256; it += c.G) {
        const int x = it & 7, y = it >> 3, bh = 8 * x + (y >> 2), r4 = y & 3, b = bh >> 4, h = bh & 15;
        dil_block(a, c, b, h, r4, 0);
        dil_block(a, c, b, h, r4, 1);
    }
}

__device__ __forceinline__ void cmp_item(const Args& a, const Ctx& c, int b, int hk, int tb) {
    unsigned char* ws = a.ws;
    const bf16* P = (const bf16*)(ws + WS_P); const bf16* KCB = (const bf16*)(ws + WS_KCB); const bf16* VCB = (const bf16*)(ws + WS_VCB);
    bf16* OC = (bf16*)(ws + WS_OC); unsigned* SEL = (unsigned*)(ws + WS_SEL);
    LAS char* lds = (LAS char*)(c.lds + RING_OFF);
    LAS float* imps = (LAS float*)(lds + 69632);
    int lane = c.lane, tid = c.tid; asm volatile("" : "+v"(lane), "+v"(tid));
    const int r32 = lane & 31, hi = lane >> 5, g = c.wave >> 1, h = hk * 4 + g, bh = b * 4 + hk;
    const int tl0 = 32 * (c.wave & 1), tw0 = 64 * tb + tl0, t = tw0 + r32, m0 = b * SEQ + tw0;
    const int nt = tb >= 16 ? 2 : 1;
    LAS char* V_lds = lds + fa::A_V; LAS char* K_lds = lds + fa::A_K;
    {   const int sr = tid >> 4, sc = (tid & 15) * 8; const int kws = FA_KSWZ(sr, sc * 2), vst0 = fa::v_st(sr, sc), vst1 = fa::v_st(32 + sr, sc);
        const bf16* Kg = KCB + (size_t)bh * 128 * 128; const bf16* Vg = VCB + (size_t)bh * 128 * 128; const unsigned lo = (unsigned)(sr * 128 + sc);
        for (int tt = 0; tt < nt; ++tt) {
            const bf16x8 k0 = *(const GAS bf16x8*)(Kg + tt * 8192 + lo), k1 = *(const GAS bf16x8*)(Kg + tt * 8192 + 4096 + lo);
            const bf16x8 v0 = *(const GAS bf16x8*)(Vg + tt * 8192 + lo), v1 = *(const GAS bf16x8*)(Vg + tt * 8192 + 4096 + lo);
            *(LAS bf16x8*)(K_lds + tt * fa::SHM_K + kws) = k0; *(LAS bf16x8*)(K_lds + tt * fa::SHM_K + kws + 32 * 256) = k1;
            *(LAS bf16x8*)(V_lds + tt * fa::SHM_V + vst0) = v0; *(LAS bf16x8*)(V_lds + tt * fa::SHM_V + vst1) = v1; } }
    bf16x8 qr[8];
    { const bf16* qb_ = P + (size_t)m0 * LDP + C_QA + h * 128; const unsigned lq = (unsigned)(r32 * LDP + hi * 8);
#pragma unroll
      for (int d0 = 0; d0 < 8; ++d0) qr[d0] = *(const GAS bf16x8*)(qb_ + lq + d0 * 16); }
    __syncthreads();
    const float NEG = -__builtin_inff();
    fa::f32x16 p0, p1, p2, p3;
    fa::qkt<0>(p0, p1, K_lds, r32, hi, qr);
    const int cmax = (t - 31) >> 4;
    fa::mask_tile(p0, p1, cmax - 4 * hi, 0x40000000u);
    if (nt == 2) { fa::qkt<1>(p2, p3, K_lds, r32, hi, qr); fa::mask_tile(p2, p3, cmax - 4 * hi - 64, 0x40000000u); }
    else {
#pragma unroll
        for (int r = 0; r < 16; ++r) { p2[r] = NEG; p3[r] = NEG; } }
    float mx = p0[0];
#pragma unroll
    for (int r = 0; r < 16; ++r) mx = fmaxf(fmaxf(mx, p0[r]), fmaxf(p1[r], fmaxf(p2[r], p3[r])));
    { auto rr = __builtin_amdgcn_permlane32_swap(__float_as_uint(mx), __float_as_uint(mx), false, false); mx = fmaxf(__uint_as_float(rr[0]), __uint_as_float(rr[1])); }
    const float mL = (mx == NEG) ? 0.f : -mx * fa::C2;
    float l = 0.f;
#pragma unroll
    for (int r = 0; r < 16; ++r) { p0[r] = __builtin_amdgcn_exp2f(fmaf(p0[r], fa::C2, mL)); p1[r] = __builtin_amdgcn_exp2f(fmaf(p1[r], fa::C2, mL));
        p2[r] = __builtin_amdgcn_exp2f(fmaf(p2[r], fa::C2, mL)); p3[r] = __builtin_amdgcn_exp2f(fmaf(p3[r], fa::C2, mL)); l += (p0[r] + p1[r]) + (p2[r] + p3[r]); }
    { auto rr = __builtin_amdgcn_permlane32_swap(__float_as_uint(l), __float_as_uint(l), false, false); l = __uint_as_float(rr[0]) + __uint_as_float(rr[1]); }
    const float inv = l > 0.f ? 1.0f / l : 0.f;
    {   fa::f32x16 o[4];
#pragma unroll
        for (int d = 0; d < 4; ++d)
#pragma unroll
            for (int r = 0; r < 16; ++r) o[d][r] = 0.f;
        const int vb0 = (int)(unsigned)(uintptr_t)lds + fa::v_rd_base(lane);
        bf16x8 pa0, pa1, pa2, pa3;
        fa::pack_p(p0, p1, pa0, pa1, pa2, pa3); FA_SBAR(); fa::pv_tile<0>(o, vb0, pa0, pa1, pa2, pa3);
        if (nt == 2) { fa::pack_p(p2, p3, pa0, pa1, pa2, pa3); FA_SBAR(); fa::pv_tile<1>(o, vb0, pa0, pa1, pa2, pa3); }
        float own[16], last[16];
#pragma unroll
        for (int k = 0; k < 16; ++k) { const int q = k & 3; const fa::f32x16& px = (k >> 2) == 0 ? p0 : (k >> 2) == 1 ? p1 : (k >> 2) == 2 ? p2 : p3;
            own[k] = ((px[4 * q] + px[4 * q + 1]) + (px[4 * q + 2] + px[4 * q + 3])) * inv; last[k] = px[4 * q + 3] * inv; }
        LAS float* dst = imps + ((g * 64 + tl0 + r32) * 32 + hi);
#pragma unroll
        for (int k = 0; k < 16; ++k) { const float x = __shfl_xor(last[k], 32); const float xp = (k > 0) ? __shfl_xor(last[k > 0 ? k - 1 : 0], 32) : 0.f;
            dst[2 * k] = own[k] + (hi ? x : xp); }
        const float g0 = sigm(bf2f((P + (size_t)m0 * LDP + C_GA + h * 3)[(unsigned)(r32 * LDP)]) + a.b_gate[h * 3]);
        float rli[16]; fa::row_factors(inv * g0, rli, lds, c.wave, r32, hi);
        __syncthreads();
        LAS float* st = (LAS float*)lds + c.wave * 2176;
#define CMP_HALF(HF) do { f32x4 lo[4], hh[4]; fa::stage_half<HF>(o, rli, st, r32, hi, lane, lo, hh); \
        _Pragma("unroll") for (int q = 0; q < 4; ++q) { const int idx = q * 64 + lane; bf16* ob = OC + (size_t)(m0 + (idx >> 3)) * 2048 + h * 128 + HF * 64 + 8 * (idx & 7); \
            { v4u w_; w_.x = fa::cvtpk(lo[q][0], lo[q][1]); w_.y = fa::cvtpk(lo[q][2], lo[q][3]); w_.z = fa::cvtpk(hh[q][0], hh[q][1]); w_.w = fa::cvtpk(hh[q][2], hh[q][3]); *(GAS v4u*)ob = w_; } } } while (0)
        CMP_HALF(0); CMP_HALF(1);
#undef CMP_HALF
    }
#pragma unroll 1
    for (int tt = 0; tt < 4; ++tt) {
        const int tl = c.wave * 8 + tt * 2 + hi, j = r32, tq = 64 * tb + tl, cur = tq >> 6;
        float imp = (imps[(0 * 64 + tl) * 32 + j] + imps[(1 * 64 + tl) * 32 + j]) + (imps[(2 * 64 + tl) * 32 + j] + imps[(3 * 64 + tl) * 32 + j]);
        const bool forced = (j == 0) || (j == cur) || (j == cur - 1);
        float v = forced ? imp + 1e4f : imp;
        if (j > cur) v = NEG;
        int rank = 0;
        for (int jj = 0; jj < 32; ++jj) { const float vo = __shfl(v, (lane & 32) + jj); rank += (vo > v || (vo == v && jj < j)) ? 1 : 0; }
        const bool sel = (rank < TOPN) && (j <= cur);
        const unsigned long long bal = __ballot(sel);
        if (r32 == 0) SEL[bh * SEQ + tq] = (unsigned)(bal >> (32 * hi));
    }
    __syncthreads();
}
__device__ __forceinline__ void p3_cmp_mfma(const Args& a, const Ctx& c) {
    for (int it = c.bid; it < 512; it += c.G) {
        const int bh = (it >> 5) & 15, tb = (it & 31) ^ ((it >> 8) ? 31 : 0);
        cmp_item(a, c, bh >> 2, bh & 3, tb);
    }
}

__device__ __forceinline__ void p6_final(const Args& a, const Ctx& c) {
    const bf16* Y = (const bf16*)(a.ws + WS_Y);
    for (int m = c.gw; m < M; m += c.NGW) {
        const GAS v4u* yr = (const GAS v4u*)(Y + (size_t)m * DM) + c.lane;
        v4u yv[8]; float s = 0.f;
#pragma unroll
        for (int j = 0; j < 8; ++j) yv[j] = yr[64 * j];
        const GAS f32x4* xr = (const GAS f32x4*)(a.x + (size_t)m * DM) + 2 * c.lane;
        GAS f32x4* orow = (GAS f32x4*)(a.out + (size_t)m * DM) + 2 * c.lane;
#pragma unroll
        for (int j = 0; j < 8; ++j) { const float y0 = fa::bflo(yv[j].x), y1 = fa::bfhi(yv[j].x), y2 = fa::bflo(yv[j].y), y3 = fa::bfhi(yv[j].y),
                                                  y4 = fa::bflo(yv[j].z), y5 = fa::bfhi(yv[j].z), y6 = fa::bflo(yv[j].w), y7 = fa::bfhi(yv[j].w);
            s += ((y0 * y0 + y1 * y1) + (y2 * y2 + y3 * y3)) + ((y4 * y4 + y5 * y5) + (y6 * y6 + y7 * y7)); }
        const float rstd = 1.0f / sqrtf(wave_sum(s) * (1.0f / DM) + EPS);
#pragma unroll
        for (int j = 0; j < 8; ++j) {
            const f32x4 w0 = ((const GAS f32x4*)a.post_w)[2 * c.lane + 128 * j], w1 = ((const GAS f32x4*)a.post_w)[2 * c.lane + 128 * j + 1];
            const f32x4 x0 = xr[128 * j], x1 = xr[128 * j + 1];
            const f32x4 ya = {fa::bflo(yv[j].x), fa::bfhi(yv[j].x), fa::bflo(yv[j].y), fa::bfhi(yv[j].y)}, yb = {fa::bflo(yv[j].z), fa::bfhi(yv[j].z), fa::bflo(yv[j].w), fa::bfhi(yv[j].w)};
            orow[128 * j] = x0 + ya * rstd * w0; orow[128 * j + 1] = x1 + yb * rstd * w1; }
    }
}


#ifndef MK_SPLIT
#define MK_SPLIT 0
#endif
constexpr int NPHASE = 8;

__global__ void __launch_bounds__(NWAVES * 64, 2) fwd_kernel(Args args) {
    extern __shared__ __attribute__((aligned(16))) unsigned char lds_raw[];
    Ctx c;
    c.lds = (LAS unsigned char*)lds_raw;
    c.tid = threadIdx.x; c.lane = c.tid & 63; c.wave = __builtin_amdgcn_readfirstlane(c.tid >> 6);
    c.G = gridDim.x; c.bid = blockIdx.x; c.gw = c.bid * NWAVES + c.wave; c.NGW = c.G * NWAVES;
    unsigned char* ws = args.ws;
    gu32* ctl = (gu32*)(ws + WS_CTL);
    volatile LAS unsigned* MISC = (volatile LAS unsigned*)(c.lds + MISC_OFF);
    for (int u = c.tid; u < (LDS_BYTES - LDSCTL_OFF) / 4; u += NWAVES * 64) ((LAS unsigned*)(c.lds + LDSCTL_OFF))[u] = 0u;
    __syncthreads();
    XcdBarrier bar; bar.bar = (unsigned*)(ctl + CW_BAR); bar.x = 0; bar.st = nullptr;
    if (!MK_SPLIT) bar = xcd_barrier_post((unsigned*)(ctl + CW_BAR), MISC + 8);
    const int lo = args.ph_lo, hi = args.ph_hi;
#define IN(k) (lo <= (k) && (k) < hi)
#define SEAM(k) do { if (IN(k) && IN((k) + 1)) xcd_barrier(bar); } while (0)

    if (IN(0)) { p0_prologue(args, c); } SEAM(0);
    if (IN(1)) {
        pg8::Gemm g{(const pg8::bf16_t*)(ws + WS_HB), (const pg8::bf16_t*)(ws + WS_WIN), M, NP, DM, DM}; pg8::StaticOrder S; S.init(M, NP, c.G, c.bid);
        pg8::EpiP E{(pg8::bf16_t*)(ws + WS_P), NP, (pg8::bf16_t*)(ws + WS_QR), (pg8::bf16_t*)(ws + WS_XKV), (const float*)(ws + WS_COS), (const float*)(ws + WS_SIN)};
        pg8::gemm_phase<pg8::EpiP, pg8::StaticOrder, true, true>(c.lds + RING_OFF, g, S, E);
        {
            const int rem = ((M / 256) * (NP / 256)) % c.G, nt_ = rem ? c.G - rem : c.G, ti = rem ? c.bid - rem : c.bid;
            if (ti >= 0) p0_transposes(args, c, TI_IN, TI_ALL, ti * NWAVES + c.wave, nt_ * NWAVES);
        }
    } SEAM(1);
    if (IN(2)) {
        pg8::Gemm g{(const pg8::bf16_t*)(ws + WS_XKV), (const pg8::bf16_t*)(ws + WS_WLR), 4096, 1024, 256, 2048}; pg8::CmpOrder S{c.bid, c.G};
        pg8::EpiLR E{(float*)(ws + WS_LR), 1024, (size_t)4096 * 1024};
        pg8::gemm_phase<pg8::EpiLR, pg8::CmpOrder, false, true>(c.lds + RING_OFF, g, S, E);
    } SEAM(2);
    if (IN(3)) { p2c_stage2(args, c); } SEAM(3);
    if (IN(4)) { p3_cmp_mfma(args, c); } SEAM(4);
    if (IN(5)) {
        p4_nsa_mfma(args, c);
        p4_dil_mfma(args, c);
    } SEAM(5);
    if (IN(6)) {
        pg8::Gemm g{(const pg8::bf16_t*)(ws + WS_MIX), (const pg8::bf16_t*)(ws + WS_WOUT), M, DM, DM, DM}; pg8::StaticOrder S; S.init(M, DM, c.G, c.bid);
        pg8::EpiBf16<0> E{(pg8::bf16_t*)(ws + WS_Y), DM, nullptr, 0, 0, 1.f};
        pg8::gemm_phase<pg8::EpiBf16<0>, pg8::StaticOrder, true, true>(c.lds + RING_OFF, g, S, E);
    } SEAM(6);
    if (IN(7)) { p6_final(args, c); }
#undef IN
#undef SEAM
}

extern "C" void kernel_launch(void* const* d_in, const int* in_sizes, int n_in, void* d_out, int out_size, void* d_ws, size_t ws_size, hipStream_t stream) {
    static int grid = 0;
    if (grid == 0) {
        if (n_in != 13 || out_size != M * DM || ws_size < WS_END) { fprintf(stderr, "kernel_launch: unexpected shapes (n_in %d out %d ws %zu)\n", n_in, out_size, ws_size); grid = -1; return; }
        int dev = 0, cus = 0, per_cu = 0;
        if (hipGetDevice(&dev) != hipSuccess || hipDeviceGetAttribute(&cus, hipDeviceAttributeMultiprocessorCount, dev) != hipSuccess) { grid = -1; return; }
        if (hipFuncSetAttribute((const void*)fwd_kernel, hipFuncAttributeMaxDynamicSharedMemorySize, LDS_BYTES) != hipSuccess) { fprintf(stderr, "kernel_launch: hipFuncSetAttribute failed\n"); grid = -1; return; }
        if (hipOccupancyMaxActiveBlocksPerMultiprocessor(&per_cu, (const void*)fwd_kernel, NWAVES * 64, LDS_BYTES) != hipSuccess || per_cu < 1)
            fprintf(stderr, "kernel_launch: occupancy query reports %d\n", per_cu);
        (void)hipGetLastError();
        grid = cus;
    }
    if (grid < 0) return;
    if (hipMemsetAsync((char*)d_ws + WS_CTL, 0, CTL_ZERO_BYTES, stream) != hipSuccess) return;
    Args a{};
    a.x = (const float*)d_in[0]; a.pos = (const int*)d_in[1]; a.pre_w = (const float*)d_in[2]; a.post_w = (const float*)d_in[3];
    a.w_in = (const float*)d_in[4]; a.b_gate = (const float*)d_in[5]; a.pe_k = (const float*)d_in[6]; a.pe_v = (const float*)d_in[7];
    a.wk1 = (const float*)d_in[8]; a.wk2 = (const float*)d_in[9]; a.wv1 = (const float*)d_in[10]; a.wv2 = (const float*)d_in[11]; a.w_out = (const float*)d_in[12];
    a.out = (float*)d_out; a.ws = (unsigned char*)d_ws;
#if MK_SPLIT
    for (int p = 0; p < NPHASE; ++p) { a.ph_lo = p; a.ph_hi = p + 1; hipLaunchKernelGGL(fwd_kernel, dim3(grid), dim3(NWAVES * 64), LDS_BYTES, stream, a); }
#else
    a.ph_lo = 0; a.ph_hi = NPHASE;
    hipLaunchKernelGGL(fwd_kernel, dim3(grid), dim3(NWAVES * 64), LDS_BYTES, stream, a);
#endif
}
```

```cpp
#include <hip/hip_runtime.h>
#include <cstdio>
#include <cstdint>
namespace pg8 {
#define PG8_LAS __attribute__((address_space(3)))
typedef unsigned short bf16_t;
typedef short bf16x8 __attribute__((ext_vector_type(8)));
typedef float f32x4 __attribute__((ext_vector_type(4)));
typedef unsigned u32x4 __attribute__((ext_vector_type(4)));
constexpr int BM = 256, BK = 64, HALF = 128, HTB = HALF * BK * 2  , STAGE_BYTES = 8 * HTB, NXCD = 8, WGM = 8;

__host__ __device__ __forceinline__ int lds_byte(int r, int c) { const int st = (r >> 4) * 2 + (c >> 5), rr = r & 15, cc = c & 31, ob = rr * 64 + cc * 2; return st * 1024 + (ob ^ (((ob >> 9) & 1) << 5)); }
__host__ __device__ __forceinline__ void stage_rc(int b, int& R, int& C) { const int st = b / 1024, sb = b % 1024, swz = sb ^ (((sb >> 9) & 1) << 5); R = (st >> 1) * 16 + swz / 64; C = (st & 1) * 32 + (swz % 64) / 2; }
__host__ __device__ __forceinline__ int perm32(int rho) { const int n = rho >> 4, i = rho & 15; return 8 * (i >> 2) + 4 * n + (i & 3); }

struct Unit { int pm, pn, ko; };
struct Gemm { const bf16_t* A; const bf16_t* Bt; int M, N, K, ld; };

struct StaticOrder {
    int nM, nN, nwg, G, c;
    __host__ __device__ void init(int M, int N, int G_, int c_) { nM = M / BM; nN = N / BM; nwg = nM * nN; G = G_; c = c_; }
    __host__ __device__ bool next(int i, Unit& u) const {
        const long L = (long)i * G + c; if (L >= nwg) return false;
        int wgid = (int)L; { const int q = nwg / NXCD, r = nwg % NXCD, xcd = wgid % NXCD, off = wgid / NXCD; wgid = (xcd < r ? xcd * (q + 1) : r * (q + 1) + (xcd - r) * q) + off; }
        const int nig = WGM * nN, gid = wgid / nig, fm = gid * WGM, gsz = (nM - fm) < WGM ? (nM - fm) : WGM;
        u.pm = fm + ((wgid % nig) % gsz); u.pn = (wgid % nig) / gsz; u.ko = 0; return true;
    }
    __device__ __forceinline__ void a_ready(const Unit&) const {}
    __device__ __forceinline__ void done(const Unit&) const {}
};

__device__ __forceinline__ unsigned cvt_pk_bf16(float lo, float hi) { unsigned r; asm volatile("v_cvt_pk_bf16_f32 %0, %1, %2" : "=v"(r) : "v"(lo), "v"(hi)); return r; }
typedef float f32x2 __attribute__((ext_vector_type(2)));
__device__ __forceinline__ f32x2 gelu_pk(f32x2 v) {
    const f32x2 av = __builtin_elementwise_abs(v), d = av * 0.2316418882f + 1.0f;
    f32x2 t; t.x = __builtin_amdgcn_rcpf(d.x); t.y = __builtin_amdgcn_rcpf(d.y);
    f32x2 q = t * 0.5307027145f + (-0.7265760135f); q = q * t + 0.7107068705f; q = q * t + (-0.142248368f); q = q * t + 0.127414796f; q = q * t;
    const f32x2 s = (v * v) * (-0.72134752044f);
    f32x2 e; e.x = __builtin_amdgcn_exp2f(s.x); e.y = __builtin_amdgcn_exp2f(s.y);
    const f32x2 m = v * (q * e), r = v - m;
    f32x2 o; o.x = v.x < 0.f ? m.x : r.x; o.y = v.y < 0.f ? m.y : r.y; return o;
}

template <int ACT  > struct EpiBf16 {
    static constexpr bool PERM = true, AFTER_DRAIN = false; static_assert(ACT == 0 || ACT == 1, "EpiBf16: ACT is 0 (none) or 1 (gelu_pk)");
    bf16_t* O; int ldc; const float* bias; int split_cols; size_t split_stride; float scale0;
    __device__ __forceinline__ void operator()(const f32x4 (&acc)[2][2][4][2], const Unit& u, int wr, int wc, int fr, int fq) const {
        const int row0 = u.pm * BM + wr * 64 + fr; int colt = u.pn * BM; bf16_t* base = O;
        float sc = 1.f; if (split_cols) { const int t = colt / split_cols; base += (size_t)t * split_stride; colt -= t * split_cols; if (t == 0) sc = scale0; }
        const int col0 = colt + wc * 32 + 8 * fq, bcol0 = u.pn * BM + wc * 32 + 8 * fq;
        f32x4 bv[2][2];
#pragma unroll
        for (int bj = 0; bj < 2; ++bj)
#pragma unroll
            for (int n = 0; n < 2; ++n) bv[bj][n] = bias ? *(const f32x4*)(bias + bcol0 + bj * HALF + 4 * n) : (f32x4){0.f, 0.f, 0.f, 0.f};
#pragma unroll
        for (int ai = 0; ai < 2; ++ai)
#pragma unroll
            for (int m = 0; m < 4; ++m) { bf16_t* rowp = base + (size_t)(row0 + ai * HALF + m * 16) * ldc + col0;
#pragma unroll
                for (int bj = 0; bj < 2; ++bj) { f32x4 v0 = acc[ai][bj][m][0] + bv[bj][0], v1 = acc[ai][bj][m][1] + bv[bj][1];
                    if (ACT == 1) { f32x2 a = gelu_pk((f32x2){v0[0], v0[1]}), b = gelu_pk((f32x2){v0[2], v0[3]}), c = gelu_pk((f32x2){v1[0], v1[1]}), d = gelu_pk((f32x2){v1[2], v1[3]});
                        v0 = (f32x4){a.x, a.y, b.x, b.y}; v1 = (f32x4){c.x, c.y, d.x, d.y}; }
                    v0 = v0 * sc; v1 = v1 * sc; u32x4 w; w.x = cvt_pk_bf16(v0[0], v0[1]); w.y = cvt_pk_bf16(v0[2], v0[3]); w.z = cvt_pk_bf16(v1[0], v1[1]); w.w = cvt_pk_bf16(v1[2], v1[3]);
                    *(u32x4*)(rowp + bj * HALF) = w; } }
    }
};
struct EpiF32 {
    static constexpr bool PERM = false, AFTER_DRAIN = false;
    float* O; int ldc;
    __device__ __forceinline__ void operator()(const f32x4 (&acc)[2][2][4][2], const Unit& u, int wr, int wc, int fr, int fq) const {
        const int row0 = u.pm * BM + wr * 64 + fr, col0 = u.pn * BM + wc * 32 + 4 * fq;
#pragma unroll
        for (int ai = 0; ai < 2; ++ai)
#pragma unroll
            for (int m = 0; m < 4; ++m) { float* rowp = O + (size_t)(row0 + ai * HALF + m * 16) * ldc + col0;
#pragma unroll
                for (int bj = 0; bj < 2; ++bj)
#pragma unroll
                    for (int n = 0; n < 2; ++n) *(f32x4*)(rowp + bj * HALF + n * 16) = acc[ai][bj][m][n]; }
    }
};

struct EpiP {
    static constexpr bool PERM = true, AFTER_DRAIN = false;
    bf16_t* Pm; int ldc; bf16_t* QR; bf16_t* XKV; const float* COS; const float* SIN;
    __device__ __forceinline__ void operator()(const f32x4 (&acc)[2][2][4][2], const Unit& u, int wr, int wc, int fr, int fq) const {
        const int pn = u.pn;
        const bool is_qa = pn < 8, is_rope = is_qa || pn == 20 || pn == 21 || pn == 24 || pn == 25 || (pn >= 28 && pn < 44), is_x = pn >= 16 && pn < 20;
        const int row0 = u.pm * BM + wr * 64 + fr, colw = wc * 32 + 8 * fq;
#pragma unroll
        for (int ai = 0; ai < 2; ++ai)
#pragma unroll
            for (int m = 0; m < 4; ++m) {
                const int row = row0 + ai * HALF + m * 16;
                f32x4 cs = {1.f, 1.f, 1.f, 1.f}, sn = {0.f, 0.f, 0.f, 0.f};
                if (is_rope) { cs = *(const f32x4*)(COS + (size_t)row * 64 + 16 * wc + 4 * fq); sn = *(const f32x4*)(SIN + (size_t)row * 64 + 16 * wc + 4 * fq); }
#pragma unroll
                for (int bj = 0; bj < 2; ++bj) {
                    const f32x4 v0 = acc[ai][bj][m][0], v1 = acc[ai][bj][m][1];
                    u32x4 w;
                    if (!is_rope || is_qa) { w.x = cvt_pk_bf16(v0[0], v0[1]); w.y = cvt_pk_bf16(v0[2], v0[3]); w.z = cvt_pk_bf16(v1[0], v1[1]); w.w = cvt_pk_bf16(v1[2], v1[3]); }
                    if (is_x) { const int hq = (pn - 16) * 2 + bj, kv = hq >> 2, hk = hq & 3, b = row >> 11, tok = row & 2047;
                        *(u32x4*)(XKV + ((size_t)((kv * 16 + b * 4 + hk) * 2048 + tok)) * 128 + colw) = w; }
                    else if (!is_rope) { *(u32x4*)(Pm + (size_t)row * ldc + pn * BM + bj * HALF + colw) = w; }
                    else {
                        if (is_qa) *(u32x4*)(Pm + (size_t)row * ldc + pn * BM + bj * HALF + colw) = w;
                        const f32x4 r0 = v0 * cs - v1 * sn, r1 = v1 * cs + v0 * sn;
                        u32x4 wr_; wr_.x = cvt_pk_bf16(r0[0], r0[1]); wr_.y = cvt_pk_bf16(r0[2], r0[3]); wr_.z = cvt_pk_bf16(r1[0], r1[1]); wr_.w = cvt_pk_bf16(r1[2], r1[3]);
                        if (is_qa) *(u32x4*)(QR + (size_t)row * 2048 + pn * BM + bj * HALF + colw) = wr_;
                        else *(u32x4*)(Pm + (size_t)row * ldc + pn * BM + bj * HALF + colw) = wr_;
                    }
                }
            }
    }
};

struct EpiLR {
    static constexpr bool PERM = false, AFTER_DRAIN = false;
    float* O; int ldc; size_t ks_stride;
    __device__ __forceinline__ void operator()(const f32x4 (&acc)[2][2][4][2], const Unit& u, int wr, int wc, int fr, int fq) const {
        const int row0 = u.pm * BM + wr * 64 + fr, col0 = u.pn * BM + wc * 32 + 4 * fq; float* Ob = O + (size_t)(u.ko >> 8) * ks_stride;
#pragma unroll
        for (int ai = 0; ai < 2; ++ai)
#pragma unroll
            for (int m = 0; m < 4; ++m) { float* rowp = Ob + (size_t)(row0 + ai * HALF + m * 16) * ldc + col0;
#pragma unroll
                for (int bj = 0; bj < 2; ++bj)
#pragma unroll
                    for (int n = 0; n < 2; ++n) *(f32x4*)(rowp + bj * HALF + n * 16) = acc[ai][bj][m][n]; }
    }
};
struct CmpOrder { int c, G;
    __device__ __forceinline__ bool next(int i, Unit& u) const { const int L = i * G + c; if (L >= 256) return false;
        const int ks = L & 7, q = L >> 3, kv = q >> 4, pmi = (q >> 1) & 7, pni = q & 1; u.pm = kv * 8 + pmi; u.pn = kv * 2 + pni; u.ko = ks * 256; return true; }
    __device__ __forceinline__ void a_ready(const Unit&) const {}
    __device__ __forceinline__ void done(const Unit&) const {}
};

template <class Epi, class Sched, bool ALIGN_EPI = false, bool SP2 = false>
__device__ __forceinline__ void gemm_phase(PG8_LAS unsigned char* lds, const Gemm g, const Sched& S, const Epi& E) {
    const int tid = threadIdx.x, wid = __builtin_amdgcn_readfirstlane(tid >> 6), lane = tid & 63, wr = wid >> 2, wc = wid & 3, fr = lane & 15, fq = lane >> 4;
    const int K = g.K, nt = K / BK, ld = g.ld;
    unsigned voffA[2], voffB[2];
#pragma unroll
    for (int i = 0; i < 2; ++i) { int R, C; stage_rc(tid * 16 + i * 8192, R, C); const int Rb = Epi::PERM ? ((R & ~31) + perm32(R & 31)) : R;
        voffA[i] = (unsigned)(R * ld + C) * 2u; voffB[i] = (unsigned)(Rb * ld + C) * 2u; }
    const size_t kstep = (size_t)(BK * 2);
    const size_t hstep = (size_t)HALF * ld * 2;
    const size_t tstep = 2 * hstep;
    const unsigned ldsw = (unsigned)wid * 1024u;
    const int aoff = lds_byte(wr * 64 + fr, fq * 8), boff = lds_byte(wc * 32 + fr, fq * 8);
#define PG8_SA(b, h) (((b) * 2 + (h)) * HTB)
#define PG8_SB(b, h) ((4 + (b) * 2 + (h)) * HTB)
#define PG8_STAGE(bufoff, gbase, voff) do { _Pragma("unroll") for (int _i = 0; _i < 2; ++_i) \
        __builtin_amdgcn_global_load_lds((const unsigned*)((const char*)(gbase) + (voff)[_i]), (PG8_LAS unsigned*)(lds + (bufoff) + ldsw + _i * 8192), 16, 0, 0); } while (0)
#define PG8_LDA(dst, b, h) do { _Pragma("unroll") for (int m = 0; m < 4; ++m) _Pragma("unroll") for (int k = 0; k < 2; ++k) dst[m][k] = *(const PG8_LAS bf16x8*)(lds + PG8_SA(b, h) + aoff + m * 2048 + k * 1024); } while (0)
#define PG8_LDB(dst, b, h) do { _Pragma("unroll") for (int n = 0; n < 2; ++n) _Pragma("unroll") for (int k = 0; k < 2; ++k) dst[n][k] = *(const PG8_LAS bf16x8*)(lds + PG8_SB(b, h) + boff + n * 2048 + k * 1024); } while (0)
#define PG8_MMA(ai, bj, At, Bt) do { __builtin_amdgcn_s_setprio(1); _Pragma("unroll") for (int m = 0; m < 4; ++m) _Pragma("unroll") for (int n = 0; n < 2; ++n) _Pragma("unroll") for (int k = 0; k < 2; ++k) \
        acc[ai][bj][m][n] = __builtin_amdgcn_mfma_f32_16x16x32_bf16(Bt[n][k], At[m][k], acc[ai][bj][m][n], 0, 0, 0); __builtin_amdgcn_s_setprio(0); } while (0)
#define PG8_WAIT_V(n) asm volatile("s_waitcnt vmcnt(" #n ")" ::: "memory")
#define PG8_WAIT_L(n) asm volatile("s_waitcnt lgkmcnt(" #n ")" ::: "memory")
#define PG8_BAR __builtin_amdgcn_s_barrier()
#define PG8_SCHED __builtin_amdgcn_sched_barrier(0)
    Unit cur, nxt; int ui = 0;
    if (!S.next(0, cur)) return;
    f32x4 acc[2][2][4][2];
#pragma unroll
    for (int a = 0; a < 2; ++a)
#pragma unroll
        for (int b = 0; b < 2; ++b)
#pragma unroll
            for (int m = 0; m < 4; ++m)
#pragma unroll
                for (int n = 0; n < 2; ++n) acc[a][b][m][n] = (f32x4){0.f, 0.f, 0.f, 0.f};
    bf16x8 At[4][2], B0[2][2], B1[2][2];
    const char* cA = (const char*)g.A + (size_t)cur.pm * tstep + (size_t)cur.ko * 2; const char* cB = (const char*)g.Bt + (size_t)cur.pn * tstep + (size_t)cur.ko * 2;
    S.a_ready(cur);
    if constexpr (SP2) {
        PG8_STAGE(PG8_SB(0, 0), cB, voffB); PG8_STAGE(PG8_SB(0, 1), cB + hstep, voffB); PG8_STAGE(PG8_SA(0, 0), cA, voffA); PG8_STAGE(PG8_SA(0, 1), cA + hstep, voffA);
        if (wr == 1) PG8_BAR;
        PG8_WAIT_V(2); PG8_BAR;
        PG8_STAGE(PG8_SB(1, 0), cB + kstep, voffB); PG8_STAGE(PG8_SA(1, 0), cA + kstep, voffA); PG8_STAGE(PG8_SB(1, 1), cB + hstep + kstep, voffB);
        PG8_WAIT_V(6); PG8_BAR;
    } else {
        PG8_STAGE(PG8_SB(0, 0), cB, voffB); PG8_STAGE(PG8_SA(0, 0), cA, voffA); PG8_STAGE(PG8_SB(0, 1), cB + hstep, voffB); PG8_STAGE(PG8_SA(0, 1), cA + hstep, voffA);
        if (wr == 1) PG8_BAR;
        PG8_WAIT_V(4); PG8_BAR;
        PG8_STAGE(PG8_SB(1, 0), cB + kstep, voffB); PG8_STAGE(PG8_SA(1, 0), cA + kstep, voffA); PG8_STAGE(PG8_SB(1, 1), cB + hstep + kstep, voffB);
        PG8_WAIT_V(6); PG8_BAR;
    }
    for (;;) {
        const bool has_next = S.next(ui + 1, nxt);
        const char* nA = has_next ? (const char*)g.A + (size_t)nxt.pm * tstep + (size_t)nxt.ko * 2 : cA; const char* nB = has_next ? (const char*)g.Bt + (size_t)nxt.pn * tstep + (size_t)nxt.ko * 2 : cB;
        for (int t = 0; t < nt; t += 2) {
            const bool last = (t == nt - 2);
            const char* a1 = cA + (size_t)(t + 1) * kstep;
            const char* a2 = last ? nA : cA + (size_t)(t + 2) * kstep; const char* b2 = last ? nB : cB + (size_t)(t + 2) * kstep;
            const char* a3 = a2 + kstep; const char* b3 = b2 + kstep;
            if (last && has_next) S.a_ready(nxt);
            if constexpr (SP2) {
            PG8_LDB(B0, 0, 0); PG8_LDB(B1, 0, 1); PG8_SCHED; PG8_LDA(At, 0, 0); PG8_STAGE(PG8_SA(1, 1), a1 + hstep, voffA);
            PG8_WAIT_V(8); PG8_WAIT_L(0); PG8_BAR; PG8_MMA(0, 0, At, B0); PG8_MMA(0, 1, At, B1); PG8_BAR; PG8_SCHED;
            PG8_LDA(At, 0, 1); PG8_STAGE(PG8_SB(0, 0), b2, voffB); PG8_STAGE(PG8_SB(0, 1), b2 + hstep, voffB); PG8_STAGE(PG8_SA(0, 0), a2, voffA);
            PG8_WAIT_V(8); PG8_WAIT_L(0); PG8_BAR; PG8_MMA(1, 0, At, B0); PG8_MMA(1, 1, At, B1); PG8_BAR; PG8_SCHED;
            PG8_LDB(B0, 1, 0); PG8_LDB(B1, 1, 1); PG8_SCHED; PG8_LDA(At, 1, 0); PG8_STAGE(PG8_SA(0, 1), a2 + hstep, voffA);
            PG8_WAIT_V(8); PG8_WAIT_L(0); PG8_BAR; PG8_MMA(0, 0, At, B0); PG8_MMA(0, 1, At, B1); PG8_BAR; PG8_SCHED;
            PG8_LDA(At, 1, 1); PG8_STAGE(PG8_SB(1, 0), b3, voffB); PG8_STAGE(PG8_SB(1, 1), b3 + hstep, voffB); PG8_STAGE(PG8_SA(1, 0), a3, voffA);
            PG8_WAIT_V(8); PG8_WAIT_L(0); PG8_BAR; PG8_MMA(1, 0, At, B0); PG8_MMA(1, 1, At, B1); PG8_BAR; PG8_SCHED;
            } else {
            PG8_LDB(B0, 0, 0); PG8_SCHED; PG8_LDA(At, 0, 0); PG8_STAGE(PG8_SA(1, 1), a1 + hstep, voffA);
            PG8_WAIT_L(8); PG8_BAR; PG8_WAIT_L(0); PG8_MMA(0, 0, At, B0); PG8_BAR; PG8_SCHED;
            PG8_LDB(B1, 0, 1); PG8_STAGE(PG8_SB(0, 0), b2, voffB);
            PG8_BAR; PG8_WAIT_L(0); PG8_MMA(0, 1, At, B1); PG8_BAR;
            PG8_LDA(At, 0, 1); PG8_STAGE(PG8_SA(0, 0), a2, voffA);
            PG8_BAR; PG8_WAIT_L(0); PG8_MMA(1, 0, At, B0); PG8_BAR; PG8_SCHED;
            PG8_STAGE(PG8_SB(0, 1), b2 + hstep, voffB);
            PG8_WAIT_V(6); PG8_BAR; PG8_MMA(1, 1, At, B1); PG8_BAR;
            PG8_LDB(B0, 1, 0); PG8_SCHED; PG8_LDA(At, 1, 0); PG8_STAGE(PG8_SA(0, 1), a2 + hstep, voffA);
            PG8_WAIT_L(8); PG8_BAR; PG8_WAIT_L(0); PG8_MMA(0, 0, At, B0); PG8_BAR; PG8_SCHED;
            PG8_LDB(B1, 1, 1); PG8_STAGE(PG8_SB(1, 0), b3, voffB);
            PG8_BAR; PG8_WAIT_L(0); PG8_MMA(0, 1, At, B1); PG8_BAR;
            PG8_LDA(At, 1, 1); PG8_STAGE(PG8_SA(1, 0), a3, voffA);
            PG8_BAR; PG8_WAIT_L(0); PG8_MMA(1, 0, At, B0); PG8_BAR; PG8_SCHED;
            PG8_STAGE(PG8_SB(1, 1), b3 + hstep, voffB);
            PG8_WAIT_V(6); PG8_BAR; PG8_MMA(1, 1, At, B1); PG8_BAR;
            }
        }
        if constexpr (ALIGN_EPI) { if (wr == 0) PG8_BAR; }
        if constexpr (!Epi::AFTER_DRAIN) { E(acc, cur, wr, wc, fr, fq); S.done(cur); }
        if (!has_next) break;
#pragma unroll
        for (int a = 0; a < 2; ++a)
#pragma unroll
            for (int b = 0; b < 2; ++b)
#pragma unroll
                for (int m = 0; m < 4; ++m)
#pragma unroll
                    for (int n = 0; n < 2; ++n) acc[a][b][m][n] = (f32x4){0.f, 0.f, 0.f, 0.f};
        cur = nxt; cA = nA; cB = nB; ++ui;
        if constexpr (ALIGN_EPI) { if (wr == 1) PG8_BAR; }
    }
    PG8_WAIT_V(0);
    if constexpr (!ALIGN_EPI) { if (wr == 0) PG8_BAR; }
    PG8_BAR;
    if constexpr (Epi::AFTER_DRAIN) { E.fused(acc, cur, wr, wc, fr, fq, lds, wid, lane); S.done(cur); }
#undef PG8_SA
#undef PG8_SB
#undef PG8_STAGE
#undef PG8_LDA
#undef PG8_LDB
#undef PG8_MMA
#undef PG8_WAIT_V
#undef PG8_WAIT_L
#undef PG8_BAR
#undef PG8_SCHED
}
}
#define GAS __attribute__((address_space(1)))
#define LAS __attribute__((address_space(3)))
typedef unsigned short bf16;
typedef unsigned v4u __attribute__((ext_vector_type(4)));
typedef float f32x4 __attribute__((ext_vector_type(4)));
typedef short bf16x8 __attribute__((ext_vector_type(8)));
typedef GAS unsigned gu32;
typedef GAS unsigned long long gu64;
#define RLX_AGENT __ATOMIC_RELAXED, __HIP_MEMORY_SCOPE_AGENT
#define LDS_WAIT() asm volatile("s_waitcnt lgkmcnt(0)" ::: "memory")
#define VM_WAIT() asm volatile("s_waitcnt vmcnt(0)" ::: "memory")
__device__ __forceinline__ unsigned long long rt() { return __builtin_amdgcn_s_memrealtime(); }
__device__ __forceinline__ unsigned f2bf(float f) { unsigned u = __builtin_bit_cast(unsigned, f); return (u + 0x7fffu + ((u >> 16) & 1u)) >> 16; }
__device__ __forceinline__ unsigned pk2(float lo, float hi) { return f2bf(lo) | (f2bf(hi) << 16); }

#define XB_TMO      128
#define XB_XCNT(j)  (256  + 64 * (j))
#define XB_XSUB(j)  (1280 + 64 * (j))
#define XB_XGEN(j)  (2304 + 64 * (j))
#define XB_TOP      3328
#define XB_TOPGEN   3392
#define XCD_BAR_WORDS 3456
#define XB_SPIN_CAP (1u << 24)

__device__ __forceinline__ unsigned xb_ld(unsigned* p)              { return __hip_atomic_load(p, __ATOMIC_RELAXED, __HIP_MEMORY_SCOPE_AGENT); }
__device__ __forceinline__ unsigned xb_add(unsigned* p, unsigned v) { return __hip_atomic_fetch_add(p, v, __ATOMIC_RELAXED, __HIP_MEMORY_SCOPE_AGENT); }
__device__ __forceinline__ unsigned xb_xcc_id() { return (unsigned)__builtin_amdgcn_s_getreg((3 << 11) | 20) & 0xFu; }
#define XB_SPIN(cond, bar) do { unsigned _sp = 0; while (cond) { __builtin_amdgcn_s_sleep(1); \
    if ((++_sp & 255u) == 0u) { if (xb_ld(&(bar)[XB_TMO])) break; if (_sp > XB_SPIN_CAP) { atomicAdd(&(bar)[XB_TMO], 1u); break; } } } } while (0)

struct XcdBarrier {
    unsigned* bar; unsigned x;
    volatile LAS unsigned* st;
};

__device__ __forceinline__ XcdBarrier xcd_barrier_post(unsigned* bar, volatile LAS unsigned* st) {
    XcdBarrier b; b.bar = bar; b.x = xb_xcc_id(); b.st = st;
    if (threadIdx.x == 0) (void)xb_add(&bar[XB_XCNT(b.x)], 1u);
    return b;
}
__device__ __forceinline__ void xcd_barrier_complete(unsigned* bar, unsigned x, unsigned& nloc, unsigned& nx) {
    const unsigned G = gridDim.x * gridDim.y * gridDim.z;
    unsigned sum, cnt, mine, sp = 0u;
    for (;;) {
        sum = 0u; cnt = 0u; mine = 0u;
#pragma unroll
        for (unsigned j = 0; j < 16; ++j) { const unsigned c = xb_ld(&bar[XB_XCNT(j)]); sum += c; cnt += (c > 0u) ? 1u : 0u; mine = (j == x) ? c : mine; }
        if (sum == G) break;
        __builtin_amdgcn_s_sleep(1);
        if ((++sp & 255u) == 0u) { if (xb_ld(&bar[XB_TMO])) break; if (sp > XB_SPIN_CAP) { atomicAdd(&bar[XB_TMO], 1u); break; } }
    }
    nloc = mine > 0u ? mine : 1u; nx = cnt > 0u ? cnt : 1u;
}

__device__ __forceinline__ void xcd_barrier(const XcdBarrier& b) {
    asm volatile("s_waitcnt vmcnt(0)" ::: "memory");
    __syncthreads();
    if (threadIdx.x == 0) {
        unsigned* bar = b.bar;
        __builtin_amdgcn_s_waitcnt(0);
        unsigned nloc = b.st[0], nx = b.st[1];
        if (nloc == 0u) { xcd_barrier_complete(bar, b.x, nloc, nx); b.st[0] = nloc; b.st[1] = nx; }
        const unsigned old = xb_add(&bar[XB_XSUB(b.x)], 1u);
        const unsigned gen = old / nloc;
        if (old + 1u == (gen + 1u) * nloc) {
            __builtin_amdgcn_fence(__ATOMIC_RELEASE, "agent");
            asm volatile("s_waitcnt vmcnt(0)" ::: "memory");
            const unsigned og = xb_add(&bar[XB_TOP], 1u);
            const unsigned tg = og / nx;
            if (og + 1u == (tg + 1u) * nx) xb_add(&bar[XB_TOPGEN], 1u);
            else XB_SPIN(xb_ld(&bar[XB_TOPGEN]) == tg, bar);
            __builtin_amdgcn_fence(__ATOMIC_ACQUIRE, "agent");
            xb_add(&bar[XB_XGEN(b.x)], 1u);
            asm volatile("s_waitcnt vmcnt(0)" ::: "memory");
        } else {
            XB_SPIN(xb_ld(&bar[XB_XGEN(b.x)]) == gen, bar);
            __builtin_amdgcn_fence(__ATOMIC_ACQUIRE, "agent");
            asm volatile("s_waitcnt vmcnt(0)" ::: "memory");
        }
    }
    __syncthreads();
}

constexpr int NWAVES = 8;
constexpr int BATCH = 4, SEQ = 2048, DM = 4096, M = BATCH * SEQ;
constexpr int HD = 128, NHA = 16, NKV = 4, GRP = 4, NHB = 16;
constexpr int CIN = 15408, NP = 15616;
constexpr int LDP = NP;
constexpr int C_QA = 0, C_ZA = 2048, C_KC = 4096, C_VC = 4608, C_KSL = 5120, C_VSL = 5632, C_KW = 6144, C_VW = 6656,
              C_QB = 7168, C_KB = 9216, C_VB = 11264, C_ZB = 13312, C_GA = 15360;
constexpr int NCMP = 127, NSEL = 32, TOPN = 16;
constexpr float EPS = 1e-6f;
constexpr float QSCALE = 0.08838834764831845f;

constexpr size_t MiB = 1u << 20;
constexpr size_t WS_CTL = 0, CTL_ZERO_BYTES = 1 * MiB;
constexpr size_t WS_WIN = 2 * MiB;
constexpr size_t WS_WOUT = 124 * MiB;
constexpr size_t WS_HB = 160 * MiB;
constexpr size_t WS_P = 224 * MiB;
constexpr size_t WS_QR = 468 * MiB;
constexpr size_t WS_COS = 500 * MiB;
constexpr size_t WS_SIN = 502 * MiB;
constexpr size_t WS_MIX = 504 * MiB;
constexpr size_t WS_Y = 568 * MiB;
constexpr size_t WS_KCMP = 696 * MiB;
constexpr size_t WS_VCMP = 697 * MiB;
constexpr size_t WS_BIAS1 = 698 * MiB;
constexpr size_t WS_SEL = 699 * MiB;
constexpr size_t WS_OC = 704 * MiB;
constexpr size_t WS_OS = 768 * MiB;
constexpr size_t WS_XKV = 832 * MiB;
constexpr size_t WS_WLR = 848 * MiB;
constexpr size_t WS_KCB = 852 * MiB;
constexpr size_t WS_VCB = 853 * MiB;
constexpr size_t WS_LR = WS_Y;
constexpr size_t WS_END = 854 * MiB;
constexpr int CW_BAR = 4096;

constexpr int RING_OFF = 0, RING_BYTES = 131072;
constexpr int LDSCTL_OFF = RING_BYTES, MISC_OFF = LDSCTL_OFF + 320;
constexpr int LDS_BYTES = 147456;

__device__ __forceinline__ float bf2f(unsigned short u) { return __builtin_bit_cast(float, (unsigned)u << 16); }
__device__ __forceinline__ float wave_sum(float v) {
#pragma unroll
    for (int o = 1; o < 64; o <<= 1) v += __shfl_xor(v, o);
    return v;
}
__device__ __forceinline__ float wave_max(float v) {
#pragma unroll
    for (int o = 1; o < 64; o <<= 1) v = fmaxf(v, __shfl_xor(v, o));
    return v;
}

struct Args {
    const float* x; const int* pos; const float* pre_w; const float* post_w; const float* w_in; const float* b_gate;
    const float* pe_k; const float* pe_v; const float* wk1; const float* wk2; const float* wv1; const float* wv2; const float* w_out;
    float* out; unsigned char* ws; int ph_lo, ph_hi;
};

struct Ctx {
    LAS unsigned char* lds; int tid, lane, wave, G, bid, gw, NGW;
};

__host__ __device__ __forceinline__ int rope_phi(int d) { const int dd = d & 63; return 32 * (dd >> 4) + 8 * ((dd >> 2) & 3) + 4 * (d >> 6) + (dd & 3); }
__device__ __forceinline__ void transpose_item(const float* W, int ldw, int K, int k0, int c0, int ncols, bf16* WT, int r0, LAS float* scr, int lane, bool perm = false) {
#pragma unroll 8
    for (int i = 0; i < 32; ++i) { const int kk = 2 * i + (lane >> 5), n = lane & 31; scr[kk * 33 + n] = (n < ncols) ? W[(size_t)(k0 + kk) * ldw + c0 + n] : 0.f; }
    LDS_WAIT(); asm volatile("" ::: "memory");
    const int c = lane & 7;
#pragma unroll
    for (int j = 0; j < 4; ++j) { const int n = (lane >> 3) + 8 * j; const LAS float* s = scr + (8 * c) * 33 + n;
        v4u o; o.x = pk2(s[0 * 33], s[1 * 33]); o.y = pk2(s[2 * 33], s[3 * 33]); o.z = pk2(s[4 * 33], s[5 * 33]); o.w = pk2(s[6 * 33], s[7 * 33]);
        const int drow = perm ? (r0 & ~127) + rope_phi((r0 & 127) + n) : r0 + n;
        if (n < ncols) *(GAS v4u*)(WT + (size_t)drow * K + k0 + 8 * c) = o; }
    LDS_WAIT(); asm volatile("" ::: "memory");
}

__device__ __forceinline__ void p0_transposes(const Args& a, const Ctx& c, int it0, int it1, int widx, int nw) {
    unsigned char* ws = a.ws;
    bf16* WinT = (bf16*)(ws + WS_WIN); bf16* WoutT = (bf16*)(ws + WS_WOUT);
    LAS float* scr = (LAS float*)(c.lds + RING_OFF + c.wave * 16384);
    constexpr int NB_IN = 482, I_IN = 64 * NB_IN, I_OUT = 64 * 128, I_LR = 4 * 32 * 8, I_ALL = I_IN + I_OUT + I_LR;
    bf16* WLR = (bf16*)(ws + WS_WLR);
    struct TItem { const float* src; bf16* dst; int ldw, K, ncols; bool perm; int r0; };
    auto decode = [&](int it) -> TItem {
        TItem t;
        if (it < I_IN) {
            const int kb = it / NB_IN, nb = it % NB_IN; int c0, r0, nc = 32;
            if (nb < 128) { c0 = nb * 32; r0 = nb * 32; }
            else if (nb < 224) { c0 = 4144 + (nb - 128) * 32; r0 = 4096 + (nb - 128) * 32; }
            else if (nb < 480) { c0 = 7216 + (nb - 224) * 32; r0 = 7168 + (nb - 224) * 32; }
            else { c0 = 4096 + (nb - 480) * 32; r0 = C_GA + (nb - 480) * 32; nc = (nb == 480) ? 32 : 16; }
            t.perm = (r0 < 2048) || (r0 >= C_KSL && r0 < C_VSL) || (r0 >= C_KW && r0 < C_VW) || (r0 >= C_QB && r0 < C_VB);
            t.src = a.w_in + (size_t)(kb * 64) * CIN + c0; t.ldw = CIN; t.K = DM; t.ncols = nc; t.dst = WinT + kb * 64; t.r0 = r0;
        } else if (it < I_IN + I_OUT) {
            const int r = it - I_IN, kb = r / 128, nb = r % 128;
            t.perm = false; t.src = a.w_out + (size_t)(kb * 64) * DM + nb * 32; t.ldw = DM; t.K = DM; t.ncols = 32; t.dst = WoutT + kb * 64; t.r0 = nb * 32;
        } else {
            const int r = it - I_IN - I_OUT, part = r >> 8, kb = (r >> 3) & 31, nb = r & 7;
            t.perm = false; t.src = ((part >> 1) ? a.wv1 : a.wk1) + (size_t)((part & 1) * 2048 + kb * 64) * 256 + nb * 32; t.ldw = 256; t.K = 2048; t.ncols = 32;
            t.dst = WLR + kb * 64; t.r0 = part * 256 + nb * 32;
        }
        return t;
    };
    {
        const int kr = c.lane >> 3, nq = (c.lane & 7) * 4;
        f32x4 v[8];
        int it = it0 + widx; bool have = it < it1; TItem cur{};
        if (have) { cur = decode(it);
#pragma unroll
            for (int i = 0; i < 8; ++i) v[i] = (nq < cur.ncols) ? __builtin_nontemporal_load((const GAS f32x4*)(cur.src + (size_t)(8 * i + kr) * cur.ldw + nq)) : (f32x4){0.f, 0.f, 0.f, 0.f}; }
        while (have) {
#pragma unroll
            for (int i = 0; i < 8; ++i) { LAS float* d = scr + (8 * i + kr) * 33 + nq; d[0] = v[i].x; d[1] = v[i].y; d[2] = v[i].z; d[3] = v[i].w; }
            const int nit = it + nw; const bool hn = nit < it1; TItem nx{};
            if (hn) { nx = decode(nit);
#pragma unroll
                for (int i = 0; i < 8; ++i) v[i] = (nq < nx.ncols) ? __builtin_nontemporal_load((const GAS f32x4*)(nx.src + (size_t)(8 * i + kr) * nx.ldw + nq)) : (f32x4){0.f, 0.f, 0.f, 0.f}; }
            LDS_WAIT(); asm volatile("" ::: "memory");
            const int cc = c.lane & 7;
#pragma unroll
            for (int j = 0; j < 4; ++j) { const int n = (c.lane >> 3) + 8 * j; const LAS float* sp = scr + (8 * cc) * 33 + n;
                v4u o; o.x = pk2(sp[0 * 33], sp[1 * 33]); o.y = pk2(sp[2 * 33], sp[3 * 33]); o.z = pk2(sp[4 * 33], sp[5 * 33]); o.w = pk2(sp[6 * 33], sp[7 * 33]);
                const int drow = cur.perm ? (cur.r0 & ~127) + rope_phi((cur.r0 & 127) + n) : cur.r0 + n;
                if (n < cur.ncols) *(GAS v4u*)(cur.dst + (size_t)drow * cur.K + 8 * cc) = o; }
            LDS_WAIT(); asm volatile("" ::: "memory");
            it = nit; have = hn; cur = nx;
        }
    }
}
constexpr int TI_IN = 64 * 482, TI_ALL = TI_IN + 64 * 128 + 4 * 32 * 8;

__device__ __forceinline__ void p0_prologue(const Args& a, const Ctx& c) {
    unsigned char* ws = a.ws;
    bf16* WinT = (bf16*)(ws + WS_WIN); bf16* HB = (bf16*)(ws + WS_HB);
    p0_transposes(a, c, 0, TI_IN, c.gw, c.NGW);
    for (int e = c.gw * 64 + c.lane; e < (NP - CIN) * (DM / 8); e += c.NGW * 64)
        *(GAS v4u*)(WinT + (size_t)CIN * DM + (size_t)e * 8) = (v4u){0u, 0u, 0u, 0u};
    for (int m = c.gw; m < M; m += c.NGW) {
        const GAS f32x4* xr = (const GAS f32x4*)(a.x + (size_t)m * DM) + c.lane;
        f32x4 v[16]; float s = 0.f;
#pragma unroll
        for (int j = 0; j < 16; ++j) { v[j] = __builtin_nontemporal_load(xr + 64 * j); s += (v[j].x * v[j].x + v[j].y * v[j].y) + (v[j].z * v[j].z + v[j].w * v[j].w); }
        const float rstd = 1.0f / sqrtf(wave_sum(s) * (1.0f / DM) + EPS);
        GAS unsigned long long* o8 = (GAS unsigned long long*)(HB + (size_t)m * DM) + c.lane;
#pragma unroll
        for (int j = 0; j < 16; ++j) { const f32x4 w = ((const GAS f32x4*)a.pre_w)[c.lane + 64 * j];
            o8[64 * j] = (unsigned long long)pk2(v[j].x * rstd * w.x, v[j].y * rstd * w.y) | ((unsigned long long)pk2(v[j].z * rstd * w.z, v[j].w * rstd * w.w) << 32); }
    }
    {
        float* COS = (float*)(ws + WS_COS); float* SIN = (float*)(ws + WS_SIN);
        for (int e = c.gw * 64 + c.lane; e < M * 64; e += c.NGW * 64) {
            const int m = e >> 6, i = e & 63;
            double inv = 1.0; for (int k = 0; k < i; ++k) inv *= 0.8659643233600653;
            const double ang = (double)a.pos[m] * inv;
            const double TWO_PI = 6.283185307179586476925286766559;
            const double n = __builtin_rint(ang / TWO_PI);
            const double r = ang - n * TWO_PI;
            const double r2 = r * r;
            double sn = 0.0, cs = 0.0;
            double ts = r, tc = 1.0;
#pragma unroll
            for (int k = 0; k < 14; ++k) { sn += ts; cs += tc; ts *= -r2 / (double)((2 * k + 2) * (2 * k + 3)); tc *= -r2 / (double)((2 * k + 1) * (2 * k + 2)); }
            COS[e] = (float)cs; SIN[e] = (float)sn;
        }
    }
    {
        float* BP = (float*)(ws + WS_BIAS1);
        for (int o = c.gw; o < 128; o += c.NGW) {
            const int kv = o >> 6, ch = o & 63; const float* pe = (kv ? a.pe_v : a.pe_k) + ch * 64; const float* w1 = (kv ? a.wv1 : a.wk1) + (size_t)ch * 64 * 256;
            float s0 = 0.f, s1 = 0.f, s2 = 0.f, s3 = 0.f;
            for (int i = 0; i < 64; ++i) { const float p = pe[i]; const float* wr = w1 + i * 256 + c.lane; s0 += p * wr[0]; s1 += p * wr[64]; s2 += p * wr[128]; s3 += p * wr[192]; }
            float* d = BP + (size_t)o * 256 + c.lane; d[0] = s0; d[64] = s1; d[128] = s2; d[192] = s3;
        }
    }
}

__device__ __forceinline__ float gelu_tanh(float x) {
    const float u = 0.7978845608028654f * (x + 0.044715f * x * x * x);
    const float e = __expf(2.0f * u);
    const float th = 1.0f - 2.0f / (e + 1.0f);
    return 0.5f * x * (1.0f + th);
}

__device__ __forceinline__ void p2c_stage2(const Args& a, const Ctx& c) {
    unsigned char* ws = a.ws;
    const float* LR = (const float*)(ws + WS_LR); const float* B1 = (const float*)(ws + WS_BIAS1);
    LAS float* Gs = (LAS float*)(c.lds + RING_OFF);
    bf16* KCB = (bf16*)(ws + WS_KCB); bf16* VCB = (bf16*)(ws + WS_VCB);
    for (int e = c.gw * 64 + c.lane; e < 2 * 16 * 128; e += c.NGW * 64) { bf16* dst = (e >> 11) ? VCB : KCB; dst[(size_t)((e >> 7) & 15) * 128 * 128 + 127 * 128 + (e & 127)] = 0; }
    for (int it = c.bid; it < 2 * 127; it += c.G) {
        const int kv = it / 127, rb = it % 127;
        const float* w2 = kv ? a.wv2 : a.wk2;
        float* OUT = (float*)(ws + (kv ? WS_VCMP : WS_KCMP)); bf16* OUTB = kv ? VCB : KCB;
        const int n = c.tid & 255, half = c.tid >> 8;
        float b1 = 0.f;
        for (int ch = 0; ch < 64; ++ch) b1 += B1[(size_t)(kv * 64 + ch) * 256 + n];
        __syncthreads();
#pragma unroll
        for (int r = 0; r < 8; ++r) { const int R = rb * 16 + half * 8 + r, bh = R / 127, cc = R % 127; const size_t rowL = (size_t)kv * 2048 + bh * 128 + cc;
            float h = b1;
#pragma unroll
            for (int ks = 0; ks < 8; ++ks) { const float* p = LR + (size_t)ks * 4096 * 1024 + rowL * 1024 + kv * 512 + n; h += p[0] + p[1024 + 256]; }
            Gs[(half * 8 + r) * 256 + n] = gelu_tanh(h); }
        __syncthreads();
        const int d = c.tid & 127, rq = c.tid >> 7;
        float o[4] = {0.f, 0.f, 0.f, 0.f};
        for (int nn = 0; nn < 256; ++nn) { const float w = w2[nn * 128 + d];
#pragma unroll
            for (int r = 0; r < 4; ++r) o[r] += Gs[(rq * 4 + r) * 256 + nn] * w; }
#pragma unroll
        for (int r = 0; r < 4; ++r) { const int R = rb * 16 + rq * 4 + r, bh = R / 127, cc = R % 127; const int dd = kv ? d : rope_phi(d);
            OUT[(size_t)(bh * 128 + cc) * 128 + dd] = o[r]; OUTB[(size_t)(bh * 128 + cc) * 128 + dd] = (bf16)f2bf(o[r]); }
    }
}

namespace fa {
typedef short s16x4 __attribute__((ext_vector_type(4)));
typedef float f32x16 __attribute__((ext_vector_type(16)));
typedef unsigned u32x4 __attribute__((ext_vector_type(4)));
constexpr int KVBLK = 64, SHM_K = KVBLK * 128 * 2, SHM_V = SHM_K;
constexpr int BUFS = SHM_V + SHM_K, A_V = 0, A_K = SHM_V, A_WS = 3 * BUFS;
constexpr float SCALE = 0.08838834764831845f, THR = 8.f;
constexpr float C2 = 1.4426950408889634f * SCALE;
constexpr float DBL = 1.0f / C2;
#define FA_KSWZ(row, colB) ((row) * 256 + ((colB) ^ (((row) & 7) << 4)))
#define FA_SBAR() __builtin_amdgcn_sched_barrier(0)
__device__ __forceinline__ int v_st(int k, int c) { const int kk = (k & ~0xC) | ((k & 4) << 1) | ((k & 8) >> 1); return ((kk >> 3) * 4 + (c >> 5)) * 512 + ((kk & 7) * 32 + (c & 31)) * 2; }
__device__ __forceinline__ int v_rd_base(int lane) { return ((lane & 3) << 3) | (((lane >> 2) & 3) << 6) | (((lane >> 4) & 1) << 5) | (((lane >> 5) & 1) << 8); }
constexpr int v_rd_off(int d0, int ks, int half) { return d0 * 512 + ks * 4096 + half * 2048; }
__device__ __forceinline__ int crow(int r, int hi) { return (r & 3) + 8 * (r >> 2) + 4 * hi; }
__device__ __forceinline__ unsigned cvtpk(float lo, float hi) { unsigned r; asm volatile("v_cvt_pk_bf16_f32 %0, %1, %2" : "=v"(r) : "v"(lo), "v"(hi)); return r; }

__device__ __forceinline__ void mask_tile(f32x16& p0, f32x16& p1, int dq, unsigned W) {
    const float NEG = -__builtin_inff();
#pragma unroll
    for (int r = 0; r < 16; ++r) {
        const int c = (r & 3) + 8 * (r >> 2);
        if ((unsigned)(dq - c) >= W) p0[r] = NEG;
        if ((unsigned)(dq - c - 32) >= W) p1[r] = NEG;
    }
}
__device__ __forceinline__ void mask_dil(f32x16& p0, f32x16& p1, int dq) {
    const float NEG = -__builtin_inff();
#pragma unroll
    for (int r = 0; r < 16; ++r) {
        const int c = (r & 3) + 8 * (r >> 2);
        { const int dl = dq - c; const bool nr = (unsigned)dl <= 128u, m4 = dl >= 0 && (dl & 3) == 0; const float v = p0[r];
          p0[r] = nr ? (m4 ? v + DBL : v) : (m4 ? v : NEG); }
        { const int dl = dq - c - 32; const bool nr = (unsigned)dl <= 128u, m4 = dl >= 0 && (dl & 3) == 0; const float v = p1[r];
          p1[r] = nr ? (m4 ? v + DBL : v) : (m4 ? v : NEG); }
    }
}
__device__ __forceinline__ void partialSM(f32x16& p0, f32x16& p1, float& m_reg, float& mn, float& alpha, bool drop) {
    float pmax = p0[0];
#pragma unroll
    for (int r = 1; r < 16; ++r) pmax = fmaxf(pmax, p0[r]);
#pragma unroll
    for (int r = 0; r < 16; ++r) pmax = fmaxf(pmax, p1[r]);
    { auto rr = __builtin_amdgcn_permlane32_swap(__float_as_uint(pmax), __float_as_uint(pmax), false, false);
      pmax = fmaxf(__uint_as_float(rr[0]), __uint_as_float(rr[1])); }
    if (drop) pmax = -__builtin_inff();
    if (__builtin_expect(__all((pmax - m_reg) * SCALE <= THR), 1)) { mn = m_reg; alpha = 1.f; }
    else { mn = fmaxf(m_reg, pmax); alpha = __builtin_amdgcn_exp2f((m_reg - mn) * C2); m_reg = mn; }
    const float mnL = drop ? -__builtin_inff() : -mn * C2;
#pragma unroll
    for (int r = 0; r < 16; ++r) p0[r] = fmaf(p0[r], C2, mnL);
#pragma unroll
    for (int r = 0; r < 16; ++r) p1[r] = fmaf(p1[r], C2, mnL);
#pragma unroll
    for (int r = 0; r < 16; ++r) p0[r] = __builtin_amdgcn_exp2f(p0[r]);
}
__device__ __forceinline__ void finishSM(f32x16& p0, f32x16& p1, float alpha, float& l_reg, bf16x8& pa0, bf16x8& pa1, bf16x8& pa2, bf16x8& pa3) {
#pragma unroll
    for (int r = 0; r < 16; ++r) p1[r] = __builtin_amdgcn_exp2f(p1[r]);
    float ps = 0;
#pragma unroll
    for (int r = 0; r < 16; ++r) ps += p0[r];
#pragma unroll
    for (int r = 0; r < 16; ++r) ps += p1[r];
    { auto rr = __builtin_amdgcn_permlane32_swap(__float_as_uint(ps), __float_as_uint(ps), false, false);
      ps = __uint_as_float(rr[0]) + __uint_as_float(rr[1]); }
    l_reg = l_reg * alpha + ps;
#define FA_PK4(P, B_, OUT) do { unsigned a0 = cvtpk(P[B_+0], P[B_+1]), a1 = cvtpk(P[B_+2], P[B_+3]);                          \
        unsigned b0 = cvtpk(P[B_+4], P[B_+5]), b1 = cvtpk(P[B_+6], P[B_+7]);                                             \
        auto r0 = __builtin_amdgcn_permlane32_swap(a0, b0, false, false); auto r1 = __builtin_amdgcn_permlane32_swap(a1, b1, false, false); \
        u32x4 w = {r0[0], r1[0], r0[1], r1[1]}; OUT = __builtin_bit_cast(bf16x8, w); } while (0)
    FA_PK4(p0, 0, pa0); FA_PK4(p0, 8, pa1); FA_PK4(p1, 0, pa2); FA_PK4(p1, 8, pa3);
#undef FA_PK4
}
__device__ __forceinline__ void pack_p(const f32x16& p0, const f32x16& p1, bf16x8& pa0, bf16x8& pa1, bf16x8& pa2, bf16x8& pa3) {
#define FA_PK4(P, B_, OUT) do { unsigned a0 = cvtpk(P[B_+0], P[B_+1]), a1 = cvtpk(P[B_+2], P[B_+3]);                          \
        unsigned b0 = cvtpk(P[B_+4], P[B_+5]), b1 = cvtpk(P[B_+6], P[B_+7]);                                             \
        auto r0 = __builtin_amdgcn_permlane32_swap(a0, b0, false, false); auto r1 = __builtin_amdgcn_permlane32_swap(a1, b1, false, false); \
        u32x4 w = {r0[0], r1[0], r0[1], r1[1]}; OUT = __builtin_bit_cast(bf16x8, w); } while (0)
    FA_PK4(p0, 0, pa0); FA_PK4(p0, 8, pa1); FA_PK4(p1, 0, pa2); FA_PK4(p1, 8, pa3);
#undef FA_PK4
}
template <int KB>
__device__ __forceinline__ void qkt(f32x16& p0, f32x16& p1, const LAS char* K_lds, int r32, int hi, const bf16x8 (&qr)[8]) {
#pragma unroll
    for (int r = 0; r < 16; ++r) { p0[r] = 0.f; p1[r] = 0.f; }
    const LAS char* kb[4];
#pragma unroll
    for (int dd = 0; dd < 4; ++dd) kb[dd] = K_lds + KB * BUFS + FA_KSWZ(r32, (dd * 16 + hi * 8) * 2);
#pragma unroll
    for (int d0 = 0; d0 < 8; ++d0) { const LAS char* a = kb[d0 & 3] + (d0 >> 2) * 128;
        const bf16x8 b0 = *(const LAS bf16x8*)a;
        const bf16x8 b1 = *(const LAS bf16x8*)(a + 32 * 256);
        p0 = __builtin_amdgcn_mfma_f32_32x32x16_bf16(b0, qr[d0], p0, 0, 0, 0);
        p1 = __builtin_amdgcn_mfma_f32_32x32x16_bf16(b1, qr[d0], p1, 0, 0, 0); }
}
template <int VB>
__device__ __forceinline__ void pv_tile(f32x16 (&o)[4], int vb0, bf16x8 pa0, bf16x8 pa1, bf16x8 pa2, bf16x8 pa3) {
#define FA_TRRD(dst, off) asm volatile("ds_read_b64_tr_b16 %0, %1 offset:%2" : "=&v"(dst) : "v"(vb0), "i"(off) : "memory")
#define FA_PV_D0(d0) do { s16x4 l0, l1, l2, l3, h0, h1, h2, h3; constexpr int b_ = A_V + VB * BUFS + v_rd_off(d0, 0, 0); \
        FA_TRRD(l0, b_); FA_TRRD(h0, b_ + 2048); FA_TRRD(l1, b_ + 4096); FA_TRRD(h1, b_ + 6144); FA_TRRD(l2, b_ + 8192); FA_TRRD(h2, b_ + 10240); FA_TRRD(l3, b_ + 12288); FA_TRRD(h3, b_ + 14336); \
        asm volatile("s_waitcnt lgkmcnt(0)" ::: "memory"); FA_SBAR(); \
        o[d0] = __builtin_amdgcn_mfma_f32_32x32x16_bf16(pa0, (bf16x8){l0[0], l0[1], l0[2], l0[3], h0[0], h0[1], h0[2], h0[3]}, o[d0], 0, 0, 0);   \
        o[d0] = __builtin_amdgcn_mfma_f32_32x32x16_bf16(pa1, (bf16x8){l1[0], l1[1], l1[2], l1[3], h1[0], h1[1], h1[2], h1[3]}, o[d0], 0, 0, 0);   \
        o[d0] = __builtin_amdgcn_mfma_f32_32x32x16_bf16(pa2, (bf16x8){l2[0], l2[1], l2[2], l2[3], h2[0], h2[1], h2[2], h2[3]}, o[d0], 0, 0, 0);   \
        o[d0] = __builtin_amdgcn_mfma_f32_32x32x16_bf16(pa3, (bf16x8){l3[0], l3[1], l3[2], l3[3], h3[0], h3[1], h3[2], h3[3]}, o[d0], 0, 0, 0); } while (0)
    FA_PV_D0(0); FA_PV_D0(1); FA_PV_D0(2); FA_PV_D0(3);
#undef FA_PV_D0
#undef FA_TRRD
}

__device__ __forceinline__ void mask_half(f32x16& p, int dq, unsigned W) {
    const float NEG = -__builtin_inff();
#pragma unroll
    for (int r = 0; r < 16; ++r) { const int c = (r & 3) + 8 * (r >> 2); if ((unsigned)(dq - c) >= W) p[r] = NEG; }
}
__device__ __forceinline__ void mask_dil_half(f32x16& p, int dq) {
    const float NEG = -__builtin_inff();
#pragma unroll
    for (int r = 0; r < 16; ++r) { const int c = (r & 3) + 8 * (r >> 2); const int dl = dq - c; const bool nr = (unsigned)dl <= 128u, m4 = dl >= 0 && (dl & 3) == 0; const float v = p[r];
        p[r] = nr ? (m4 ? v + DBL : v) : (m4 ? v : NEG); }
}
template <int KB, int H>
__device__ __forceinline__ void qk_half(f32x16& p, const LAS char* K_lds, int r32, int hi, const bf16x8 (&qr)[8]) {
#pragma unroll
    for (int r = 0; r < 16; ++r) p[r] = 0.f;
    const LAS char* kb[4];
#pragma unroll
    for (int dd = 0; dd < 4; ++dd) kb[dd] = K_lds + KB * BUFS + H * 32 * 256 + FA_KSWZ(r32, (dd * 16 + hi * 8) * 2);
#pragma unroll
    for (int d0 = 0; d0 < 8; ++d0) { const bf16x8 b0 = *(const LAS bf16x8*)(kb[d0 & 3] + (d0 >> 2) * 128); p = __builtin_amdgcn_mfma_f32_32x32x16_bf16(b0, qr[d0], p, 0, 0, 0); }
}
template <int KB, int H>
__device__ __forceinline__ void k_reads(const LAS char* K_lds, int r32, int hi, bf16x8 (&kf)[8]) {
    const unsigned a0 = (unsigned)(uintptr_t)(K_lds + KB * BUFS + FA_KSWZ(r32, (0 * 16 + hi * 8) * 2)), a1 = (unsigned)(uintptr_t)(K_lds + KB * BUFS + FA_KSWZ(r32, (1 * 16 + hi * 8) * 2)),
                   a2 = (unsigned)(uintptr_t)(K_lds + KB * BUFS + FA_KSWZ(r32, (2 * 16 + hi * 8) * 2)), a3 = (unsigned)(uintptr_t)(K_lds + KB * BUFS + FA_KSWZ(r32, (3 * 16 + hi * 8) * 2));
#define FA_KRD(dst, ad, off) asm volatile("ds_read_b128 %0, %1 offset:%2" : "=&v"(dst) : "v"(ad), "i"(off) : "memory")
    FA_KRD(kf[0], a0, H * 8192); FA_KRD(kf[1], a1, H * 8192); FA_KRD(kf[2], a2, H * 8192); FA_KRD(kf[3], a3, H * 8192);
    FA_KRD(kf[4], a0, H * 8192 + 128); FA_KRD(kf[5], a1, H * 8192 + 128); FA_KRD(kf[6], a2, H * 8192 + 128); FA_KRD(kf[7], a3, H * 8192 + 128);
#undef FA_KRD
}
__device__ __forceinline__ void qk_mma(f32x16& p, const bf16x8 (&kf)[8], const bf16x8 (&qr)[8]) {
#pragma unroll
    for (int r = 0; r < 16; ++r) p[r] = 0.f;
#pragma unroll
    for (int d0 = 0; d0 < 8; ++d0) p = __builtin_amdgcn_mfma_f32_32x32x16_bf16(kf[d0], qr[d0], p, 0, 0, 0);
}
__device__ __forceinline__ float sm_max(const f32x16& p, float& m_reg, bool drop, float& mnL) {
    float pmax = p[0];
#pragma unroll
    for (int r = 1; r < 16; ++r) pmax = fmaxf(pmax, p[r]);
    { auto rr = __builtin_amdgcn_permlane32_swap(__float_as_uint(pmax), __float_as_uint(pmax), false, false); pmax = fmaxf(__uint_as_float(rr[0]), __uint_as_float(rr[1])); }
    if (drop) pmax = -__builtin_inff();
    const bool keep = __all((pmax - m_reg) * SCALE <= THR);
    const float mn = keep ? m_reg : fmaxf(m_reg, pmax);
    const float alpha = __builtin_amdgcn_exp2f((m_reg - mn) * C2);
    m_reg = mn; mnL = drop ? -__builtin_inff() : -mn * C2;
    return alpha;
}
__device__ __forceinline__ void sm_exp(f32x16& p, float mnL, float alpha, float& l_reg, bf16x8& paA, bf16x8& paB) {
    float ps = 0.f;
#pragma unroll
    for (int r = 0; r < 16; ++r) { p[r] = __builtin_amdgcn_exp2f(fmaf(p[r], C2, mnL)); ps += p[r]; }
    { auto rr = __builtin_amdgcn_permlane32_swap(__float_as_uint(ps), __float_as_uint(ps), false, false); ps = __uint_as_float(rr[0]) + __uint_as_float(rr[1]); }
    l_reg = l_reg * alpha + ps;
#define FA_PK4(P, B_, OUT) do { unsigned a0 = cvtpk(P[B_+0], P[B_+1]), a1 = cvtpk(P[B_+2], P[B_+3]);                          \
        unsigned b0 = cvtpk(P[B_+4], P[B_+5]), b1 = cvtpk(P[B_+6], P[B_+7]);                                             \
        auto r0 = __builtin_amdgcn_permlane32_swap(a0, b0, false, false); auto r1 = __builtin_amdgcn_permlane32_swap(a1, b1, false, false); \
        u32x4 w = {r0[0], r1[0], r0[1], r1[1]}; OUT = __builtin_bit_cast(bf16x8, w); } while (0)
    FA_PK4(p, 0, paA); FA_PK4(p, 8, paB);
#undef FA_PK4
}
template <int VB, int H, int D0A = 0, int D0B = 4>
__device__ __forceinline__ void pv_reads(int vb0, s16x4 (&vl)[8], s16x4 (&vh)[8]) {
    const int vbb = vb0 + VB * BUFS;
#define FA_TRRD(dst, off) asm volatile("ds_read_b64_tr_b16 %0, %1 offset:%2" : "=&v"(dst) : "v"(vbb), "i"(off) : "memory")
#define FA_RD_D0(d0) do { constexpr int b_ = A_V + v_rd_off(d0, 2 * H, 0); \
        FA_TRRD(vl[2 * d0], b_); FA_TRRD(vh[2 * d0], b_ + 2048); FA_TRRD(vl[2 * d0 + 1], b_ + 4096); FA_TRRD(vh[2 * d0 + 1], b_ + 6144); } while (0)
    if constexpr (D0A <= 0 && 0 < D0B) FA_RD_D0(0); if constexpr (D0A <= 1 && 1 < D0B) FA_RD_D0(1); if constexpr (D0A <= 2 && 2 < D0B) FA_RD_D0(2); if constexpr (D0A <= 3 && 3 < D0B) FA_RD_D0(3);
#undef FA_RD_D0
#undef FA_TRRD
}
__device__ __forceinline__ void pv_mma(f32x16 (&o)[4], const s16x4 (&vl)[8], const s16x4 (&vh)[8], bf16x8 paA, bf16x8 paB) {
#pragma unroll
    for (int d0 = 0; d0 < 4; ++d0) {
        o[d0] = __builtin_amdgcn_mfma_f32_32x32x16_bf16(paA, (bf16x8){vl[2 * d0][0], vl[2 * d0][1], vl[2 * d0][2], vl[2 * d0][3], vh[2 * d0][0], vh[2 * d0][1], vh[2 * d0][2], vh[2 * d0][3]}, o[d0], 0, 0, 0);
        o[d0] = __builtin_amdgcn_mfma_f32_32x32x16_bf16(paB, (bf16x8){vl[2 * d0 + 1][0], vl[2 * d0 + 1][1], vl[2 * d0 + 1][2], vl[2 * d0 + 1][3], vh[2 * d0 + 1][0], vh[2 * d0 + 1][1], vh[2 * d0 + 1][2], vh[2 * d0 + 1][3]}, o[d0], 0, 0, 0); }
}

struct St { float m, l; f32x16 o[4]; };
__device__ __forceinline__ void st_init(St& S) { S.m = -1e30f; S.l = 0.f;
#pragma unroll
    for (int d = 0; d < 4; ++d)
#pragma unroll
        for (int r = 0; r < 16; ++r) S.o[d][r] = 0.f; }

struct MaskWin { int qlo, qm;
    __device__ __forceinline__ bool act(int t) const { const int kb = t * 64; return kb <= qlo + 31 && kb + 63 >= qlo - 511; }
    __device__ __forceinline__ void apply(f32x16& p0, f32x16& p1, int t) const { const int kb = t * 64; if (kb + 63 > qlo || kb <= qlo + 31 - 512) mask_tile(p0, p1, qm - kb, 512u); }
    __device__ __forceinline__ bool needs_mask(int t) const { const int kb = t * 64; return kb + 63 > qlo || kb <= qlo + 31 - 512; }
    __device__ __forceinline__ void apply_half(f32x16& p, int t, int H) const { mask_half(p, qm - t * 64 - 32 * H, 512u); }
    __device__ __forceinline__ bool drop(int) const { return false; } };
struct MaskSel { int qlo, qm; unsigned selw;
    __device__ __forceinline__ bool act(int t) const { return t * 64 <= qlo + 31; }
    __device__ __forceinline__ void apply(f32x16& p0, f32x16& p1, int t) const { const int kb = t * 64; if (kb + 63 > qlo) mask_tile(p0, p1, qm - kb, 0x40000000u); }
    __device__ __forceinline__ bool needs_mask(int t) const { return t * 64 + 63 > qlo; }
    __device__ __forceinline__ void apply_half(f32x16& p, int t, int H) const { mask_half(p, qm - t * 64 - 32 * H, 0x40000000u); }
    __device__ __forceinline__ bool drop(int t) const { return ((selw >> t) & 1u) == 0u; } };
struct MaskDilA { int plo, pm;
    __device__ __forceinline__ bool act(int t) const { return t * 64 <= plo + 31; }
    __device__ __forceinline__ void apply(f32x16& p0, f32x16& p1, int t) const { mask_dil(p0, p1, pm - t * 64); }
    __device__ __forceinline__ bool needs_mask(int) const { return true; }
    __device__ __forceinline__ void apply_half(f32x16& p, int t, int H) const { mask_dil_half(p, pm - t * 64 - 32 * H); }
    __device__ __forceinline__ bool drop(int) const { return false; } };
struct MaskDilB { int tlo, tm;
    __device__ __forceinline__ bool act(int t) const { const int kb = t * 64; return kb <= tlo + 124 && kb + 63 >= tlo - 128; }
    __device__ __forceinline__ void apply(f32x16& p0, f32x16& p1, int t) const { mask_tile(p0, p1, tm - t * 64, 129u); }
    __device__ __forceinline__ bool needs_mask(int) const { return true; }
    __device__ __forceinline__ void apply_half(f32x16& p, int t, int H) const { mask_half(p, tm - t * 64 - 32 * H, 129u); }
    __device__ __forceinline__ bool drop(int) const { return false; } };

template <class MK>
__device__ __forceinline__ void attn_pass(St& S, const bf16x8 (&qr)[8], const bf16* Kg, const bf16* Vg, int pitch, int t0, int t1, LAS char* lds, const MK& mk, int tid, int wid, int lane) {
    if (t0 >= t1) return;
    const int r32 = lane & 31, hi = lane >> 5;
    LAS char* K_lds = lds + A_K;
    LAS float* al_l = (LAS float*)(lds + A_WS) + wid * 64 + 32;
    const int vb0 = (int)(unsigned)(uintptr_t)lds + v_rd_base(lane);
    unsigned kso[2], vso[2];
#pragma unroll
    for (int j = 0; j < 2; ++j) { const int ch = 2 * wid + j;
        const int row = ch * 4 + (lane >> 4), chunk = (lane & 15) ^ (row & 7); kso[j] = (unsigned)(row * pitch + chunk * 8);
        const int sub = ch * 2 + (lane >> 5), kk = (sub >> 2) * 8 + ((lane & 31) >> 2), key = (kk & ~0xC) | ((kk & 4) << 1) | ((kk & 8) >> 1), col = (sub & 3) * 32 + (lane & 3) * 8;
        vso[j] = (unsigned)(key * pitch + col); }
    const unsigned ldsw = (unsigned)wid * 2048u;
#define FA_DMA(t, bf) do { const bf16* kt_ = Kg + (size_t)((t) * 64) * pitch; const bf16* vt_ = Vg + (size_t)((t) * 64) * pitch; \
        _Pragma("unroll") for (int j_ = 0; j_ < 2; ++j_) { \
            __builtin_amdgcn_global_load_lds((const GAS unsigned*)(kt_ + kso[j_]), (LAS unsigned*)(lds + (bf) * BUFS + A_K + ldsw + j_ * 1024), 16, 0, 0); \
            __builtin_amdgcn_global_load_lds((const GAS unsigned*)(vt_ + vso[j_]), (LAS unsigned*)(lds + (bf) * BUFS + A_V + ldsw + j_ * 1024), 16, 0, 0); } } while (0)
#define FA_BAR() do { asm volatile("s_waitcnt lgkmcnt(0)" ::: "memory"); __builtin_amdgcn_s_barrier(); asm volatile("" ::: "memory"); } while (0)
#define FA_RESC(al_) do { if (__any((al_) < 1.f)) { if (hi == 0) al_l[r32] = (al_); asm volatile("s_waitcnt lgkmcnt(0)" ::: "memory"); \
            _Pragma("unroll") for (int d_ = 0; d_ < 4; ++d_) _Pragma("unroll") for (int r = 0; r < 16; ++r) S.o[d_][r] *= al_l[crow(r, hi)]; \
            asm volatile("s_waitcnt lgkmcnt(0)" ::: "memory"); } } while (0)
#define FA_LWAIT() do { asm volatile("s_waitcnt lgkmcnt(0)" ::: "memory"); FA_SBAR(); } while (0)
#define FA_BODY(t, B) do { f32x16 p0, p1; bf16x8 pa0, pa1, pa2, pa3; float mnL0, mnL1; const bool dr_ = mk.drop(t), nm_ = mk.needs_mask(t); \
            { bf16x8 kfa[8], kfb[8]; k_reads<B, 0>(K_lds, r32, hi, kfa); FA_LWAIT(); \
              k_reads<B, 1>(K_lds, r32, hi, kfb); qk_mma(p0, kfa, qr); FA_LWAIT(); \
              if (nm_) mk.apply_half(p0, (t), 0); \
              s16x4 vl[8], vh[8]; pv_reads<B, 0>(vb0, vl, vh); \
              qk_mma(p1, kfb, qr); const float al0 = sm_max(p0, S.m, dr_, mnL0); sm_exp(p0, mnL0, al0, S.l, pa0, pa1); \
              FA_LWAIT(); FA_RESC(al0); FA_SBAR(); \
              if (nm_) mk.apply_half(p1, (t), 1); \
              pv_mma(S.o, vl, vh, pa0, pa1); const float al1 = sm_max(p1, S.m, dr_, mnL1); sm_exp(p1, mnL1, al1, S.l, pa2, pa3); \
              FA_SBAR(); FA_RESC(al1); \
              pv_reads<B, 1>(vb0, vl, vh); FA_LWAIT(); \
              pv_mma(S.o, vl, vh, pa2, pa3); } } while (0)
#define FA_STEP(t, B) do { const bool more2_ = (t) + 2 < t1; \
        if (more2_) FA_DMA((t) + 2, ((B) + 2) % 3); \
        if (mk.act(t)) { FA_BODY(t, B); } \
        if (more2_) asm volatile("s_waitcnt vmcnt(4)" ::: "memory"); else asm volatile("s_waitcnt vmcnt(0)" ::: "memory"); \
        FA_BAR(); } while (0)
    FA_DMA(t0, 0);
    if (t0 + 1 < t1) { FA_DMA(t0 + 1, 1); asm volatile("s_waitcnt vmcnt(4)" ::: "memory"); } else asm volatile("s_waitcnt vmcnt(0)" ::: "memory");
    FA_BAR();
    for (int t = t0; t < t1; t += 3) {
        FA_STEP(t, 0);
        if (t + 1 < t1) FA_STEP(t + 1, 1);
        if (t + 2 < t1) FA_STEP(t + 2, 2);
    }
#undef FA_STEP
#undef FA_BODY
#undef FA_LWAIT
#undef FA_RESC
#undef FA_BAR
#undef FA_DMA
}
__device__ __forceinline__ void row_factors(float f, float (&rli)[16], LAS char* lds, int wid, int r32, int hi) {
    LAS float* li_l = (LAS float*)(lds + A_WS) + wid * 64;
    if (hi == 0) li_l[r32] = f;
    asm volatile("s_waitcnt lgkmcnt(0)" ::: "memory");
#pragma unroll
    for (int r = 0; r < 16; ++r) rli[r] = li_l[crow(r, hi)];
    asm volatile("s_waitcnt lgkmcnt(0)" ::: "memory");
}
template <int HALF>
__device__ __forceinline__ void stage_half(const f32x16 (&o)[4], const float (&rli)[16], LAS float* st, int r32, int hi, int lane, f32x4 (&lo)[4], f32x4 (&hh)[4]) {
    asm volatile("s_waitcnt lgkmcnt(0)" ::: "memory");
#pragma unroll
    for (int r = 0; r < 16; ++r) { const int row = crow(r, hi); st[row * 64 + r32] = o[2 * HALF][r] * rli[r]; st[row * 64 + 32 + r32] = o[2 * HALF + 1][r] * rli[r]; }
    asm volatile("s_waitcnt lgkmcnt(0)" ::: "memory");
#pragma unroll
    for (int q = 0; q < 4; ++q) { const int idx = q * 64 + lane; const LAS float* p = st + (idx >> 3) * 64 + 8 * (idx & 7); lo[q] = *(const LAS f32x4*)p; hh[q] = *(const LAS f32x4*)(p + 4); }
    asm volatile("s_waitcnt lgkmcnt(0)" ::: "memory");
}
__device__ __forceinline__ float bflo(unsigned w) { return __builtin_bit_cast(float, w << 16); }
__device__ __forceinline__ float bfhi(unsigned w) { return __builtin_bit_cast(float, w & 0xffff0000u); }
__device__ __forceinline__ float silu_mul(float v, float z) { return v * z / (1.0f + __expf(-z)); }
}

__device__ __forceinline__ float sigm(float x) { return 1.0f / (1.0f + __expf(-x)); }

__device__ __forceinline__ void nsa_block(const Args& a, const Ctx& c, int b, int h, int qb) {
    unsigned char* ws = a.ws;
    const bf16* P = (const bf16*)(ws + WS_P); const bf16* QR = (const bf16*)(ws + WS_QR);
    const bf16* OC = (const bf16*)(ws + WS_OC); bf16* OS = (bf16*)(ws + WS_OS); const unsigned* SEL = (const unsigned*)(ws + WS_SEL);
    bf16* MIX = (bf16*)(ws + WS_MIX);
    LAS char* lds = (LAS char*)(c.lds + RING_OFF);
    int lane = c.lane, tid = c.tid; asm volatile("" : "+v"(lane), "+v"(tid));
    const int hk = h >> 2, r32 = lane & 31, hi = lane >> 5;
    const int qlo = qb * 256 + c.wave * 32, t_row = qlo + r32, m0 = b * SEQ + qlo;
    bf16x8 qr[8];
    { const bf16* qb_ = QR + (size_t)m0 * 2048 + h * 128; const unsigned lq = (unsigned)(r32 * 2048 + hi * 8);
#pragma unroll
      for (int d0 = 0; d0 < 8; ++d0) qr[d0] = *(const GAS bf16x8*)(qb_ + lq + d0 * 16); }
    const bf16* Pb = P + (size_t)b * SEQ * LDP;
    const bf16* grow = P + (size_t)m0 * LDP + C_GA + h * 3;

    {
        fa::St S; fa::st_init(S);
        fa::MaskSel mk{qlo, t_row - 4 * hi, (SEL + (b * 4 + hk) * SEQ + qlo)[r32]};
        fa::attn_pass(S, qr, Pb + C_KSL + hk * 128, Pb + C_VSL + hk * 128, LDP, 0, 4 * qb + 4, lds, mk, tid, c.wave, lane);
        const float g1 = sigm(bf2f(grow[(unsigned)(r32 * LDP + 1)]) + a.b_gate[h * 3 + 1]);
        float rli[16]; fa::row_factors(g1 / S.l, rli, lds, c.wave, r32, hi);
        __syncthreads();
        LAS float* st = (LAS float*)lds + c.wave * 2048;
#define SEL_HALF(HF) do { f32x4 lo[4], hh[4]; fa::stage_half<HF>(S.o, rli, st, r32, hi, lane, lo, hh); \
        _Pragma("unroll") for (int q = 0; q < 4; ++q) { const int idx = q * 64 + lane; bf16* ob = OS + (size_t)(m0 + (idx >> 3)) * 2048 + h * 128 + HF * 64 + 8 * (idx & 7); \
            { v4u w_; w_.x = fa::cvtpk(lo[q][0], lo[q][1]); w_.y = fa::cvtpk(lo[q][2], lo[q][3]); w_.z = fa::cvtpk(hh[q][0], hh[q][1]); w_.w = fa::cvtpk(hh[q][2], hh[q][3]); *(GAS v4u*)ob = w_; } } } while (0)
        SEL_HALF(0); SEL_HALF(1);
#undef SEL_HALF
        __syncthreads();
    }
    {
        fa::St S; fa::st_init(S);
        fa::MaskWin mk{qlo, t_row - 4 * hi};
        const int t0 = 4 * qb - 8 > 0 ? 4 * qb - 8 : 0;
        fa::attn_pass(S, qr, Pb + C_KW + hk * 128, Pb + C_VW + hk * 128, LDP, t0, 4 * qb + 4, lds, mk, tid, c.wave, lane);
        const float g2 = sigm(bf2f(grow[(unsigned)(r32 * LDP + 2)]) + a.b_gate[h * 3 + 2]);
        float rli[16]; fa::row_factors(g2 / S.l, rli, lds, c.wave, r32, hi);
        __syncthreads();
        LAS float* st = (LAS float*)lds + c.wave * 2048;
#define WIN_HALF(HF) do { f32x4 lo[4], hh[4]; fa::stage_half<HF>(S.o, rli, st, r32, hi, lane, lo, hh); \
        v4u zz[4], cc_[4], ss_[4]; \
        _Pragma("unroll") for (int q = 0; q < 4; ++q) { const int idx = q * 64 + lane; const size_t mr = (size_t)(m0 + (idx >> 3)); const int gcol = h * 128 + HF * 64 + 8 * (idx & 7); \
            zz[q] = *(const GAS v4u*)(P + mr * LDP + C_ZA + gcol); cc_[q] = *(const GAS v4u*)(OC + mr * 2048 + gcol); ss_[q] = *(const GAS v4u*)(OS + mr * 2048 + gcol); } \
        _Pragma("unroll") for (int q = 0; q < 4; ++q) { const int idx = q * 64 + lane; const size_t mr = (size_t)(m0 + (idx >> 3)); const int gcol = h * 128 + HF * 64 + 8 * (idx & 7); \
            const f32x4 c0 = {fa::bflo(cc_[q].x), fa::bfhi(cc_[q].x), fa::bflo(cc_[q].y), fa::bfhi(cc_[q].y)}, c1 = {fa::bflo(cc_[q].z), fa::bfhi(cc_[q].z), fa::bflo(cc_[q].w), fa::bfhi(cc_[q].w)}; \
            const f32x4 s0 = {fa::bflo(ss_[q].x), fa::bfhi(ss_[q].x), fa::bflo(ss_[q].y), fa::bfhi(ss_[q].y)}, s1 = {fa::bflo(ss_[q].z), fa::bfhi(ss_[q].z), fa::bflo(ss_[q].w), fa::bfhi(ss_[q].w)}; \
            const f32x4 a0 = lo[q] + c0 + s0, a1 = hh[q] + c1 + s1; v4u w; \
            w.x = fa::cvtpk(fa::silu_mul(a0[0], fa::bflo(zz[q].x)), fa::silu_mul(a0[1], fa::bfhi(zz[q].x))); w.y = fa::cvtpk(fa::silu_mul(a0[2], fa::bflo(zz[q].y)), fa::silu_mul(a0[3], fa::bfhi(zz[q].y))); \
            w.z = fa::cvtpk(fa::silu_mul(a1[0], fa::bflo(zz[q].z)), fa::silu_mul(a1[1], fa::bfhi(zz[q].z))); w.w = fa::cvtpk(fa::silu_mul(a1[2], fa::bflo(zz[q].w)), fa::silu_mul(a1[3], fa::bfhi(zz[q].w))); \
            *(GAS v4u*)(MIX + mr * DM + gcol) = w; } } while (0)
        WIN_HALF(0); WIN_HALF(1);
#undef WIN_HALF
        __syncthreads();
    }
}
__device__ __forceinline__ void p4_nsa_mfma(const Args& a, const Ctx& c) {
    for (int it = c.bid; it < 256; it += c.G) {
        const int x = it & 7, y = it >> 3, grp = 2 * x + (y >> 4), idx = y & 15;
        const int b = grp >> 2, hk = grp & 3, g = idx >> 2, pr = idx & 3, h = hk * 4 + g;
        nsa_block(a, c, b, h, pr);
        nsa_block(a, c, b, h, 7 - pr);
    }
}

__device__ __forceinline__ void dil_block(const Args& a, const Ctx& c, int b, int h, int r4, int pb) {
    unsigned char* ws = a.ws;
    const bf16* P = (const bf16*)(ws + WS_P); bf16* MIX = (bf16*)(ws + WS_MIX);
    LAS char* lds = (LAS char*)(c.lds + RING_OFF);
    int lane = c.lane, tid = c.tid; asm volatile("" : "+v"(lane), "+v"(tid));
    const int r32 = lane & 31, hi = lane >> 5;
    const int plo = pb * 256 + c.wave * 32, p_row = plo + r32, tok = 4 * p_row + r4, mrow0 = b * SEQ + 4 * plo + r4;
    bf16x8 qr[8];
    { const bf16* qb_ = P + (size_t)mrow0 * LDP + C_QB + h * 128; const unsigned lq = (unsigned)(r32 * 4 * LDP + hi * 8);
#pragma unroll
      for (int d0 = 0; d0 < 8; ++d0) qr[d0] = *(const GAS bf16x8*)(qb_ + lq + d0 * 16); }
    const bf16* Pb = P + (size_t)b * SEQ * LDP;
    fa::St S; fa::st_init(S);
    {   fa::MaskDilA mk{plo, p_row - 4 * hi};
        fa::attn_pass(S, qr, Pb + (size_t)r4 * LDP + C_KB + h * 128, Pb + (size_t)r4 * LDP + C_VB + h * 128, 4 * LDP, 0, 4 * pb + 4, lds, mk, tid, c.wave, lane); }
    {   const int tmin = 1024 * pb + r4, tmax = 1024 * pb + 1020 + r4;
        const int t0 = tmin - 128 > 0 ? (tmin - 128) >> 6 : 0, t1 = (tmax >> 6) + 1;
        fa::MaskDilB mk{4 * plo + r4, tok - 4 * hi};
        fa::attn_pass(S, qr, Pb + C_KB + h * 128, Pb + C_VB + h * 128, LDP, t0, t1, lds, mk, tid, c.wave, lane); }
    float rli[16]; fa::row_factors(1.0f / S.l, rli, lds, c.wave, r32, hi);
    __syncthreads();
    LAS float* st = (LAS float*)lds + c.wave * 2048;
#define DIL_HALF(HF) do { f32x4 lo[4], hh[4]; fa::stage_half<HF>(S.o, rli, st, r32, hi, lane, lo, hh); \
        v4u zz[4]; \
        _Pragma("unroll") for (int q = 0; q < 4; ++q) { const int idx = q * 64 + lane; const size_t mr = (size_t)(mrow0 + 4 * (idx >> 3)); const int gcol = h * 128 + HF * 64 + 8 * (idx & 7); \
            zz[q] = *(const GAS v4u*)(P + mr * LDP + C_ZB + gcol); } \
        _Pragma("unroll") for (int q = 0; q < 4; ++q) { const int idx = q * 64 + lane; const size_t mr = (size_t)(mrow0 + 4 * (idx >> 3)); const int gcol = h * 128 + HF * 64 + 8 * (idx & 7); \
            const f32x4 a0 = lo[q], a1 = hh[q]; v4u w; \
            w.x = fa::cvtpk(fa::silu_mul(a0[0], fa::bflo(zz[q].x)), fa::silu_mul(a0[1], fa::bfhi(zz[q].x))); w.y = fa::cvtpk(fa::silu_mul(a0[2], fa::bflo(zz[q].y)), fa::silu_mul(a0[3], fa::bfhi(zz[q].y))); \
            w.z = fa::cvtpk(fa::silu_mul(a1[0], fa::bflo(zz[q].z)), fa::silu_mul(a1[1], fa::bfhi(zz[q].z))); w.w = fa::cvtpk(fa::silu_mul(a1[2], fa::bflo(zz[q].w)), fa::silu_mul(a1[3], fa::bfhi(zz[q].w))); \
            *(GAS v4u*)(MIX + mr * DM + 2048 + gcol) = w; } } while (0)
    DIL_HALF(0); DIL_HALF(1);
#undef DIL_HALF
    __syncthreads();
}
__device__ __forceinline__ void p4_dil_mfma(const Args& a, const Ctx& c) {
    for (int it = c.bid; it < 256; it += c.G) {
        const int x = it & 7, y = it >> 3, bh = 8 * x + (y >> 2), r4 = y & 3, b = bh >> 4, h = bh & 15;
        dil_block(a, c, b, h, r4, 0);
        dil_block(a, c, b, h, r4, 1);
    }
}

__device__ __forceinline__ void cmp_item(const Args& a, const Ctx& c, int b, int hk, int tb) {
    unsigned char* ws = a.ws;
    const bf16* P = (const bf16*)(ws + WS_P); const bf16* KCB = (const bf16*)(ws + WS_KCB); const bf16* VCB = (const bf16*)(ws + WS_VCB);
    bf16* OC = (bf16*)(ws + WS_OC); unsigned* SEL = (unsigned*)(ws + WS_SEL);
    LAS char* lds = (LAS char*)(c.lds + RING_OFF);
    LAS float* imps = (LAS float*)(lds + 2 * fa::BUFS);
    int lane = c.lane, tid = c.tid; asm volatile("" : "+v"(lane), "+v"(tid));
    const int r32 = lane & 31, hi = lane >> 5, g = c.wave >> 1, h = hk * 4 + g, bh = b * 4 + hk;
    const int tl0 = 32 * (c.wave & 1), tw0 = 64 * tb + tl0, t = tw0 + r32, m0 = b * SEQ + tw0;
    const int nt = tb >= 16 ? 2 : 1;
    LAS char* V_lds = lds + fa::A_V; LAS char* K_lds = lds + fa::A_K;
    {   const int sr = tid >> 4, sc = (tid & 15) * 8; const int kws = FA_KSWZ(sr, sc * 2), vst0 = fa::v_st(sr, sc), vst1 = fa::v_st(32 + sr, sc);
        const bf16* Kg = KCB + (size_t)bh * 128 * 128; const bf16* Vg = VCB + (size_t)bh * 128 * 128; const unsigned lo = (unsigned)(sr * 128 + sc);
        for (int tt = 0; tt < nt; ++tt) {
            const bf16x8 k0 = *(const GAS bf16x8*)(Kg + tt * 8192 + lo), k1 = *(const GAS bf16x8*)(Kg + tt * 8192 + 4096 + lo);
            const bf16x8 v0 = *(const GAS bf16x8*)(Vg + tt * 8192 + lo), v1 = *(const GAS bf16x8*)(Vg + tt * 8192 + 4096 + lo);
            *(LAS bf16x8*)(K_lds + tt * fa::BUFS + kws) = k0; *(LAS bf16x8*)(K_lds + tt * fa::BUFS + kws + 32 * 256) = k1;
            *(LAS bf16x8*)(V_lds + tt * fa::BUFS + vst0) = v0; *(LAS bf16x8*)(V_lds + tt * fa::BUFS + vst1) = v1; } }
    bf16x8 qr[8];
    { const bf16* qb_ = P + (size_t)m0 * LDP + C_QA + h * 128; const unsigned lq = (unsigned)(r32 * LDP + hi * 8);
#pragma unroll
      for (int d0 = 0; d0 < 8; ++d0) qr[d0] = *(const GAS bf16x8*)(qb_ + lq + d0 * 16); }
    __syncthreads();
    const float NEG = -__builtin_inff();
    fa::f32x16 p0, p1, p2, p3;
    fa::qkt<0>(p0, p1, K_lds, r32, hi, qr);
    const int cmax = (t - 31) >> 4;
    fa::mask_tile(p0, p1, cmax - 4 * hi, 0x40000000u);
    if (nt == 2) { fa::qkt<1>(p2, p3, K_lds, r32, hi, qr); fa::mask_tile(p2, p3, cmax - 4 * hi - 64, 0x40000000u); }
    else {
#pragma unroll
        for (int r = 0; r < 16; ++r) { p2[r] = NEG; p3[r] = NEG; } }
    float mx = p0[0];
#pragma unroll
    for (int r = 0; r < 16; ++r) mx = fmaxf(fmaxf(mx, p0[r]), fmaxf(p1[r], fmaxf(p2[r], p3[r])));
    { auto rr = __builtin_amdgcn_permlane32_swap(__float_as_uint(mx), __float_as_uint(mx), false, false); mx = fmaxf(__uint_as_float(rr[0]), __uint_as_float(rr[1])); }
    const float mL = (mx == NEG) ? 0.f : -mx * fa::C2;
    float l = 0.f;
#pragma unroll
    for (int r = 0; r < 16; ++r) { p0[r] = __builtin_amdgcn_exp2f(fmaf(p0[r], fa::C2, mL)); p1[r] = __builtin_amdgcn_exp2f(fmaf(p1[r], fa::C2, mL));
        p2[r] = __builtin_amdgcn_exp2f(fmaf(p2[r], fa::C2, mL)); p3[r] = __builtin_amdgcn_exp2f(fmaf(p3[r], fa::C2, mL)); l += (p0[r] + p1[r]) + (p2[r] + p3[r]); }
    { auto rr = __builtin_amdgcn_permlane32_swap(__float_as_uint(l), __float_as_uint(l), false, false); l = __uint_as_float(rr[0]) + __uint_as_float(rr[1]); }
    const float inv = l > 0.f ? 1.0f / l : 0.f;
    {   fa::f32x16 o[4];
#pragma unroll
        for (int d = 0; d < 4; ++d)
#pragma unroll
            for (int r = 0; r < 16; ++r) o[d][r] = 0.f;
        const int vb0 = (int)(unsigned)(uintptr_t)lds + fa::v_rd_base(lane);
        bf16x8 pa0, pa1, pa2, pa3;
        fa::pack_p(p0, p1, pa0, pa1, pa2, pa3); FA_SBAR(); fa::pv_tile<0>(o, vb0, pa0, pa1, pa2, pa3);
        if (nt == 2) { fa::pack_p(p2, p3, pa0, pa1, pa2, pa3); FA_SBAR(); fa::pv_tile<1>(o, vb0, pa0, pa1, pa2, pa3); }
        float own[16], last[16];
#pragma unroll
        for (int k = 0; k < 16; ++k) { const int q = k & 3; const fa::f32x16& px = (k >> 2) == 0 ? p0 : (k >> 2) == 1 ? p1 : (k >> 2) == 2 ? p2 : p3;
            own[k] = ((px[4 * q] + px[4 * q + 1]) + (px[4 * q + 2] + px[4 * q + 3])) * inv; last[k] = px[4 * q + 3] * inv; }
        LAS float* dst = imps + ((g * 64 + tl0 + r32) * 32 + hi);
#pragma unroll
        for (int k = 0; k < 16; ++k) { const float x = __shfl_xor(last[k], 32); const float xp = (k > 0) ? __shfl_xor(last[k > 0 ? k - 1 : 0], 32) : 0.f;
            dst[2 * k] = own[k] + (hi ? x : xp); }
        const float g0 = sigm(bf2f((P + (size_t)m0 * LDP + C_GA + h * 3)[(unsigned)(r32 * LDP)]) + a.b_gate[h * 3]);
        float rli[16]; fa::row_factors(inv * g0, rli, lds, c.wave, r32, hi);
        __syncthreads();
        LAS float* st = (LAS float*)lds + c.wave * 2048;
#define CMP_HALF(HF) do { f32x4 lo[4], hh[4]; fa::stage_half<HF>(o, rli, st, r32, hi, lane, lo, hh); \
        _Pragma("unroll") for (int q = 0; q < 4; ++q) { const int idx = q * 64 + lane; bf16* ob = OC + (size_t)(m0 + (idx >> 3)) * 2048 + h * 128 + HF * 64 + 8 * (idx & 7); \
            { v4u w_; w_.x = fa::cvtpk(lo[q][0], lo[q][1]); w_.y = fa::cvtpk(lo[q][2], lo[q][3]); w_.z = fa::cvtpk(hh[q][0], hh[q][1]); w_.w = fa::cvtpk(hh[q][2], hh[q][3]); *(GAS v4u*)ob = w_; } } } while (0)
        CMP_HALF(0); CMP_HALF(1);
#undef CMP_HALF
    }
#pragma unroll 1
    for (int tt = 0; tt < 4; ++tt) {
        const int tl = c.wave * 8 + tt * 2 + hi, j = r32, tq = 64 * tb + tl, cur = tq >> 6;
        float imp = (imps[(0 * 64 + tl) * 32 + j] + imps[(1 * 64 + tl) * 32 + j]) + (imps[(2 * 64 + tl) * 32 + j] + imps[(3 * 64 + tl) * 32 + j]);
        const bool forced = (j == 0) || (j == cur) || (j == cur - 1);
        float v = forced ? imp + 1e4f : imp;
        if (j > cur) v = NEG;
        int rank = 0;
        for (int jj = 0; jj < 32; ++jj) { const float vo = __shfl(v, (lane & 32) + jj); rank += (vo > v || (vo == v && jj < j)) ? 1 : 0; }
        const bool sel = (rank < TOPN) && (j <= cur);
        const unsigned long long bal = __ballot(sel);
        if (r32 == 0) SEL[bh * SEQ + tq] = (unsigned)(bal >> (32 * hi));
    }
    __syncthreads();
}
__device__ __forceinline__ void p3_cmp_mfma(const Args& a, const Ctx& c) {
    for (int it = c.bid; it < 512; it += c.G) {
        const int bh = (it >> 5) & 15, tb = (it & 31) ^ ((it >> 8) ? 31 : 0);
        cmp_item(a, c, bh >> 2, bh & 3, tb);
    }
}

__device__ __forceinline__ void p6_final(const Args& a, const Ctx& c) {
    const bf16* Y = (const bf16*)(a.ws + WS_Y);
    for (int m = c.gw; m < M; m += c.NGW) {
        const GAS v4u* yr = (const GAS v4u*)(Y + (size_t)m * DM) + c.lane;
        v4u yv[8]; float s = 0.f;
#pragma unroll
        for (int j = 0; j < 8; ++j) yv[j] = yr[64 * j];
        const GAS f32x4* xr = (const GAS f32x4*)(a.x + (size_t)m * DM) + 2 * c.lane;
        GAS f32x4* orow = (GAS f32x4*)(a.out + (size_t)m * DM) + 2 * c.lane;
#pragma unroll
        for (int j = 0; j < 8; ++j) { const float y0 = fa::bflo(yv[j].x), y1 = fa::bfhi(yv[j].x), y2 = fa::bflo(yv[j].y), y3 = fa::bfhi(yv[j].y),
                                                  y4 = fa::bflo(yv[j].z), y5 = fa::bfhi(yv[j].z), y6 = fa::bflo(yv[j].w), y7 = fa::bfhi(yv[j].w);
            s += ((y0 * y0 + y1 * y1) + (y2 * y2 + y3 * y3)) + ((y4 * y4 + y5 * y5) + (y6 * y6 + y7 * y7)); }
        const float rstd = 1.0f / sqrtf(wave_sum(s) * (1.0f / DM) + EPS);
#pragma unroll
        for (int j = 0; j < 8; ++j) {
            const f32x4 w0 = ((const GAS f32x4*)a.post_w)[2 * c.lane + 128 * j], w1 = ((const GAS f32x4*)a.post_w)[2 * c.lane + 128 * j + 1];
            const f32x4 x0 = xr[128 * j], x1 = xr[128 * j + 1];
            const f32x4 ya = {fa::bflo(yv[j].x), fa::bfhi(yv[j].x), fa::bflo(yv[j].y), fa::bfhi(yv[j].y)}, yb = {fa::bflo(yv[j].z), fa::bfhi(yv[j].z), fa::bflo(yv[j].w), fa::bfhi(yv[j].w)};
            orow[128 * j] = x0 + ya * rstd * w0; orow[128 * j + 1] = x1 + yb * rstd * w1; }
    }
}


#ifndef MK_SPLIT
#define MK_SPLIT 0
#endif
constexpr int NPHASE = 8;

__global__ void __launch_bounds__(NWAVES * 64, 2) fwd_kernel(Args args) {
    extern __shared__ __attribute__((aligned(16))) unsigned char lds_raw[];
    Ctx c;
    c.lds = (LAS unsigned char*)lds_raw;
    c.tid = threadIdx.x; c.lane = c.tid & 63; c.wave = __builtin_amdgcn_readfirstlane(c.tid >> 6);
    c.G = gridDim.x; c.bid = blockIdx.x; c.gw = c.bid * NWAVES + c.wave; c.NGW = c.G * NWAVES;
    unsigned char* ws = args.ws;
    gu32* ctl = (gu32*)(ws + WS_CTL);
    volatile LAS unsigned* MISC = (volatile LAS unsigned*)(c.lds + MISC_OFF);
    for (int u = c.tid; u < (LDS_BYTES - LDSCTL_OFF) / 4; u += NWAVES * 64) ((LAS unsigned*)(c.lds + LDSCTL_OFF))[u] = 0u;
    __syncthreads();
    XcdBarrier bar; bar.bar = (unsigned*)(ctl + CW_BAR); bar.x = 0; bar.st = nullptr;
    if (!MK_SPLIT) bar = xcd_barrier_post((unsigned*)(ctl + CW_BAR), MISC + 8);
    const int lo = args.ph_lo, hi = args.ph_hi;
#define IN(k) (lo <= (k) && (k) < hi)
#define SEAM(k) do { if (IN(k) && IN((k) + 1)) xcd_barrier(bar); } while (0)

    if (IN(0)) { p0_prologue(args, c); } SEAM(0);
    if (IN(1)) {
        pg8::Gemm g{(const pg8::bf16_t*)(ws + WS_HB), (const pg8::bf16_t*)(ws + WS_WIN), M, NP, DM, DM}; pg8::StaticOrder S; S.init(M, NP, c.G, c.bid);
        pg8::EpiP E{(pg8::bf16_t*)(ws + WS_P), NP, (pg8::bf16_t*)(ws + WS_QR), (pg8::bf16_t*)(ws + WS_XKV), (const float*)(ws + WS_COS), (const float*)(ws + WS_SIN)};
        pg8::gemm_phase<pg8::EpiP, pg8::StaticOrder, true, true>(c.lds + RING_OFF, g, S, E);
        {
            const int rem = ((M / 256) * (NP / 256)) % c.G, nt_ = rem ? c.G - rem : c.G, ti = rem ? c.bid - rem : c.bid;
            if (ti >= 0) p0_transposes(args, c, TI_IN, TI_ALL, ti * NWAVES + c.wave, nt_ * NWAVES);
        }
    } SEAM(1);
    if (IN(2)) {
        pg8::Gemm g{(const pg8::bf16_t*)(ws + WS_XKV), (const pg8::bf16_t*)(ws + WS_WLR), 4096, 1024, 256, 2048}; pg8::CmpOrder S{c.bid, c.G};
        pg8::EpiLR E{(float*)(ws + WS_LR), 1024, (size_t)4096 * 1024};
        pg8::gemm_phase<pg8::EpiLR, pg8::CmpOrder, false, true>(c.lds + RING_OFF, g, S, E);
    } SEAM(2);
    if (IN(3)) { p2c_stage2(args, c); } SEAM(3);
    if (IN(4)) { p3_cmp_mfma(args, c); } SEAM(4);
    if (IN(5)) {
        p4_nsa_mfma(args, c);
        p4_dil_mfma(args, c);
    } SEAM(5);
    if (IN(6)) {
        pg8::Gemm g{(const pg8::bf16_t*)(ws + WS_MIX), (const pg8::bf16_t*)(ws + WS_WOUT), M, DM, DM, DM}; pg8::StaticOrder S; S.init(M, DM, c.G, c.bid);
        pg8::EpiBf16<0> E{(pg8::bf16_t*)(ws + WS_Y), DM, nullptr, 0, 0, 1.f};
        pg8::gemm_phase<pg8::EpiBf16<0>, pg8::StaticOrder, true, true>(c.lds + RING_OFF, g, S, E);
    } SEAM(6);
    if (IN(7)) { p6_final(args, c); }
#undef IN
#undef SEAM
}

extern "C" void kernel_launch(void* const* d_in, const int* in_sizes, int n_in, void* d_out, int out_size, void* d_ws, size_t ws_size, hipStream_t stream) {
    static int grid = 0;
    if (grid == 0) {
        if (n_in != 13 || out_size != M * DM || ws_size < WS_END) { fprintf(stderr, "kernel_launch: unexpected shapes (n_in %d out %d ws %zu)\n", n_in, out_size, ws_size); grid = -1; return; }
        int dev = 0, cus = 0, per_cu = 0;
        if (hipGetDevice(&dev) != hipSuccess || hipDeviceGetAttribute(&cus, hipDeviceAttributeMultiprocessorCount, dev) != hipSuccess) { grid = -1; return; }
        if (hipFuncSetAttribute((const void*)fwd_kernel, hipFuncAttributeMaxDynamicSharedMemorySize, LDS_BYTES) != hipSuccess) { fprintf(stderr, "kernel_launch: hipFuncSetAttribute failed\n"); grid = -1; return; }
        if (hipOccupancyMaxActiveBlocksPerMultiprocessor(&per_cu, (const void*)fwd_kernel, NWAVES * 64, LDS_BYTES) != hipSuccess || per_cu < 1)
            fprintf(stderr, "kernel_launch: occupancy query reports %d\n", per_cu);
        (void)hipGetLastError();
        grid = cus;
    }
    if (grid < 0) return;
    if (hipMemsetAsync((char*)d_ws + WS_CTL, 0, CTL_ZERO_BYTES, stream) != hipSuccess) return;
    Args a{};
    a.x = (const float*)d_in[0]; a.pos = (const int*)d_in[1]; a.pre_w = (const float*)d_in[2]; a.post_w = (const float*)d_in[3];
    a.w_in = (const float*)d_in[4]; a.b_gate = (const float*)d_in[5]; a.pe_k = (const float*)d_in[6]; a.pe_v = (const float*)d_in[7];
    a.wk1 = (const float*)d_in[8]; a.wk2 = (const float*)d_in[9]; a.wv1 = (const float*)d_in[10]; a.wv2 = (const float*)d_in[11]; a.w_out = (const float*)d_in[12];
    a.out = (float*)d_out; a.ws = (unsigned char*)d_ws;
#if MK_SPLIT
    for (int p = 0; p < NPHASE; ++p) { a.ph_lo = p; a.ph_hi = p + 1; hipLaunchKernelGGL(fwd_kernel, dim3(grid), dim3(NWAVES * 64), LDS_BYTES, stream, a); }
#else
    a.ph_lo = 0; a.ph_hi = NPHASE;
    hipLaunchKernelGGL(fwd_kernel, dim3(grid), dim3(NWAVES * 64), LDS_BYTES, stream, a);
#endif
}
```

```cpp
#include <hip/hip_runtime.h>
#include <cstdio>
#include <cstdint>
namespace pg8 {
#define PG8_LAS __attribute__((address_space(3)))
typedef unsigned short bf16_t;
typedef short bf16x8 __attribute__((ext_vector_type(8)));
typedef float f32x4 __attribute__((ext_vector_type(4)));
typedef unsigned u32x4 __attribute__((ext_vector_type(4)));
constexpr int BM = 256, BK = 64, HALF = 128, HTB = HALF * BK * 2  , STAGE_BYTES = 8 * HTB, NXCD = 8, WGM = 8;

__host__ __device__ __forceinline__ int lds_byte(int r, int c) { const int st = (r >> 4) * 2 + (c >> 5), rr = r & 15, cc = c & 31, ob = rr * 64 + cc * 2; return st * 1024 + (ob ^ (((ob >> 9) & 1) << 5)); }
__host__ __device__ __forceinline__ void stage_rc(int b, int& R, int& C) { const int st = b / 1024, sb = b % 1024, swz = sb ^ (((sb >> 9) & 1) << 5); R = (st >> 1) * 16 + swz / 64; C = (st & 1) * 32 + (swz % 64) / 2; }
__host__ __device__ __forceinline__ int perm32(int rho) { const int n = rho >> 4, i = rho & 15; return 8 * (i >> 2) + 4 * n + (i & 3); }

struct Unit { int pm, pn, ko; };
struct Gemm { const bf16_t* A; const bf16_t* Bt; int M, N, K, ld; };

struct StaticOrder {
    int nM, nN, nwg, G, c;
    __host__ __device__ void init(int M, int N, int G_, int c_) { nM = M / BM; nN = N / BM; nwg = nM * nN; G = G_; c = c_; }
    __host__ __device__ bool next(int i, Unit& u) const {
        const long L = (long)i * G + c; if (L >= nwg) return false;
        int wgid = (int)L; { const int q = nwg / NXCD, r = nwg % NXCD, xcd = wgid % NXCD, off = wgid / NXCD; wgid = (xcd < r ? xcd * (q + 1) : r * (q + 1) + (xcd - r) * q) + off; }
        const int nig = WGM * nN, gid = wgid / nig, fm = gid * WGM, gsz = (nM - fm) < WGM ? (nM - fm) : WGM;
        u.pm = fm + ((wgid % nig) % gsz); u.pn = (wgid % nig) / gsz; u.ko = 0; return true;
    }
    __device__ __forceinline__ void a_ready(const Unit&) const {}
    __device__ __forceinline__ void done(const Unit&) const {}
};

__device__ __forceinline__ unsigned cvt_pk_bf16(float lo, float hi) { unsigned r; asm volatile("v_cvt_pk_bf16_f32 %0, %1, %2" : "=v"(r) : "v"(lo), "v"(hi)); return r; }
typedef float f32x2 __attribute__((ext_vector_type(2)));
__device__ __forceinline__ f32x2 gelu_pk(f32x2 v) {
    const f32x2 av = __builtin_elementwise_abs(v), d = av * 0.2316418882f + 1.0f;
    f32x2 t; t.x = __builtin_amdgcn_rcpf(d.x); t.y = __builtin_amdgcn_rcpf(d.y);
    f32x2 q = t * 0.5307027145f + (-0.7265760135f); q = q * t + 0.7107068705f; q = q * t + (-0.142248368f); q = q * t + 0.127414796f; q = q * t;
    const f32x2 s = (v * v) * (-0.72134752044f);
    f32x2 e; e.x = __builtin_amdgcn_exp2f(s.x); e.y = __builtin_amdgcn_exp2f(s.y);
    const f32x2 m = v * (q * e), r = v - m;
    f32x2 o; o.x = v.x < 0.f ? m.x : r.x; o.y = v.y < 0.f ? m.y : r.y; return o;
}

template <int ACT  > struct EpiBf16 {
    static constexpr bool PERM = true, AFTER_DRAIN = false; static_assert(ACT == 0 || ACT == 1, "EpiBf16: ACT is 0 (none) or 1 (gelu_pk)");
    bf16_t* O; int ldc; const float* bias; int split_cols; size_t split_stride; float scale0;
    __device__ __forceinline__ void operator()(const f32x4 (&acc)[2][2][4][2], const Unit& u, int wr, int wc, int fr, int fq) const {
        const int row0 = u.pm * BM + wr * 64 + fr; int colt = u.pn * BM; bf16_t* base = O;
        float sc = 1.f; if (split_cols) { const int t = colt / split_cols; base += (size_t)t * split_stride; colt -= t * split_cols; if (t == 0) sc = scale0; }
        const int col0 = colt + wc * 32 + 8 * fq, bcol0 = u.pn * BM + wc * 32 + 8 * fq;
        f32x4 bv[2][2];
#pragma unroll
        for (int bj = 0; bj < 2; ++bj)
#pragma unroll
            for (int n = 0; n < 2; ++n) bv[bj][n] = bias ? *(const f32x4*)(bias + bcol0 + bj * HALF + 4 * n) : (f32x4){0.f, 0.f, 0.f, 0.f};
#pragma unroll
        for (int ai = 0; ai < 2; ++ai)
#pragma unroll
            for (int m = 0; m < 4; ++m) { bf16_t* rowp = base + (size_t)(row0 + ai * HALF + m * 16) * ldc + col0;
#pragma unroll
                for (int bj = 0; bj < 2; ++bj) { f32x4 v0 = acc[ai][bj][m][0] + bv[bj][0], v1 = acc[ai][bj][m][1] + bv[bj][1];
                    if (ACT == 1) { f32x2 a = gelu_pk((f32x2){v0[0], v0[1]}), b = gelu_pk((f32x2){v0[2], v0[3]}), c = gelu_pk((f32x2){v1[0], v1[1]}), d = gelu_pk((f32x2){v1[2], v1[3]});
                        v0 = (f32x4){a.x, a.y, b.x, b.y}; v1 = (f32x4){c.x, c.y, d.x, d.y}; }
                    v0 = v0 * sc; v1 = v1 * sc; u32x4 w; w.x = cvt_pk_bf16(v0[0], v0[1]); w.y = cvt_pk_bf16(v0[2], v0[3]); w.z = cvt_pk_bf16(v1[0], v1[1]); w.w = cvt_pk_bf16(v1[2], v1[3]);
                    *(u32x4*)(rowp + bj * HALF) = w; } }
    }
};
struct EpiF32 {
    static constexpr bool PERM = false, AFTER_DRAIN = false;
    float* O; int ldc;
    __device__ __forceinline__ void operator()(const f32x4 (&acc)[2][2][4][2], const Unit& u, int wr, int wc, int fr, int fq) const {
        const int row0 = u.pm * BM + wr * 64 + fr, col0 = u.pn * BM + wc * 32 + 4 * fq;
#pragma unroll
        for (int ai = 0; ai < 2; ++ai)
#pragma unroll
            for (int m = 0; m < 4; ++m) { float* rowp = O + (size_t)(row0 + ai * HALF + m * 16) * ldc + col0;
#pragma unroll
                for (int bj = 0; bj < 2; ++bj)
#pragma unroll
                    for (int n = 0; n < 2; ++n) *(f32x4*)(rowp + bj * HALF + n * 16) = acc[ai][bj][m][n]; }
    }
};

struct EpiP {
    static constexpr bool PERM = true, AFTER_DRAIN = false;
    bf16_t* Pm; int ldc; bf16_t* QR; bf16_t* XKV; const float* COS; const float* SIN;
    __device__ __forceinline__ void operator()(const f32x4 (&acc)[2][2][4][2], const Unit& u, int wr, int wc, int fr, int fq) const {
        const int pn = u.pn;
        const bool is_qa = pn < 8, is_rope = is_qa || pn == 20 || pn == 21 || pn == 24 || pn == 25 || (pn >= 28 && pn < 44), is_x = pn >= 16 && pn < 20;
        const int row0 = u.pm * BM + wr * 64 + fr, colw = wc * 32 + 8 * fq;
#pragma unroll
        for (int ai = 0; ai < 2; ++ai)
#pragma unroll
            for (int m = 0; m < 4; ++m) {
                const int row = row0 + ai * HALF + m * 16;
                f32x4 cs = {1.f, 1.f, 1.f, 1.f}, sn = {0.f, 0.f, 0.f, 0.f};
                if (is_rope) { cs = *(const f32x4*)(COS + (size_t)row * 64 + 16 * wc + 4 * fq); sn = *(const f32x4*)(SIN + (size_t)row * 64 + 16 * wc + 4 * fq); }
#pragma unroll
                for (int bj = 0; bj < 2; ++bj) {
                    const f32x4 v0 = acc[ai][bj][m][0], v1 = acc[ai][bj][m][1];
                    u32x4 w;
                    if (!is_rope || is_qa) { w.x = cvt_pk_bf16(v0[0], v0[1]); w.y = cvt_pk_bf16(v0[2], v0[3]); w.z = cvt_pk_bf16(v1[0], v1[1]); w.w = cvt_pk_bf16(v1[2], v1[3]); }
                    if (is_x) { const int hq = (pn - 16) * 2 + bj, kv = hq >> 2, hk = hq & 3, b = row >> 11, tok = row & 2047;
                        *(u32x4*)(XKV + ((size_t)((kv * 16 + b * 4 + hk) * 2048 + tok)) * 128 + colw) = w; }
                    else if (!is_rope) { *(u32x4*)(Pm + (size_t)row * ldc + pn * BM + bj * HALF + colw) = w; }
                    else {
                        if (is_qa) *(u32x4*)(Pm + (size_t)row * ldc + pn * BM + bj * HALF + colw) = w;
                        const f32x4 r0 = v0 * cs - v1 * sn, r1 = v1 * cs + v0 * sn;
                        u32x4 wr_; wr_.x = cvt_pk_bf16(r0[0], r0[1]); wr_.y = cvt_pk_bf16(r0[2], r0[3]); wr_.z = cvt_pk_bf16(r1[0], r1[1]); wr_.w = cvt_pk_bf16(r1[2], r1[3]);
                        if (is_qa) *(u32x4*)(QR + (size_t)row * 2048 + pn * BM + bj * HALF + colw) = wr_;
                        else *(u32x4*)(Pm + (size_t)row * ldc + pn * BM + bj * HALF + colw) = wr_;
                    }
                }
            }
    }
};

struct EpiLR {
    static constexpr bool PERM = false, AFTER_DRAIN = false;
    float* O; int ldc; size_t ks_stride;
    __device__ __forceinline__ void operator()(const f32x4 (&acc)[2][2][4][2], const Unit& u, int wr, int wc, int fr, int fq) const {
        const int row0 = u.pm * BM + wr * 64 + fr, col0 = u.pn * BM + wc * 32 + 4 * fq; float* Ob = O + (size_t)(u.ko >> 8) * ks_stride;
#pragma unroll
        for (int ai = 0; ai < 2; ++ai)
#pragma unroll
            for (int m = 0; m < 4; ++m) { float* rowp = Ob + (size_t)(row0 + ai * HALF + m * 16) * ldc + col0;
#pragma unroll
                for (int bj = 0; bj < 2; ++bj)
#pragma unroll
                    for (int n = 0; n < 2; ++n) *(f32x4*)(rowp + bj * HALF + n * 16) = acc[ai][bj][m][n]; }
    }
};
struct CmpOrder { int c, G;
    __device__ __forceinline__ bool next(int i, Unit& u) const { const int L = i * G + c; if (L >= 256) return false;
        const int ks = L & 7, q = L >> 3, kv = q >> 4, pmi = (q >> 1) & 7, pni = q & 1; u.pm = kv * 8 + pmi; u.pn = kv * 2 + pni; u.ko = ks * 256; return true; }
    __device__ __forceinline__ void a_ready(const Unit&) const {}
    __device__ __forceinline__ void done(const Unit&) const {}
};

template <class Epi, class Sched, bool ALIGN_EPI = false, bool SP2 = false>
__device__ __forceinline__ void gemm_phase(PG8_LAS unsigned char* lds, const Gemm g, const Sched& S, const Epi& E) {
    const int tid = threadIdx.x, wid = __builtin_amdgcn_readfirstlane(tid >> 6), lane = tid & 63, wr = wid >> 2, wc = wid & 3, fr = lane & 15, fq = lane >> 4;
    const int K = g.K, nt = K / BK, ld = g.ld;
    unsigned voffA[2], voffB[2];
#pragma unroll
    for (int i = 0; i < 2; ++i) { int R, C; stage_rc(tid * 16 + i * 8192, R, C); const int Rb = Epi::PERM ? ((R & ~31) + perm32(R & 31)) : R;
        voffA[i] = (unsigned)(R * ld + C) * 2u; voffB[i] = (unsigned)(Rb * ld + C) * 2u; }
    const size_t kstep = (size_t)(BK * 2);
    const size_t hstep = (size_t)HALF * ld * 2;
    const size_t tstep = 2 * hstep;
    const unsigned ldsw = (unsigned)wid * 1024u;
    const int aoff = lds_byte(wr * 64 + fr, fq * 8), boff = lds_byte(wc * 32 + fr, fq * 8);
#define PG8_SA(b, h) (((b) * 2 + (h)) * HTB)
#define PG8_SB(b, h) ((4 + (b) * 2 + (h)) * HTB)
#define PG8_STAGE(bufoff, gbase, voff) do { _Pragma("unroll") for (int _i = 0; _i < 2; ++_i) \
        __builtin_amdgcn_global_load_lds((const unsigned*)((const char*)(gbase) + (voff)[_i]), (PG8_LAS unsigned*)(lds + (bufoff) + ldsw + _i * 8192), 16, 0, 0); } while (0)
#define PG8_LDA(dst, b, h) do { _Pragma("unroll") for (int m = 0; m < 4; ++m) _Pragma("unroll") for (int k = 0; k < 2; ++k) dst[m][k] = *(const PG8_LAS bf16x8*)(lds + PG8_SA(b, h) + aoff + m * 2048 + k * 1024); } while (0)
#define PG8_LDB(dst, b, h) do { _Pragma("unroll") for (int n = 0; n < 2; ++n) _Pragma("unroll") for (int k = 0; k < 2; ++k) dst[n][k] = *(const PG8_LAS bf16x8*)(lds + PG8_SB(b, h) + boff + n * 2048 + k * 1024); } while (0)
#define PG8_MMA(ai, bj, At, Bt) do { __builtin_amdgcn_s_setprio(1); _Pragma("unroll") for (int m = 0; m < 4; ++m) _Pragma("unroll") for (int n = 0; n < 2; ++n) _Pragma("unroll") for (int k = 0; k < 2; ++k) \
        acc[ai][bj][m][n] = __builtin_amdgcn_mfma_f32_16x16x32_bf16(Bt[n][k], At[m][k], acc[ai][bj][m][n], 0, 0, 0); __builtin_amdgcn_s_setprio(0); } while (0)
#define PG8_WAIT_V(n) asm volatile("s_waitcnt vmcnt(" #n ")" ::: "memory")
#define PG8_WAIT_L(n) asm volatile("s_waitcnt lgkmcnt(" #n ")" ::: "memory")
#define PG8_BAR __builtin_amdgcn_s_barrier()
#define PG8_SCHED __builtin_amdgcn_sched_barrier(0)
    Unit cur, nxt; int ui = 0;
    if (!S.next(0, cur)) return;
    f32x4 acc[2][2][4][2];
#pragma unroll
    for (int a = 0; a < 2; ++a)
#pragma unroll
        for (int b = 0; b < 2; ++b)
#pragma unroll
            for (int m = 0; m < 4; ++m)
#pragma unroll
                for (int n = 0; n < 2; ++n) acc[a][b][m][n] = (f32x4){0.f, 0.f, 0.f, 0.f};
    bf16x8 At[4][2], B0[2][2], B1[2][2];
    const char* cA = (const char*)g.A + (size_t)cur.pm * tstep + (size_t)cur.ko * 2; const char* cB = (const char*)g.Bt + (size_t)cur.pn * tstep + (size_t)cur.ko * 2;
    S.a_ready(cur);
    if constexpr (SP2) {
        PG8_STAGE(PG8_SB(0, 0), cB, voffB); PG8_STAGE(PG8_SB(0, 1), cB + hstep, voffB); PG8_STAGE(PG8_SA(0, 0), cA, voffA); PG8_STAGE(PG8_SA(0, 1), cA + hstep, voffA);
        if (wr == 1) PG8_BAR;
        PG8_WAIT_V(2); PG8_BAR;
        PG8_STAGE(PG8_SB(1, 0), cB + kstep, voffB); PG8_STAGE(PG8_SA(1, 0), cA + kstep, voffA); PG8_STAGE(PG8_SB(1, 1), cB + hstep + kstep, voffB);
        PG8_WAIT_V(6); PG8_BAR;
    } else {
        PG8_STAGE(PG8_SB(0, 0), cB, voffB); PG8_STAGE(PG8_SA(0, 0), cA, voffA); PG8_STAGE(PG8_SB(0, 1), cB + hstep, voffB); PG8_STAGE(PG8_SA(0, 1), cA + hstep, voffA);
        if (wr == 1) PG8_BAR;
        PG8_WAIT_V(4); PG8_BAR;
        PG8_STAGE(PG8_SB(1, 0), cB + kstep, voffB); PG8_STAGE(PG8_SA(1, 0), cA + kstep, voffA); PG8_STAGE(PG8_SB(1, 1), cB + hstep + kstep, voffB);
        PG8_WAIT_V(6); PG8_BAR;
    }
    for (;;) {
        const bool has_next = S.next(ui + 1, nxt);
        const char* nA = has_next ? (const char*)g.A + (size_t)nxt.pm * tstep + (size_t)nxt.ko * 2 : cA; const char* nB = has_next ? (const char*)g.Bt + (size_t)nxt.pn * tstep + (size_t)nxt.ko * 2 : cB;
        for (int t = 0; t < nt; t += 2) {
            const bool last = (t == nt - 2);
            const char* a1 = cA + (size_t)(t + 1) * kstep;
            const char* a2 = last ? nA : cA + (size_t)(t + 2) * kstep; const char* b2 = last ? nB : cB + (size_t)(t + 2) * kstep;
            const char* a3 = a2 + kstep; const char* b3 = b2 + kstep;
            if (last && has_next) S.a_ready(nxt);
            if constexpr (SP2) {
            PG8_LDB(B0, 0, 0); PG8_LDB(B1, 0, 1); PG8_SCHED; PG8_LDA(At, 0, 0); PG8_STAGE(PG8_SA(1, 1), a1 + hstep, voffA);
            PG8_WAIT_V(8); PG8_WAIT_L(0); PG8_BAR; PG8_MMA(0, 0, At, B0); PG8_MMA(0, 1, At, B1); PG8_BAR; PG8_SCHED;
            PG8_LDA(At, 0, 1); PG8_STAGE(PG8_SB(0, 0), b2, voffB); PG8_STAGE(PG8_SB(0, 1), b2 + hstep, voffB); PG8_STAGE(PG8_SA(0, 0), a2, voffA);
            PG8_WAIT_V(8); PG8_WAIT_L(0); PG8_BAR; PG8_MMA(1, 0, At, B0); PG8_MMA(1, 1, At, B1); PG8_BAR; PG8_SCHED;
            PG8_LDB(B0, 1, 0); PG8_LDB(B1, 1, 1); PG8_SCHED; PG8_LDA(At, 1, 0); PG8_STAGE(PG8_SA(0, 1), a2 + hstep, voffA);
            PG8_WAIT_V(8); PG8_WAIT_L(0); PG8_BAR; PG8_MMA(0, 0, At, B0); PG8_MMA(0, 1, At, B1); PG8_BAR; PG8_SCHED;
            PG8_LDA(At, 1, 1); PG8_STAGE(PG8_SB(1, 0), b3, voffB); PG8_STAGE(PG8_SB(1, 1), b3 + hstep, voffB); PG8_STAGE(PG8_SA(1, 0), a3, voffA);
            PG8_WAIT_V(8); PG8_WAIT_L(0); PG8_BAR; PG8_MMA(1, 0, At, B0); PG8_MMA(1, 1, At, B1); PG8_BAR; PG8_SCHED;
            } else {
            PG8_LDB(B0, 0, 0); PG8_SCHED; PG8_LDA(At, 0, 0); PG8_STAGE(PG8_SA(1, 1), a1 + hstep, voffA);
            PG8_WAIT_L(8); PG8_BAR; PG8_WAIT_L(0); PG8_MMA(0, 0, At, B0); PG8_BAR; PG8_SCHED;
            PG8_LDB(B1, 0, 1); PG8_STAGE(PG8_SB(0, 0), b2, voffB);
            PG8_BAR; PG8_WAIT_L(0); PG8_MMA(0, 1, At, B1); PG8_BAR;
            PG8_LDA(At, 0, 1); PG8_STAGE(PG8_SA(0, 0), a2, voffA);
            PG8_BAR; PG8_WAIT_L(0); PG8_MMA(1, 0, At, B0); PG8_BAR; PG8_SCHED;
            PG8_STAGE(PG8_SB(0, 1), b2 + hstep, voffB);
            PG8_WAIT_V(6); PG8_BAR; PG8_MMA(1, 1, At, B1); PG8_BAR;
            PG8_LDB(B0, 1, 0); PG8_SCHED; PG8_LDA(At, 1, 0); PG8_STAGE(PG8_SA(0, 1), a2 + hstep, voffA);
            PG8_WAIT_L(8); PG8_BAR; PG8_WAIT_L(0); PG8_MMA(0, 0, At, B0); PG8_BAR; PG8_SCHED;
            PG8_LDB(B1, 1, 1); PG8_STAGE(PG8_SB(1, 0), b3, voffB);
            PG8_BAR; PG8_WAIT_L(0); PG8_MMA(0, 1, At, B1); PG8_BAR;
            PG8_LDA(At, 1, 1); PG8_STAGE(PG8_SA(1, 0), a3, voffA);
            PG8_BAR; PG8_WAIT_L(0); PG8_MMA(1, 0, At, B0); PG8_BAR; PG8_SCHED;
            PG8_STAGE(PG8_SB(1, 1), b3 + hstep, voffB);
            PG8_WAIT_V(6); PG8_BAR; PG8_MMA(1, 1, At, B1); PG8_BAR;
            }
        }
        if constexpr (ALIGN_EPI) { if (wr == 0) PG8_BAR; }
        if constexpr (!Epi::AFTER_DRAIN) { E(acc, cur, wr, wc, fr, fq); S.done(cur); }
        if (!has_next) break;
#pragma unroll
        for (int a = 0; a < 2; ++a)
#pragma unroll
            for (int b = 0; b < 2; ++b)
#pragma unroll
                for (int m = 0; m < 4; ++m)
#pragma unroll
                    for (int n = 0; n < 2; ++n) acc[a][b][m][n] = (f32x4){0.f, 0.f, 0.f, 0.f};
        cur = nxt; cA = nA; cB = nB; ++ui;
        if constexpr (ALIGN_EPI) { if (wr == 1) PG8_BAR; }
    }
    PG8_WAIT_V(0);
    if constexpr (!ALIGN_EPI) { if (wr == 0) PG8_BAR; }
    PG8_BAR;
    if constexpr (Epi::AFTER_DRAIN) { E.fused(acc, cur, wr, wc, fr, fq, lds, wid, lane); S.done(cur); }
#undef PG8_SA
#undef PG8_SB
#undef PG8_STAGE
#undef PG8_LDA
#undef PG8_LDB
#undef PG8_MMA
#undef PG8_WAIT_V
#undef PG8_WAIT_L
#undef PG8_BAR
#undef PG8_SCHED
}
}
#define GAS __attribute__((address_space(1)))
#define LAS __attribute__((address_space(3)))
typedef unsigned short bf16;
typedef unsigned v4u __attribute__((ext_vector_type(4)));
typedef float f32x4 __attribute__((ext_vector_type(4)));
typedef short bf16x8 __attribute__((ext_vector_type(8)));
typedef GAS unsigned gu32;
typedef GAS unsigned long long gu64;
#define RLX_AGENT __ATOMIC_RELAXED, __HIP_MEMORY_SCOPE_AGENT
#define LDS_WAIT() asm volatile("s_waitcnt lgkmcnt(0)" ::: "memory")
#define VM_WAIT() asm volatile("s_waitcnt vmcnt(0)" ::: "memory")
__device__ __forceinline__ unsigned long long rt() { return __builtin_amdgcn_s_memrealtime(); }
__device__ __forceinline__ unsigned f2bf(float f) { unsigned u = __builtin_bit_cast(unsigned, f); return (u + 0x7fffu + ((u >> 16) & 1u)) >> 16; }
__device__ __forceinline__ unsigned pk2(float lo, float hi) { return f2bf(lo) | (f2bf(hi) << 16); }

#define XB_TMO      128
#define XB_XCNT(j)  (256  + 64 * (j))
#define XB_XSUB(j)  (1280 + 64 * (j))
#define XB_XGEN(j)  (2304 + 64 * (j))
#define XB_TOP      3328
#define XB_TOPGEN   3392
#define XCD_BAR_WORDS 3456
#define XB_SPIN_CAP (1u << 24)

__device__ __forceinline__ unsigned xb_ld(unsigned* p)              { return __hip_atomic_load(p, __ATOMIC_RELAXED, __HIP_MEMORY_SCOPE_AGENT); }
__device__ __forceinline__ unsigned xb_add(unsigned* p, unsigned v) { return __hip_atomic_fetch_add(p, v, __ATOMIC_RELAXED, __HIP_MEMORY_SCOPE_AGENT); }
__device__ __forceinline__ unsigned xb_xcc_id() { return (unsigned)__builtin_amdgcn_s_getreg((3 << 11) | 20) & 0xFu; }
#define XB_SPIN(cond, bar) do { unsigned _sp = 0; while (cond) { __builtin_amdgcn_s_sleep(1); \
    if ((++_sp & 255u) == 0u) { if (xb_ld(&(bar)[XB_TMO])) break; if (_sp > XB_SPIN_CAP) { atomicAdd(&(bar)[XB_TMO], 1u); break; } } } } while (0)

struct XcdBarrier {
    unsigned* bar; unsigned x;
    volatile LAS unsigned* st;
};

__device__ __forceinline__ XcdBarrier xcd_barrier_post(unsigned* bar, volatile LAS unsigned* st) {
    XcdBarrier b; b.bar = bar; b.x = xb_xcc_id(); b.st = st;
    if (threadIdx.x == 0) (void)xb_add(&bar[XB_XCNT(b.x)], 1u);
    return b;
}
__device__ __forceinline__ void xcd_barrier_complete(unsigned* bar, unsigned x, unsigned& nloc, unsigned& nx) {
    const unsigned G = gridDim.x * gridDim.y * gridDim.z;
    unsigned sum, cnt, mine, sp = 0u;
    for (;;) {
        sum = 0u; cnt = 0u; mine = 0u;
#pragma unroll
        for (unsigned j = 0; j < 16; ++j) { const unsigned c = xb_ld(&bar[XB_XCNT(j)]); sum += c; cnt += (c > 0u) ? 1u : 0u; mine = (j == x) ? c : mine; }
        if (sum == G) break;
        __builtin_amdgcn_s_sleep(1);
        if ((++sp & 255u) == 0u) { if (xb_ld(&bar[XB_TMO])) break; if (sp > XB_SPIN_CAP) { atomicAdd(&bar[XB_TMO], 1u); break; } }
    }
    nloc = mine > 0u ? mine : 1u; nx = cnt > 0u ? cnt : 1u;
}

__device__ __forceinline__ void xcd_barrier(const XcdBarrier& b) {
    asm volatile("s_waitcnt vmcnt(0)" ::: "memory");
    __syncthreads();
    if (threadIdx.x == 0) {
        unsigned* bar = b.bar;
        __builtin_amdgcn_s_waitcnt(0);
        unsigned nloc = b.st[0], nx = b.st[1];
        if (nloc == 0u) { xcd_barrier_complete(bar, b.x, nloc, nx); b.st[0] = nloc; b.st[1] = nx; }
        const unsigned old = xb_add(&bar[XB_XSUB(b.x)], 1u);
        const unsigned gen = old / nloc;
        if (old + 1u == (gen + 1u) * nloc) {
            __builtin_amdgcn_fence(__ATOMIC_RELEASE, "agent");
            asm volatile("s_waitcnt vmcnt(0)" ::: "memory");
            const unsigned og = xb_add(&bar[XB_TOP], 1u);
            const unsigned tg = og / nx;
            if (og + 1u == (tg + 1u) * nx) xb_add(&bar[XB_TOPGEN], 1u);
            else XB_SPIN(xb_ld(&bar[XB_TOPGEN]) == tg, bar);
            __builtin_amdgcn_fence(__ATOMIC_ACQUIRE, "agent");
            xb_add(&bar[XB_XGEN(b.x)], 1u);
            asm volatile("s_waitcnt vmcnt(0)" ::: "memory");
        } else {
            XB_SPIN(xb_ld(&bar[XB_XGEN(b.x)]) == gen, bar);
            __builtin_amdgcn_fence(__ATOMIC_ACQUIRE, "agent");
            asm volatile("s_waitcnt vmcnt(0)" ::: "memory");
        }
    }
    __syncthreads();
}

constexpr int NWAVES = 8;
constexpr int BATCH = 4, SEQ = 2048, DM = 4096, M = BATCH * SEQ;
constexpr int HD = 128, NHA = 16, NKV = 4, GRP = 4, NHB = 16;
constexpr int CIN = 15408, NP = 15616;
constexpr int LDP = NP;
constexpr int C_QA = 0, C_ZA = 2048, C_KC = 4096, C_VC = 4608, C_KSL = 5120, C_VSL = 5632, C_KW = 6144, C_VW = 6656,
              C_QB = 7168, C_KB = 9216, C_VB = 11264, C_ZB = 13312, C_GA = 15360;
constexpr int NCMP = 127, NSEL = 32, TOPN = 16;
constexpr float EPS = 1e-6f;
constexpr float QSCALE = 0.08838834764831845f;

constexpr size_t MiB = 1u << 20;
constexpr size_t WS_CTL = 0, CTL_ZERO_BYTES = 1 * MiB;
constexpr size_t WS_WIN = 2 * MiB;
constexpr size_t WS_WOUT = 124 * MiB;
constexpr size_t WS_HB = 160 * MiB;
constexpr size_t WS_P = 224 * MiB;
constexpr size_t WS_QR = 468 * MiB;
constexpr size_t WS_COS = 500 * MiB;
constexpr size_t WS_SIN = 502 * MiB;
constexpr size_t WS_MIX = 504 * MiB;
constexpr size_t WS_Y = 568 * MiB;
constexpr size_t WS_KCMP = 696 * MiB;
constexpr size_t WS_VCMP = 697 * MiB;
constexpr size_t WS_BIAS1 = 698 * MiB;
constexpr size_t WS_SEL = 699 * MiB;
constexpr size_t WS_OC = 704 * MiB;
constexpr size_t WS_OS = 768 * MiB;
constexpr size_t WS_XKV = 832 * MiB;
constexpr size_t WS_WLR = 848 * MiB;
constexpr size_t WS_KCB = 852 * MiB;
constexpr size_t WS_VCB = 853 * MiB;
constexpr size_t WS_LR = WS_Y;
constexpr size_t WS_END = 854 * MiB;
constexpr int CW_BAR = 4096;

constexpr int RING_OFF = 0, RING_BYTES = 131072;
constexpr int LDSCTL_OFF = RING_BYTES, MISC_OFF = LDSCTL_OFF + 320;
constexpr int LDS_BYTES = 147456;

__device__ __forceinline__ float bf2f(unsigned short u) { return __builtin_bit_cast(float, (unsigned)u << 16); }
__device__ __forceinline__ float wave_sum(float v) {
#pragma unroll
    for (int o = 1; o < 64; o <<= 1) v += __shfl_xor(v, o);
    return v;
}
__device__ __forceinline__ float wave_max(float v) {
#pragma unroll
    for (int o = 1; o < 64; o <<= 1) v = fmaxf(v, __shfl_xor(v, o));
    return v;
}

struct Args {
    const float* x; const int* pos; const float* pre_w; const float* post_w; const float* w_in; const float* b_gate;
    const float* pe_k; const float* pe_v; const float* wk1; const float* wk2; const float* wv1; const float* wv2; const float* w_out;
    float* out; unsigned char* ws; int ph_lo, ph_hi;
};

struct Ctx {
    LAS unsigned char* lds; int tid, lane, wave, G, bid, gw, NGW;
};

__host__ __device__ __forceinline__ int rope_phi(int d) { const int dd = d & 63; return 32 * (dd >> 4) + 8 * ((dd >> 2) & 3) + 4 * (d >> 6) + (dd & 3); }
__device__ __forceinline__ void transpose_item(const float* W, int ldw, int K, int k0, int c0, int ncols, bf16* WT, int r0, LAS float* scr, int lane, bool perm = false) {
#pragma unroll 8
    for (int i = 0; i < 32; ++i) { const int kk = 2 * i + (lane >> 5), n = lane & 31; scr[kk * 33 + n] = (n < ncols) ? W[(size_t)(k0 + kk) * ldw + c0 + n] : 0.f; }
    LDS_WAIT(); asm volatile("" ::: "memory");
    const int c = lane & 7;
#pragma unroll
    for (int j = 0; j < 4; ++j) { const int n = (lane >> 3) + 8 * j; const LAS float* s = scr + (8 * c) * 33 + n;
        v4u o; o.x = pk2(s[0 * 33], s[1 * 33]); o.y = pk2(s[2 * 33], s[3 * 33]); o.z = pk2(s[4 * 33], s[5 * 33]); o.w = pk2(s[6 * 33], s[7 * 33]);
        const int drow = perm ? (r0 & ~127) + rope_phi((r0 & 127) + n) : r0 + n;
        if (n < ncols) *(GAS v4u*)(WT + (size_t)drow * K + k0 + 8 * c) = o; }
    LDS_WAIT(); asm volatile("" ::: "memory");
}

__device__ __forceinline__ void p0_transposes(const Args& a, const Ctx& c, int it0, int it1, int widx, int nw) {
    unsigned char* ws = a.ws;
    bf16* WinT = (bf16*)(ws + WS_WIN); bf16* WoutT = (bf16*)(ws + WS_WOUT);
    LAS float* scr = (LAS float*)(c.lds + RING_OFF + c.wave * 16384);
    constexpr int NB_IN = 482, I_IN = 64 * NB_IN, I_OUT = 64 * 128, I_LR = 4 * 32 * 8, I_ALL = I_IN + I_OUT + I_LR;
    bf16* WLR = (bf16*)(ws + WS_WLR);
    struct TItem { const float* src; bf16* dst; int ldw, K, ncols; bool perm; int r0; };
    auto decode = [&](int it) -> TItem {
        TItem t;
        if (it < I_IN) {
            const int kb = it / NB_IN, nb = it % NB_IN; int c0, r0, nc = 32;
            if (nb < 128) { c0 = nb * 32; r0 = nb * 32; }
            else if (nb < 224) { c0 = 4144 + (nb - 128) * 32; r0 = 4096 + (nb - 128) * 32; }
            else if (nb < 480) { c0 = 7216 + (nb - 224) * 32; r0 = 7168 + (nb - 224) * 32; }
            else { c0 = 4096 + (nb - 480) * 32; r0 = C_GA + (nb - 480) * 32; nc = (nb == 480) ? 32 : 16; }
            t.perm = (r0 < 2048) || (r0 >= C_KSL && r0 < C_VSL) || (r0 >= C_KW && r0 < C_VW) || (r0 >= C_QB && r0 < C_VB);
            t.src = a.w_in + (size_t)(kb * 64) * CIN + c0; t.ldw = CIN; t.K = DM; t.ncols = nc; t.dst = WinT + kb * 64; t.r0 = r0;
        } else if (it < I_IN + I_OUT) {
            const int r = it - I_IN, kb = r / 128, nb = r % 128;
            t.perm = false; t.src = a.w_out + (size_t)(kb * 64) * DM + nb * 32; t.ldw = DM; t.K = DM; t.ncols = 32; t.dst = WoutT + kb * 64; t.r0 = nb * 32;
        } else {
            const int r = it - I_IN - I_OUT, part = r >> 8, kb = (r >> 3) & 31, nb = r & 7;
            t.perm = false; t.src = ((part >> 1) ? a.wv1 : a.wk1) + (size_t)((part & 1) * 2048 + kb * 64) * 256 + nb * 32; t.ldw = 256; t.K = 2048; t.ncols = 32;
            t.dst = WLR + kb * 64; t.r0 = part * 256 + nb * 32;
        }
        return t;
    };
    {
        const int kr = c.lane >> 3, nq = (c.lane & 7) * 4;
        f32x4 v[8];
        int it = it0 + widx; bool have = it < it1; TItem cur{};
        if (have) { cur = decode(it);
#pragma unroll
            for (int i = 0; i < 8; ++i) v[i] = (nq < cur.ncols) ? __builtin_nontemporal_load((const GAS f32x4*)(cur.src + (size_t)(8 * i + kr) * cur.ldw + nq)) : (f32x4){0.f, 0.f, 0.f, 0.f}; }
        while (have) {
#pragma unroll
            for (int i = 0; i < 8; ++i) { LAS float* d = scr + (8 * i + kr) * 33 + nq; d[0] = v[i].x; d[1] = v[i].y; d[2] = v[i].z; d[3] = v[i].w; }
            const int nit = it + nw; const bool hn = nit < it1; TItem nx{};
            if (hn) { nx = decode(nit);
#pragma unroll
                for (int i = 0; i < 8; ++i) v[i] = (nq < nx.ncols) ? __builtin_nontemporal_load((const GAS f32x4*)(nx.src + (size_t)(8 * i + kr) * nx.ldw + nq)) : (f32x4){0.f, 0.f, 0.f, 0.f}; }
            LDS_WAIT(); asm volatile("" ::: "memory");
            const int cc = c.lane & 7;
#pragma unroll
            for (int j = 0; j < 4; ++j) { const int n = (c.lane >> 3) + 8 * j; const LAS float* sp = scr + (8 * cc) * 33 + n;
                v4u o; o.x = pk2(sp[0 * 33], sp[1 * 33]); o.y = pk2(sp[2 * 33], sp[3 * 33]); o.z = pk2(sp[4 * 33], sp[5 * 33]); o.w = pk2(sp[6 * 33], sp[7 * 33]);
                const int drow = cur.perm ? (cur.r0 & ~127) + rope_phi((cur.r0 & 127) + n) : cur.r0 + n;
                if (n < cur.ncols) *(GAS v4u*)(cur.dst + (size_t)drow * cur.K + 8 * cc) = o; }
            LDS_WAIT(); asm volatile("" ::: "memory");
            it = nit; have = hn; cur = nx;
        }
    }
}
constexpr int TI_IN = 64 * 482, TI_ALL = TI_IN + 64 * 128 + 4 * 32 * 8;

__device__ __forceinline__ void p0_prologue(const Args& a, const Ctx& c) {
    unsigned char* ws = a.ws;
    bf16* WinT = (bf16*)(ws + WS_WIN); bf16* HB = (bf16*)(ws + WS_HB);
    p0_transposes(a, c, 0, TI_IN, c.gw, c.NGW);
    for (int e = c.gw * 64 + c.lane; e < (NP - CIN) * (DM / 8); e += c.NGW * 64)
        *(GAS v4u*)(WinT + (size_t)CIN * DM + (size_t)e * 8) = (v4u){0u, 0u, 0u, 0u};
    for (int m = c.gw; m < M; m += c.NGW) {
        const GAS f32x4* xr = (const GAS f32x4*)(a.x + (size_t)m * DM) + c.lane;
        f32x4 v[16]; float s = 0.f;
#pragma unroll
        for (int j = 0; j < 16; ++j) { v[j] = __builtin_nontemporal_load(xr + 64 * j); s += (v[j].x * v[j].x + v[j].y * v[j].y) + (v[j].z * v[j].z + v[j].w * v[j].w); }
        const float rstd = 1.0f / sqrtf(wave_sum(s) * (1.0f / DM) + EPS);
        GAS unsigned long long* o8 = (GAS unsigned long long*)(HB + (size_t)m * DM) + c.lane;
#pragma unroll
        for (int j = 0; j < 16; ++j) { const f32x4 w = ((const GAS f32x4*)a.pre_w)[c.lane + 64 * j];
            o8[64 * j] = (unsigned long long)pk2(v[j].x * rstd * w.x, v[j].y * rstd * w.y) | ((unsigned long long)pk2(v[j].z * rstd * w.z, v[j].w * rstd * w.w) << 32); }
    }
    {
        float* COS = (float*)(ws + WS_COS); float* SIN = (float*)(ws + WS_SIN);
        for (int e = c.gw * 64 + c.lane; e < M * 64; e += c.NGW * 64) {
            const int m = e >> 6, i = e & 63;
            double inv = 1.0; for (int k = 0; k < i; ++k) inv *= 0.8659643233600653;
            const double ang = (double)a.pos[m] * inv;
            const double TWO_PI = 6.283185307179586476925286766559;
            const double n = __builtin_rint(ang / TWO_PI);
            const double r = ang - n * TWO_PI;
            const double r2 = r * r;
            double sn = 0.0, cs = 0.0;
            double ts = r, tc = 1.0;
#pragma unroll
            for (int k = 0; k < 14; ++k) { sn += ts; cs += tc; ts *= -r2 / (double)((2 * k + 2) * (2 * k + 3)); tc *= -r2 / (double)((2 * k + 1) * (2 * k + 2)); }
            COS[e] = (float)cs; SIN[e] = (float)sn;
        }
    }
    {
        float* BP = (float*)(ws + WS_BIAS1);
        for (int o = c.gw; o < 128; o += c.NGW) {
            const int kv = o >> 6, ch = o & 63; const float* pe = (kv ? a.pe_v : a.pe_k) + ch * 64; const float* w1 = (kv ? a.wv1 : a.wk1) + (size_t)ch * 64 * 256;
            float s0 = 0.f, s1 = 0.f, s2 = 0.f, s3 = 0.f;
            for (int i = 0; i < 64; ++i) { const float p = pe[i]; const float* wr = w1 + i * 256 + c.lane; s0 += p * wr[0]; s1 += p * wr[64]; s2 += p * wr[128]; s3 += p * wr[192]; }
            float* d = BP + (size_t)o * 256 + c.lane; d[0] = s0; d[64] = s1; d[128] = s2; d[192] = s3;
        }
    }
}

__device__ __forceinline__ float gelu_tanh(float x) {
    const float u = 0.7978845608028654f * (x + 0.044715f * x * x * x);
    const float e = __expf(2.0f * u);
    const float th = 1.0f - 2.0f / (e + 1.0f);
    return 0.5f * x * (1.0f + th);
}

__device__ __forceinline__ void p2c_stage2(const Args& a, const Ctx& c) {
    unsigned char* ws = a.ws;
    const float* LR = (const float*)(ws + WS_LR); const float* B1 = (const float*)(ws + WS_BIAS1);
    LAS float* Gs = (LAS float*)(c.lds + RING_OFF);
    bf16* KCB = (bf16*)(ws + WS_KCB); bf16* VCB = (bf16*)(ws + WS_VCB);
    for (int e = c.gw * 64 + c.lane; e < 2 * 16 * 128; e += c.NGW * 64) { bf16* dst = (e >> 11) ? VCB : KCB; dst[(size_t)((e >> 7) & 15) * 128 * 128 + 127 * 128 + (e & 127)] = 0; }
    for (int it = c.bid; it < 2 * 127; it += c.G) {
        const int kv = it / 127, rb = it % 127;
        const float* w2 = kv ? a.wv2 : a.wk2;
        float* OUT = (float*)(ws + (kv ? WS_VCMP : WS_KCMP)); bf16* OUTB = kv ? VCB : KCB;
        const int n = c.tid & 255, half = c.tid >> 8;
        float b1 = 0.f;
        for (int ch = 0; ch < 64; ++ch) b1 += B1[(size_t)(kv * 64 + ch) * 256 + n];
        __syncthreads();
#pragma unroll
        for (int r = 0; r < 8; ++r) { const int R = rb * 16 + half * 8 + r, bh = R / 127, cc = R % 127; const size_t rowL = (size_t)kv * 2048 + bh * 128 + cc;
            float h = b1;
#pragma unroll
            for (int ks = 0; ks < 8; ++ks) { const float* p = LR + (size_t)ks * 4096 * 1024 + rowL * 1024 + kv * 512 + n; h += p[0] + p[1024 + 256]; }
            Gs[(half * 8 + r) * 256 + n] = gelu_tanh(h); }
        __syncthreads();
        const int d = c.tid & 127, rq = c.tid >> 7;
        float o[4] = {0.f, 0.f, 0.f, 0.f};
        for (int nn = 0; nn < 256; ++nn) { const float w = w2[nn * 128 + d];
#pragma unroll
            for (int r = 0; r < 4; ++r) o[r] += Gs[(rq * 4 + r) * 256 + nn] * w; }
#pragma unroll
        for (int r = 0; r < 4; ++r) { const int R = rb * 16 + rq * 4 + r, bh = R / 127, cc = R % 127; const int dd = kv ? d : rope_phi(d);
            OUT[(size_t)(bh * 128 + cc) * 128 + dd] = o[r]; OUTB[(size_t)(bh * 128 + cc) * 128 + dd] = (bf16)f2bf(o[r]); }
    }
}

namespace fa {
typedef short s16x4 __attribute__((ext_vector_type(4)));
typedef float f32x16 __attribute__((ext_vector_type(16)));
typedef unsigned u32x4 __attribute__((ext_vector_type(4)));
constexpr int KVBLK = 64, SHM_K = KVBLK * 128 * 2, SHM_V = SHM_K;
constexpr int BUFS = SHM_V + SHM_K, A_V = 0, A_K = SHM_V, A_WS = 3 * BUFS;
constexpr float SCALE = 0.08838834764831845f, THR = 8.f;
constexpr float C2 = 1.4426950408889634f * SCALE;
constexpr float DBL = 1.0f / C2;
#define FA_KSWZ(row, colB) ((row) * 256 + ((colB) ^ (((row) & 7) << 4)))
#define FA_SBAR() __builtin_amdgcn_sched_barrier(0)
__device__ __forceinline__ int v_st(int k, int c) { const int kk = (k & ~0xC) | ((k & 4) << 1) | ((k & 8) >> 1); return ((kk >> 3) * 4 + (c >> 5)) * 512 + ((kk & 7) * 32 + (c & 31)) * 2; }
__device__ __forceinline__ int v_rd_base(int lane) { return ((lane & 3) << 3) | (((lane >> 2) & 3) << 6) | (((lane >> 4) & 1) << 5) | (((lane >> 5) & 1) << 8); }
constexpr int v_rd_off(int d0, int ks, int half) { return d0 * 512 + ks * 4096 + half * 2048; }
__device__ __forceinline__ int crow(int r, int hi) { return (r & 3) + 8 * (r >> 2) + 4 * hi; }
__device__ __forceinline__ unsigned cvtpk(float lo, float hi) { unsigned r; asm volatile("v_cvt_pk_bf16_f32 %0, %1, %2" : "=v"(r) : "v"(lo), "v"(hi)); return r; }

__device__ __forceinline__ void mask_tile(f32x16& p0, f32x16& p1, int dq, unsigned W) {
    const float NEG = -__builtin_inff();
#pragma unroll
    for (int r = 0; r < 16; ++r) {
        const int c = (r & 3) + 8 * (r >> 2);
        if ((unsigned)(dq - c) >= W) p0[r] = NEG;
        if ((unsigned)(dq - c - 32) >= W) p1[r] = NEG;
    }
}
__device__ __forceinline__ void mask_dil(f32x16& p0, f32x16& p1, int dq) {
    const float NEG = -__builtin_inff();
#pragma unroll
    for (int r = 0; r < 16; ++r) {
        const int c = (r & 3) + 8 * (r >> 2);
        { const int dl = dq - c; const bool nr = (unsigned)dl <= 128u, m4 = dl >= 0 && (dl & 3) == 0; const float v = p0[r];
          p0[r] = nr ? (m4 ? v + DBL : v) : (m4 ? v : NEG); }
        { const int dl = dq - c - 32; const bool nr = (unsigned)dl <= 128u, m4 = dl >= 0 && (dl & 3) == 0; const float v = p1[r];
          p1[r] = nr ? (m4 ? v + DBL : v) : (m4 ? v : NEG); }
    }
}
__device__ __forceinline__ void partialSM(f32x16& p0, f32x16& p1, float& m_reg, float& mn, float& alpha, bool drop) {
    float pmax = p0[0];
#pragma unroll
    for (int r = 1; r < 16; ++r) pmax = fmaxf(pmax, p0[r]);
#pragma unroll
    for (int r = 0; r < 16; ++r) pmax = fmaxf(pmax, p1[r]);
    { auto rr = __builtin_amdgcn_permlane32_swap(__float_as_uint(pmax), __float_as_uint(pmax), false, false);
      pmax = fmaxf(__uint_as_float(rr[0]), __uint_as_float(rr[1])); }
    if (drop) pmax = -__builtin_inff();
    if (__builtin_expect(__all((pmax - m_reg) * SCALE <= THR), 1)) { mn = m_reg; alpha = 1.f; }
    else { mn = fmaxf(m_reg, pmax); alpha = __builtin_amdgcn_exp2f((m_reg - mn) * C2); m_reg = mn; }
    const float mnL = drop ? -__builtin_inff() : -mn * C2;
#pragma unroll
    for (int r = 0; r < 16; ++r) p0[r] = fmaf(p0[r], C2, mnL);
#pragma unroll
    for (int r = 0; r < 16; ++r) p1[r] = fmaf(p1[r], C2, mnL);
#pragma unroll
    for (int r = 0; r < 16; ++r) p0[r] = __builtin_amdgcn_exp2f(p0[r]);
}
__device__ __forceinline__ void finishSM(f32x16& p0, f32x16& p1, float alpha, float& l_reg, bf16x8& pa0, bf16x8& pa1, bf16x8& pa2, bf16x8& pa3) {
#pragma unroll
    for (int r = 0; r < 16; ++r) p1[r] = __builtin_amdgcn_exp2f(p1[r]);
    float ps = 0;
#pragma unroll
    for (int r = 0; r < 16; ++r) ps += p0[r];
#pragma unroll
    for (int r = 0; r < 16; ++r) ps += p1[r];
    { auto rr = __builtin_amdgcn_permlane32_swap(__float_as_uint(ps), __float_as_uint(ps), false, false);
      ps = __uint_as_float(rr[0]) + __uint_as_float(rr[1]); }
    l_reg = l_reg * alpha + ps;
#define FA_PK4(P, B_, OUT) do { unsigned a0 = cvtpk(P[B_+0], P[B_+1]), a1 = cvtpk(P[B_+2], P[B_+3]);                          \
        unsigned b0 = cvtpk(P[B_+4], P[B_+5]), b1 = cvtpk(P[B_+6], P[B_+7]);                                             \
        auto r0 = __builtin_amdgcn_permlane32_swap(a0, b0, false, false); auto r1 = __builtin_amdgcn_permlane32_swap(a1, b1, false, false); \
        u32x4 w = {r0[0], r1[0], r0[1], r1[1]}; OUT = __builtin_bit_cast(bf16x8, w); } while (0)
    FA_PK4(p0, 0, pa0); FA_PK4(p0, 8, pa1); FA_PK4(p1, 0, pa2); FA_PK4(p1, 8, pa3);
#undef FA_PK4
}
__device__ __forceinline__ void pack_p(const f32x16& p0, const f32x16& p1, bf16x8& pa0, bf16x8& pa1, bf16x8& pa2, bf16x8& pa3) {
#define FA_PK4(P, B_, OUT) do { unsigned a0 = cvtpk(P[B_+0], P[B_+1]), a1 = cvtpk(P[B_+2], P[B_+3]);                          \
        unsigned b0 = cvtpk(P[B_+4], P[B_+5]), b1 = cvtpk(P[B_+6], P[B_+7]);                                             \
        auto r0 = __builtin_amdgcn_permlane32_swap(a0, b0, false, false); auto r1 = __builtin_amdgcn_permlane32_swap(a1, b1, false, false); \
        u32x4 w = {r0[0], r1[0], r0[1], r1[1]}; OUT = __builtin_bit_cast(bf16x8, w); } while (0)
    FA_PK4(p0, 0, pa0); FA_PK4(p0, 8, pa1); FA_PK4(p1, 0, pa2); FA_PK4(p1, 8, pa3);
#undef FA_PK4
}
template <int KB>
__device__ __forceinline__ void qkt(f32x16& p0, f32x16& p1, const LAS char* K_lds, int r32, int hi, const bf16x8 (&qr)[8]) {
#pragma unroll
    for (int r = 0; r < 16; ++r) { p0[r] = 0.f; p1[r] = 0.f; }
    const LAS char* kb[4];
#pragma unroll
    for (int dd = 0; dd < 4; ++dd) kb[dd] = K_lds + KB * BUFS + FA_KSWZ(r32, (dd * 16 + hi * 8) * 2);
#pragma unroll
    for (int d0 = 0; d0 < 8; ++d0) { const LAS char* a = kb[d0 & 3] + (d0 >> 2) * 128;
        const bf16x8 b0 = *(const LAS bf16x8*)a;
        const bf16x8 b1 = *(const LAS bf16x8*)(a + 32 * 256);
        p0 = __builtin_amdgcn_mfma_f32_32x32x16_bf16(b0, qr[d0], p0, 0, 0, 0);
        p1 = __builtin_amdgcn_mfma_f32_32x32x16_bf16(b1, qr[d0], p1, 0, 0, 0); }
}
template <int VB>
__device__ __forceinline__ void pv_tile(f32x16 (&o)[4], int vb0, bf16x8 pa0, bf16x8 pa1, bf16x8 pa2, bf16x8 pa3) {
#define FA_TRRD(dst, off) asm volatile("ds_read_b64_tr_b16 %0, %1 offset:%2" : "=&v"(dst) : "v"(vb0), "i"(off) : "memory")
#define FA_PV_D0(d0) do { s16x4 l0, l1, l2, l3, h0, h1, h2, h3; constexpr int b_ = A_V + VB * BUFS + v_rd_off(d0, 0, 0); \
        FA_TRRD(l0, b_); FA_TRRD(h0, b_ + 2048); FA_TRRD(l1, b_ + 4096); FA_TRRD(h1, b_ + 6144); FA_TRRD(l2, b_ + 8192); FA_TRRD(h2, b_ + 10240); FA_TRRD(l3, b_ + 12288); FA_TRRD(h3, b_ + 14336); \
        asm volatile("s_waitcnt lgkmcnt(0)" ::: "memory"); FA_SBAR(); \
        o[d0] = __builtin_amdgcn_mfma_f32_32x32x16_bf16(pa0, (bf16x8){l0[0], l0[1], l0[2], l0[3], h0[0], h0[1], h0[2], h0[3]}, o[d0], 0, 0, 0);   \
        o[d0] = __builtin_amdgcn_mfma_f32_32x32x16_bf16(pa1, (bf16x8){l1[0], l1[1], l1[2], l1[3], h1[0], h1[1], h1[2], h1[3]}, o[d0], 0, 0, 0);   \
        o[d0] = __builtin_amdgcn_mfma_f32_32x32x16_bf16(pa2, (bf16x8){l2[0], l2[1], l2[2], l2[3], h2[0], h2[1], h2[2], h2[3]}, o[d0], 0, 0, 0);   \
        o[d0] = __builtin_amdgcn_mfma_f32_32x32x16_bf16(pa3, (bf16x8){l3[0], l3[1], l3[2], l3[3], h3[0], h3[1], h3[2], h3[3]}, o[d0], 0, 0, 0); } while (0)
    FA_PV_D0(0); FA_PV_D0(1); FA_PV_D0(2); FA_PV_D0(3);
#undef FA_PV_D0
#undef FA_TRRD
}

__device__ __forceinline__ void mask_half(f32x16& p, int dq, unsigned W) {
    const float NEG = -__builtin_inff();
#pragma unroll
    for (int r = 0; r < 16; ++r) { const int c = (r & 3) + 8 * (r >> 2); if ((unsigned)(dq - c) >= W) p[r] = NEG; }
}
__device__ __forceinline__ void mask_dil_half(f32x16& p, int dq) {
    const float NEG = -__builtin_inff();
#pragma unroll
    for (int r = 0; r < 16; ++r) { const int c = (r & 3) + 8 * (r >> 2); const int dl = dq - c; const bool nr = (unsigned)dl <= 128u, m4 = dl >= 0 && (dl & 3) == 0; const float v = p[r];
        p[r] = nr ? (m4 ? v + DBL : v) : (m4 ? v : NEG); }
}
template <int KB, int H>
__device__ __forceinline__ void qk_half(f32x16& p, const LAS char* K_lds, int r32, int hi, const bf16x8 (&qr)[8]) {
#pragma unroll
    for (int r = 0; r < 16; ++r) p[r] = 0.f;
    const LAS char* kb[4];
#pragma unroll
    for (int dd = 0; dd < 4; ++dd) kb[dd] = K_lds + KB * BUFS + H * 32 * 256 + FA_KSWZ(r32, (dd * 16 + hi * 8) * 2);
#pragma unroll
    for (int d0 = 0; d0 < 8; ++d0) { const bf16x8 b0 = *(const LAS bf16x8*)(kb[d0 & 3] + (d0 >> 2) * 128); p = __builtin_amdgcn_mfma_f32_32x32x16_bf16(b0, qr[d0], p, 0, 0, 0); }
}
template <int KB, int H>
__device__ __forceinline__ void k_reads(const LAS char* K_lds, int r32, int hi, bf16x8 (&kf)[8]) {
    const unsigned a0 = (unsigned)(uintptr_t)(K_lds + KB * BUFS + FA_KSWZ(r32, (0 * 16 + hi * 8) * 2)), a1 = (unsigned)(uintptr_t)(K_lds + KB * BUFS + FA_KSWZ(r32, (1 * 16 + hi * 8) * 2)),
                   a2 = (unsigned)(uintptr_t)(K_lds + KB * BUFS + FA_KSWZ(r32, (2 * 16 + hi * 8) * 2)), a3 = (unsigned)(uintptr_t)(K_lds + KB * BUFS + FA_KSWZ(r32, (3 * 16 + hi * 8) * 2));
#define FA_KRD(dst, ad, off) asm volatile("ds_read_b128 %0, %1 offset:%2" : "=&v"(dst) : "v"(ad), "i"(off) : "memory")
    FA_KRD(kf[0], a0, H * 8192); FA_KRD(kf[1], a1, H * 8192); FA_KRD(kf[2], a2, H * 8192); FA_KRD(kf[3], a3, H * 8192);
    FA_KRD(kf[4], a0, H * 8192 + 128); FA_KRD(kf[5], a1, H * 8192 + 128); FA_KRD(kf[6], a2, H * 8192 + 128); FA_KRD(kf[7], a3, H * 8192 + 128);
#undef FA_KRD
}
__device__ __forceinline__ void qk_mma(f32x16& p, const bf16x8 (&kf)[8], const bf16x8 (&qr)[8]) {
#pragma unroll
    for (int r = 0; r < 16; ++r) p[r] = 0.f;
#pragma unroll
    for (int d0 = 0; d0 < 8; ++d0) p = __builtin_amdgcn_mfma_f32_32x32x16_bf16(kf[d0], qr[d0], p, 0, 0, 0);
}
__device__ __forceinline__ float sm_max(const f32x16& p, float& m_reg, bool drop, float& mnL) {
    float pmax = p[0];
#pragma unroll
    for (int r = 1; r < 16; ++r) pmax = fmaxf(pmax, p[r]);
    { auto rr = __builtin_amdgcn_permlane32_swap(__float_as_uint(pmax), __float_as_uint(pmax), false, false); pmax = fmaxf(__uint_as_float(rr[0]), __uint_as_float(rr[1])); }
    if (drop) pmax = -__builtin_inff();
    const bool keep = __all((pmax - m_reg) * SCALE <= THR);
    const float mn = keep ? m_reg : fmaxf(m_reg, pmax);
    const float alpha = __builtin_amdgcn_exp2f((m_reg - mn) * C2);
    m_reg = mn; mnL = drop ? -__builtin_inff() : -mn * C2;
    return alpha;
}
__device__ __forceinline__ void sm_exp(f32x16& p, float mnL, float alpha, float& l_reg, bf16x8& paA, bf16x8& paB) {
    float ps = 0.f;
#pragma unroll
    for (int r = 0; r < 16; ++r) { p[r] = __builtin_amdgcn_exp2f(fmaf(p[r], C2, mnL)); ps += p[r]; }
    { auto rr = __builtin_amdgcn_permlane32_swap(__float_as_uint(ps), __float_as_uint(ps), false, false); ps = __uint_as_float(rr[0]) + __uint_as_float(rr[1]); }
    l_reg = l_reg * alpha + ps;
#define FA_PK4(P, B_, OUT) do { unsigned a0 = cvtpk(P[B_+0], P[B_+1]), a1 = cvtpk(P[B_+2], P[B_+3]);                          \
        unsigned b0 = cvtpk(P[B_+4], P[B_+5]), b1 = cvtpk(P[B_+6], P[B_+7]);                                             \
        auto r0 = __builtin_amdgcn_permlane32_swap(a0, b0, false, false); auto r1 = __builtin_amdgcn_permlane32_swap(a1, b1, false, false); \
        u32x4 w = {r0[0], r1[0], r0[1], r1[1]}; OUT = __builtin_bit_cast(bf16x8, w); } while (0)
    FA_PK4(p, 0, paA); FA_PK4(p, 8, paB);
#undef FA_PK4
}
template <int VB, int H, int D0A = 0, int D0B = 4>
__device__ __forceinline__ void pv_reads(int vb0, s16x4 (&vl)[8], s16x4 (&vh)[8]) {
    const int vbb = vb0 + VB * BUFS;
#define FA_TRRD(dst, off) asm volatile("ds_read_b64_tr_b16 %0, %1 offset:%2" : "=&v"(dst) : "v"(vbb), "i"(off) : "memory")
#define FA_RD_D0(d0) do { constexpr int b_ = A_V + v_rd_off(d0, 2 * H, 0); \
        FA_TRRD(vl[2 * d0], b_); FA_TRRD(vh[2 * d0], b_ + 2048); FA_TRRD(vl[2 * d0 + 1], b_ + 4096); FA_TRRD(vh[2 * d0 + 1], b_ + 6144); } while (0)
    if constexpr (D0A <= 0 && 0 < D0B) FA_RD_D0(0); if constexpr (D0A <= 1 && 1 < D0B) FA_RD_D0(1); if constexpr (D0A <= 2 && 2 < D0B) FA_RD_D0(2); if constexpr (D0A <= 3 && 3 < D0B) FA_RD_D0(3);
#undef FA_RD_D0
#undef FA_TRRD
}
__device__ __forceinline__ void pv_mma(f32x16 (&o)[4], const s16x4 (&vl)[8], const s16x4 (&vh)[8], bf16x8 paA, bf16x8 paB) {
#pragma unroll
    for (int d0 = 0; d0 < 4; ++d0) {
        o[d0] = __builtin_amdgcn_mfma_f32_32x32x16_bf16(paA, (bf16x8){vl[2 * d0][0], vl[2 * d0][1], vl[2 * d0][2], vl[2 * d0][3], vh[2 * d0][0], vh[2 * d0][1], vh[2 * d0][2], vh[2 * d0][3]}, o[d0], 0, 0, 0);
        o[d0] = __builtin_amdgcn_mfma_f32_32x32x16_bf16(paB, (bf16x8){vl[2 * d0 + 1][0], vl[2 * d0 + 1][1], vl[2 * d0 + 1][2], vl[2 * d0 + 1][3], vh[2 * d0 + 1][0], vh[2 * d0 + 1][1], vh[2 * d0 + 1][2], vh[2 * d0 + 1][3]}, o[d0], 0, 0, 0); }
}

struct St { float m, l; f32x16 o[4]; };
__device__ __forceinline__ void st_init(St& S) { S.m = -1e30f; S.l = 0.f;
#pragma unroll
    for (int d = 0; d < 4; ++d)
#pragma unroll
        for (int r = 0; r < 16; ++r) S.o[d][r] = 0.f; }

struct MaskWin { int qlo, qm;
    __device__ __forceinline__ bool act(int t) const { const int kb = t * 64; return kb <= qlo + 31 && kb + 63 >= qlo - 511; }
    __device__ __forceinline__ void apply(f32x16& p0, f32x16& p1, int t) const { const int kb = t * 64; if (kb + 63 > qlo || kb <= qlo + 31 - 512) mask_tile(p0, p1, qm - kb, 512u); }
    __device__ __forceinline__ bool needs_mask(int t) const { const int kb = t * 64; return kb + 63 > qlo || kb <= qlo + 31 - 512; }
    __device__ __forceinline__ void apply_half(f32x16& p, int t, int H) const { mask_half(p, qm - t * 64 - 32 * H, 512u); }
    __device__ __forceinline__ bool drop(int) const { return false; } };
struct MaskSel { int qlo, qm; unsigned selw;
    __device__ __forceinline__ bool act(int t) const { return t * 64 <= qlo + 31; }
    __device__ __forceinline__ void apply(f32x16& p0, f32x16& p1, int t) const { const int kb = t * 64; if (kb + 63 > qlo) mask_tile(p0, p1, qm - kb, 0x40000000u); }
    __device__ __forceinline__ bool needs_mask(int t) const { return t * 64 + 63 > qlo; }
    __device__ __forceinline__ void apply_half(f32x16& p, int t, int H) const { mask_half(p, qm - t * 64 - 32 * H, 0x40000000u); }
    __device__ __forceinline__ bool drop(int t) const { return ((selw >> t) & 1u) == 0u; } };
struct MaskDilA { int plo, pm;
    __device__ __forceinline__ bool act(int t) const { return t * 64 <= plo + 31; }
    __device__ __forceinline__ void apply(f32x16& p0, f32x16& p1, int t) const { mask_dil(p0, p1, pm - t * 64); }
    __device__ __forceinline__ bool needs_mask(int) const { return true; }
    __device__ __forceinline__ void apply_half(f32x16& p, int t, int H) const { mask_dil_half(p, pm - t * 64 - 32 * H); }
    __device__ __forceinline__ bool drop(int) const { return false; } };
struct MaskDilB { int tlo, tm;
    __device__ __forceinline__ bool act(int t) const { const int kb = t * 64; return kb <= tlo + 124 && kb + 63 >= tlo - 128; }
    __device__ __forceinline__ void apply(f32x16& p0, f32x16& p1, int t) const { mask_tile(p0, p1, tm - t * 64, 129u); }
    __device__ __forceinline__ bool needs_mask(int) const { return true; }
    __device__ __forceinline__ void apply_half(f32x16& p, int t, int H) const { mask_half(p, tm - t * 64 - 32 * H, 129u); }
    __device__ __forceinline__ bool drop(int) const { return false; } };

template <class MK>
__device__ __forceinline__ void attn_pass(St& S, const bf16x8 (&qr)[8], const bf16* Kg, const bf16* Vg, int pitch, int t0, int t1, LAS char* lds, const MK& mk, int tid, int wid, int lane) {
    if (t0 >= t1) return;
    const int r32 = lane & 31, hi = lane >> 5;
    LAS char* K_lds = lds + A_K;
    LAS float* al_l = (LAS float*)(lds + A_WS) + wid * 64 + 32;
    const int vb0 = (int)(unsigned)(uintptr_t)lds + v_rd_base(lane);
    unsigned kso[2], vso[2];
#pragma unroll
    for (int j = 0; j < 2; ++j) { const int ch = 2 * wid + j;
        const int row = ch * 4 + (lane >> 4), chunk = (lane & 15) ^ (row & 7); kso[j] = (unsigned)(row * pitch + chunk * 8);
        const int sub = ch * 2 + (lane >> 5), kk = (sub >> 2) * 8 + ((lane & 31) >> 2), key = (kk & ~0xC) | ((kk & 4) << 1) | ((kk & 8) >> 1), col = (sub & 3) * 32 + (lane & 3) * 8;
        vso[j] = (unsigned)(key * pitch + col); }
    const unsigned ldsw = (unsigned)wid * 2048u;
#define FA_DMA(t, bf) do { const bf16* kt_ = Kg + (size_t)((t) * 64) * pitch; const bf16* vt_ = Vg + (size_t)((t) * 64) * pitch; \
        _Pragma("unroll") for (int j_ = 0; j_ < 2; ++j_) { \
            __builtin_amdgcn_global_load_lds((const GAS unsigned*)(kt_ + kso[j_]), (LAS unsigned*)(lds + (bf) * BUFS + A_K + ldsw + j_ * 1024), 16, 0, 0); \
            __builtin_amdgcn_global_load_lds((const GAS unsigned*)(vt_ + vso[j_]), (LAS unsigned*)(lds + (bf) * BUFS + A_V + ldsw + j_ * 1024), 16, 0, 0); } } while (0)
#define FA_BAR() do { asm volatile("s_waitcnt lgkmcnt(0)" ::: "memory"); __builtin_amdgcn_s_barrier(); asm volatile("" ::: "memory"); } while (0)
#define FA_RESC(al_) do { if (__any((al_) < 1.f)) { if (hi == 0) al_l[r32] = (al_); asm volatile("s_waitcnt lgkmcnt(0)" ::: "memory"); \
            _Pragma("unroll") for (int d_ = 0; d_ < 4; ++d_) _Pragma("unroll") for (int r = 0; r < 16; ++r) S.o[d_][r] *= al_l[crow(r, hi)]; \
            asm volatile("s_waitcnt lgkmcnt(0)" ::: "memory"); } } while (0)
#define FA_LWAIT() do { asm volatile("s_waitcnt lgkmcnt(0)" ::: "memory"); FA_SBAR(); } while (0)
#define FA_BODY(t, B) do { f32x16 p0, p1; bf16x8 pa0, pa1, pa2, pa3; float mnL0, mnL1; const bool dr_ = mk.drop(t), nm_ = mk.needs_mask(t); \
            { bf16x8 kfa[8], kfb[8]; k_reads<B, 0>(K_lds, r32, hi, kfa); FA_LWAIT(); \
              k_reads<B, 1>(K_lds, r32, hi, kfb); qk_mma(p0, kfa, qr); FA_LWAIT(); \
              if (nm_) mk.apply_half(p0, (t), 0); \
              s16x4 vl[8], vh[8]; pv_reads<B, 0>(vb0, vl, vh); \
              qk_mma(p1, kfb, qr); const float al0 = sm_max(p0, S.m, dr_, mnL0); sm_exp(p0, mnL0, al0, S.l, pa0, pa1); \
              FA_LWAIT(); FA_RESC(al0); FA_SBAR(); \
              if (nm_) mk.apply_half(p1, (t), 1); \
              pv_mma(S.o, vl, vh, pa0, pa1); const float al1 = sm_max(p1, S.m, dr_, mnL1); sm_exp(p1, mnL1, al1, S.l, pa2, pa3); \
              FA_SBAR(); FA_RESC(al1); \
              pv_reads<B, 1>(vb0, vl, vh); FA_LWAIT(); \
              pv_mma(S.o, vl, vh, pa2, pa3); } } while (0)
#define FA_STEP(t, B) do { const bool more2_ = (t) + 2 < t1; \
        if (more2_) FA_DMA((t) + 2, ((B) + 2) % 3); \
        if (mk.act(t)) { FA_BODY(t, B); } \
        if (more2_) asm volatile("s_waitcnt vmcnt(4)" ::: "memory"); else asm volatile("s_waitcnt vmcnt(0)" ::: "memory"); \
        FA_BAR(); } while (0)
    FA_DMA(t0, 0);
    if (t0 + 1 < t1) { FA_DMA(t0 + 1, 1); asm volatile("s_waitcnt vmcnt(4)" ::: "memory"); } else asm volatile("s_waitcnt vmcnt(0)" ::: "memory");
    FA_BAR();
    for (int t = t0; t < t1; t += 3) {
        FA_STEP(t, 0);
        if (t + 1 < t1) FA_STEP(t + 1, 1);
        if (t + 2 < t1) FA_STEP(t + 2, 2);
    }
#undef FA_STEP
#undef FA_BODY
#undef FA_LWAIT
#undef FA_RESC
#undef FA_BAR
#undef FA_DMA
}
__device__ __forceinline__ void row_factors(float f, float (&rli)[16], LAS char* lds, int wid, int r32, int hi) {
    LAS float* li_l = (LAS float*)(lds + A_WS) + wid * 64;
    if (hi == 0) li_l[r32] = f;
    asm volatile("s_waitcnt lgkmcnt(0)" ::: "memory");
#pragma unroll
    for (int r = 0; r < 16; ++r) rli[r] = li_l[crow(r, hi)];
    asm volatile("s_waitcnt lgkmcnt(0)" ::: "memory");
}
template <int HALF>
__device__ __forceinline__ void stage_half(const f32x16 (&o)[4], const float (&rli)[16], LAS float* st, int r32, int hi, int lane, f32x4 (&lo)[4], f32x4 (&hh)[4]) {
    asm volatile("s_waitcnt lgkmcnt(0)" ::: "memory");
#pragma unroll
    for (int r = 0; r < 16; ++r) { const int row = crow(r, hi); st[row * 64 + r32] = o[2 * HALF][r] * rli[r]; st[row * 64 + 32 + r32] = o[2 * HALF + 1][r] * rli[r]; }
    asm volatile("s_waitcnt lgkmcnt(0)" ::: "memory");
#pragma unroll
    for (int q = 0; q < 4; ++q) { const int idx = q * 64 + lane; const LAS float* p = st + (idx >> 3) * 64 + 8 * (idx & 7); lo[q] = *(const LAS f32x4*)p; hh[q] = *(const LAS f32x4*)(p + 4); }
    asm volatile("s_waitcnt lgkmcnt(0)" ::: "memory");
}
__device__ __forceinline__ float bflo(unsigned w) { return __builtin_bit_cast(float, w << 16); }
__device__ __forceinline__ float bfhi(unsigned w) { return __builtin_bit_cast(float, w & 0xffff0000u); }
__device__ __forceinline__ float silu_mul(float v, float z) { return v * z / (1.0f + __expf(-z)); }
}

__device__ __forceinline__ float sigm(float x) { return 1.0f / (1.0f + __expf(-x)); }

__device__ __forceinline__ void nsa_block(const Args& a, const Ctx& c, int b, int h, int qb) {
    unsigned char* ws = a.ws;
    const bf16* P = (const bf16*)(ws + WS_P); const bf16* QR = (const bf16*)(ws + WS_QR);
    const bf16* OC = (const bf16*)(ws + WS_OC); bf16* OS = (bf16*)(ws + WS_OS); const unsigned* SEL = (const unsigned*)(ws + WS_SEL);
    bf16* MIX = (bf16*)(ws + WS_MIX);
    LAS char* lds = (LAS char*)(c.lds + RING_OFF);
    int lane = c.lane, tid = c.tid; asm volatile("" : "+v"(lane), "+v"(tid));
    const int hk = h >> 2, r32 = lane & 31, hi = lane >> 5;
    const int qlo = qb * 256 + c.wave * 32, t_row = qlo + r32, m0 = b * SEQ + qlo;
    bf16x8 qr[8];
    { const bf16* qb_ = QR + (size_t)m0 * 2048 + h * 128; const unsigned lq = (unsigned)(r32 * 2048 + hi * 8);
#pragma unroll
      for (int d0 = 0; d0 < 8; ++d0) qr[d0] = *(const GAS bf16x8*)(qb_ + lq + d0 * 16); }
    const bf16* Pb = P + (size_t)b * SEQ * LDP;
    const bf16* grow = P + (size_t)m0 * LDP + C_GA + h * 3;

    {
        fa::St S; fa::st_init(S);
        fa::MaskSel mk{qlo, t_row - 4 * hi, (SEL + (b * 4 + hk) * SEQ + qlo)[r32]};
        fa::attn_pass(S, qr, Pb + C_KSL + hk * 128, Pb + C_VSL + hk * 128, LDP, 0, 4 * qb + 4, lds, mk, tid, c.wave, lane);
        const float g1 = sigm(bf2f(grow[(unsigned)(r32 * LDP + 1)]) + a.b_gate[h * 3 + 1]);
        float rli[16]; fa::row_factors(g1 / S.l, rli, lds, c.wave, r32, hi);
        __syncthreads();
        LAS float* st = (LAS float*)lds + c.wave * 2048;
#define SEL_HALF(HF) do { f32x4 lo[4], hh[4]; fa::stage_half<HF>(S.o, rli, st, r32, hi, lane, lo, hh); \
        _Pragma("unroll") for (int q = 0; q < 4; ++q) { const int idx = q * 64 + lane; bf16* ob = OS + (size_t)(m0 + (idx >> 3)) * 2048 + h * 128 + HF * 64 + 8 * (idx & 7); \
            { v4u w_; w_.x = fa::cvtpk(lo[q][0], lo[q][1]); w_.y = fa::cvtpk(lo[q][2], lo[q][3]); w_.z = fa::cvtpk(hh[q][0], hh[q][1]); w_.w = fa::cvtpk(hh[q][2], hh[q][3]); *(GAS v4u*)ob = w_; } } } while (0)
        SEL_HALF(0); SEL_HALF(1);
#undef SEL_HALF
        __syncthreads();
    }
    {
        fa::St S; fa::st_init(S);
        fa::MaskWin mk{qlo, t_row - 4 * hi};
        const int t0 = 4 * qb - 8 > 0 ? 4 * qb - 8 : 0;
        fa::attn_pass(S, qr, Pb + C_KW + hk * 128, Pb + C_VW + hk * 128, LDP, t0, 4 * qb + 4, lds, mk, tid, c.wave, lane);
        const float g2 = sigm(bf2f(grow[(unsigned)(r32 * LDP + 2)]) + a.b_gate[h * 3 + 2]);
        float rli[16]; fa::row_factors(g2 / S.l, rli, lds, c.wave, r32, hi);
        __syncthreads();
        LAS float* st = (LAS float*)lds + c.wave * 2048;
#define WIN_HALF(HF) do { f32x4 lo[4], hh[4]; v4u zz[4], cc_[4], ss_[4]; \
        _Pragma("unroll") for (int q = 0; q < 4; ++q) { const int idx = q * 64 + lane; const size_t mr = (size_t)(m0 + (idx >> 3)); const int gcol = h * 128 + HF * 64 + 8 * (idx & 7); \
            zz[q] = *(const GAS v4u*)(P + mr * LDP + C_ZA + gcol); cc_[q] = *(const GAS v4u*)(OC + mr * 2048 + gcol); ss_[q] = *(const GAS v4u*)(OS + mr * 2048 + gcol); } \
        fa::stage_half<HF>(S.o, rli, st, r32, hi, lane, lo, hh); \
        _Pragma("unroll") for (int q = 0; q < 4; ++q) { const int idx = q * 64 + lane; const size_t mr = (size_t)(m0 + (idx >> 3)); const int gcol = h * 128 + HF * 64 + 8 * (idx & 7); \
            const f32x4 c0 = {fa::bflo(cc_[q].x), fa::bfhi(cc_[q].x), fa::bflo(cc_[q].y), fa::bfhi(cc_[q].y)}, c1 = {fa::bflo(cc_[q].z), fa::bfhi(cc_[q].z), fa::bflo(cc_[q].w), fa::bfhi(cc_[q].w)}; \
            const f32x4 s0 = {fa::bflo(ss_[q].x), fa::bfhi(ss_[q].x), fa::bflo(ss_[q].y), fa::bfhi(ss_[q].y)}, s1 = {fa::bflo(ss_[q].z), fa::bfhi(ss_[q].z), fa::bflo(ss_[q].w), fa::bfhi(ss_[q].w)}; \
            const f32x4 a0 = lo[q] + c0 + s0, a1 = hh[q] + c1 + s1; v4u w; \
            w.x = fa::cvtpk(fa::silu_mul(a0[0], fa::bflo(zz[q].x)), fa::silu_mul(a0[1], fa::bfhi(zz[q].x))); w.y = fa::cvtpk(fa::silu_mul(a0[2], fa::bflo(zz[q].y)), fa::silu_mul(a0[3], fa::bfhi(zz[q].y))); \
            w.z = fa::cvtpk(fa::silu_mul(a1[0], fa::bflo(zz[q].z)), fa::silu_mul(a1[1], fa::bfhi(zz[q].z))); w.w = fa::cvtpk(fa::silu_mul(a1[2], fa::bflo(zz[q].w)), fa::silu_mul(a1[3], fa::bfhi(zz[q].w))); \
            *(GAS v4u*)(MIX + mr * DM + gcol) = w; } } while (0)
        WIN_HALF(0); WIN_HALF(1);
#undef WIN_HALF
        __syncthreads();
    }
}
__device__ __forceinline__ void p4_nsa_mfma(const Args& a, const Ctx& c) {
    for (int it = c.bid; it < 256; it += c.G) {
        const int x = it & 7, y = it >> 3, grp = 2 * x + (y >> 4), idx = y & 15;
        const int b = grp >> 2, hk = grp & 3, g = idx >> 2, pr = idx & 3, h = hk * 4 + g;
        nsa_block(a, c, b, h, pr);
        nsa_block(a, c, b, h, 7 - pr);
    }
}

__device__ __forceinline__ void dil_block(const Args& a, const Ctx& c, int b, int h, int r4, int pb) {
    unsigned char* ws = a.ws;
    const bf16* P = (const bf16*)(ws + WS_P); bf16* MIX = (bf16*)(ws + WS_MIX);
    LAS char* lds = (LAS char*)(c.lds + RING_OFF);
    int lane = c.lane, tid = c.tid; asm volatile("" : "+v"(lane), "+v"(tid));
    const int r32 = lane & 31, hi = lane >> 5;
    const int plo = pb * 256 + c.wave * 32, p_row = plo + r32, tok = 4 * p_row + r4, mrow0 = b * SEQ + 4 * plo + r4;
    bf16x8 qr[8];
    { const bf16* qb_ = P + (size_t)mrow0 * LDP + C_QB + h * 128; const unsigned lq = (unsigned)(r32 * 4 * LDP + hi * 8);
#pragma unroll
      for (int d0 = 0; d0 < 8; ++d0) qr[d0] = *(const GAS bf16x8*)(qb_ + lq + d0 * 16); }
    const bf16* Pb = P + (size_t)b * SEQ * LDP;
    fa::St S; fa::st_init(S);
    {   fa::MaskDilA mk{plo, p_row - 4 * hi};
        fa::attn_pass(S, qr, Pb + (size_t)r4 * LDP + C_KB + h * 128, Pb + (size_t)r4 * LDP + C_VB + h * 128, 4 * LDP, 0, 4 * pb + 4, lds, mk, tid, c.wave, lane); }
    {   const int tmin = 1024 * pb + r4, tmax = 1024 * pb + 1020 + r4;
        const int t0 = tmin - 128 > 0 ? (tmin - 128) >> 6 : 0, t1 = (tmax >> 6) + 1;
        fa::MaskDilB mk{4 * plo + r4, tok - 4 * hi};
        fa::attn_pass(S, qr, Pb + C_KB + h * 128, Pb + C_VB + h * 128, LDP, t0, t1, lds, mk, tid, c.wave, lane); }
    float rli[16]; fa::row_factors(1.0f / S.l, rli, lds, c.wave, r32, hi);
    __syncthreads();
    LAS float* st = (LAS float*)lds + c.wave * 2048;
#define DIL_HALF(HF) do { f32x4 lo[4], hh[4]; v4u zz[4]; \
        _Pragma("unroll") for (int q = 0; q < 4; ++q) { const int idx = q * 64 + lane; const size_t mr = (size_t)(mrow0 + 4 * (idx >> 3)); const int gcol = h * 128 + HF * 64 + 8 * (idx & 7); \
            zz[q] = *(const GAS v4u*)(P + mr * LDP + C_ZB + gcol); } \
        fa::stage_half<HF>(S.o, rli, st, r32, hi, lane, lo, hh); \
        _Pragma("unroll") for (int q = 0; q < 4; ++q) { const int idx = q * 64 + lane; const size_t mr = (size_t)(mrow0 + 4 * (idx >> 3)); const int gcol = h * 128 + HF * 64 + 8 * (idx & 7); \
            const f32x4 a0 = lo[q], a1 = hh[q]; v4u w; \
            w.x = fa::cvtpk(fa::silu_mul(a0[0], fa::bflo(zz[q].x)), fa::silu_mul(a0[1], fa::bfhi(zz[q].x))); w.y = fa::cvtpk(fa::silu_mul(a0[2], fa::bflo(zz[q].y)), fa::silu_mul(a0[3], fa::bfhi(zz[q].y))); \
            w.z = fa::cvtpk(fa::silu_mul(a1[0], fa::bflo(zz[q].z)), fa::silu_mul(a1[1], fa::bfhi(zz[q].z))); w.w = fa::cvtpk(fa::silu_mul(a1[2], fa::bflo(zz[q].w)), fa::silu_mul(a1[3], fa::bfhi(zz[q].w))); \
            *(GAS v4u*)(MIX + mr * DM + 2048 + gcol) = w; } } while (0)
    DIL_HALF(0); DIL_HALF(1);
#undef DIL_HALF
    __syncthreads();
}
__device__ __forceinline__ void p4_dil_mfma(const Args& a, const Ctx& c) {
    for (int it = c.bid; it < 256; it += c.G) {
        const int x = it & 7, y = it >> 3, bh = 8 * x + (y >> 2), r4 = y & 3, b = bh >> 4, h = bh & 15;
        dil_block(a, c, b, h, r4, 0);
        dil_block(a, c, b, h, r4, 1);
    }
}

__device__ __forceinline__ void cmp_item(const Args& a, const Ctx& c, int b, int hk, int tb) {
    unsigned char* ws = a.ws;
    const bf16* P = (const bf16*)(ws + WS_P); const bf16* KCB = (const bf16*)(ws + WS_KCB); const bf16* VCB = (const bf16*)(ws + WS_VCB);
    bf16* OC = (bf16*)(ws + WS_OC); unsigned* SEL = (unsigned*)(ws + WS_SEL);
    LAS char* lds = (LAS char*)(c.lds + RING_OFF);
    LAS float* imps = (LAS float*)(lds + 2 * fa::BUFS);
    int lane = c.lane, tid = c.tid; asm volatile("" : "+v"(lane), "+v"(tid));
    const int r32 = lane & 31, hi = lane >> 5, g = c.wave >> 1, h = hk * 4 + g, bh = b * 4 + hk;
    const int tl0 = 32 * (c.wave & 1), tw0 = 64 * tb + tl0, t = tw0 + r32, m0 = b * SEQ + tw0;
    const int nt = tb >= 16 ? 2 : 1;
    LAS char* V_lds = lds + fa::A_V; LAS char* K_lds = lds + fa::A_K;
    {   const int sr = tid >> 4, sc = (tid & 15) * 8; const int kws = FA_KSWZ(sr, sc * 2), vst0 = fa::v_st(sr, sc), vst1 = fa::v_st(32 + sr, sc);
        const bf16* Kg = KCB + (size_t)bh * 128 * 128; const bf16* Vg = VCB + (size_t)bh * 128 * 128; const unsigned lo = (unsigned)(sr * 128 + sc);
        for (int tt = 0; tt < nt; ++tt) {
            const bf16x8 k0 = *(const GAS bf16x8*)(Kg + tt * 8192 + lo), k1 = *(const GAS bf16x8*)(Kg + tt * 8192 + 4096 + lo);
            const bf16x8 v0 = *(const GAS bf16x8*)(Vg + tt * 8192 + lo), v1 = *(const GAS bf16x8*)(Vg + tt * 8192 + 4096 + lo);
            *(LAS bf16x8*)(K_lds + tt * fa::BUFS + kws) = k0; *(LAS bf16x8*)(K_lds + tt * fa::BUFS + kws + 32 * 256) = k1;
            *(LAS bf16x8*)(V_lds + tt * fa::BUFS + vst0) = v0; *(LAS bf16x8*)(V_lds + tt * fa::BUFS + vst1) = v1; } }
    bf16x8 qr[8];
    { const bf16* qb_ = P + (size_t)m0 * LDP + C_QA + h * 128; const unsigned lq = (unsigned)(r32 * LDP + hi * 8);
#pragma unroll
      for (int d0 = 0; d0 < 8; ++d0) qr[d0] = *(const GAS bf16x8*)(qb_ + lq + d0 * 16); }
    __syncthreads();
    const float NEG = -__builtin_inff();
    fa::f32x16 p0, p1, p2, p3;
    fa::qkt<0>(p0, p1, K_lds, r32, hi, qr);
    const int cmax = (t - 31) >> 4;
    fa::mask_tile(p0, p1, cmax - 4 * hi, 0x40000000u);
    if (nt == 2) { fa::qkt<1>(p2, p3, K_lds, r32, hi, qr); fa::mask_tile(p2, p3, cmax - 4 * hi - 64, 0x40000000u); }
    else {
#pragma unroll
        for (int r = 0; r < 16; ++r) { p2[r] = NEG; p3[r] = NEG; } }
    float mx = p0[0];
#pragma unroll
    for (int r = 0; r < 16; ++r) mx = fmaxf(fmaxf(mx, p0[r]), fmaxf(p1[r], fmaxf(p2[r], p3[r])));
    { auto rr = __builtin_amdgcn_permlane32_swap(__float_as_uint(mx), __float_as_uint(mx), false, false); mx = fmaxf(__uint_as_float(rr[0]), __uint_as_float(rr[1])); }
    const float mL = (mx == NEG) ? 0.f : -mx * fa::C2;
    float l = 0.f;
#pragma unroll
    for (int r = 0; r < 16; ++r) { p0[r] = __builtin_amdgcn_exp2f(fmaf(p0[r], fa::C2, mL)); p1[r] = __builtin_amdgcn_exp2f(fmaf(p1[r], fa::C2, mL));
        p2[r] = __builtin_amdgcn_exp2f(fmaf(p2[r], fa::C2, mL)); p3[r] = __builtin_amdgcn_exp2f(fmaf(p3[r], fa::C2, mL)); l += (p0[r] + p1[r]) + (p2[r] + p3[r]); }
    { auto rr = __builtin_amdgcn_permlane32_swap(__float_as_uint(l), __float_as_uint(l), false, false); l = __uint_as_float(rr[0]) + __uint_as_float(rr[1]); }
    const float inv = l > 0.f ? 1.0f / l : 0.f;
    {   fa::f32x16 o[4];
#pragma unroll
        for (int d = 0; d < 4; ++d)
#pragma unroll
            for (int r = 0; r < 16; ++r) o[d][r] = 0.f;
        const int vb0 = (int)(unsigned)(uintptr_t)lds + fa::v_rd_base(lane);
        bf16x8 pa0, pa1, pa2, pa3;
        fa::pack_p(p0, p1, pa0, pa1, pa2, pa3); FA_SBAR(); fa::pv_tile<0>(o, vb0, pa0, pa1, pa2, pa3);
        if (nt == 2) { fa::pack_p(p2, p3, pa0, pa1, pa2, pa3); FA_SBAR(); fa::pv_tile<1>(o, vb0, pa0, pa1, pa2, pa3); }
        float own[16], last[16];
#pragma unroll
        for (int k = 0; k < 16; ++k) { const int q = k & 3; const fa::f32x16& px = (k >> 2) == 0 ? p0 : (k >> 2) == 1 ? p1 : (k >> 2) == 2 ? p2 : p3;
            own[k] = ((px[4 * q] + px[4 * q + 1]) + (px[4 * q + 2] + px[4 * q + 3])) * inv; last[k] = px[4 * q + 3] * inv; }
        LAS float* dst = imps + ((g * 64 + tl0 + r32) * 32 + hi);
#pragma unroll
        for (int k = 0; k < 16; ++k) { const float x = __shfl_xor(last[k], 32); const float xp = (k > 0) ? __shfl_xor(last[k > 0 ? k - 1 : 0], 32) : 0.f;
            dst[2 * k] = own[k] + (hi ? x : xp); }
        const float g0 = sigm(bf2f((P + (size_t)m0 * LDP + C_GA + h * 3)[(unsigned)(r32 * LDP)]) + a.b_gate[h * 3]);
        float rli[16]; fa::row_factors(inv * g0, rli, lds, c.wave, r32, hi);
        __syncthreads();
        LAS float* st = (LAS float*)lds + c.wave * 2048;
#define CMP_HALF(HF) do { f32x4 lo[4], hh[4]; fa::stage_half<HF>(o, rli, st, r32, hi, lane, lo, hh); \
        _Pragma("unroll") for (int q = 0; q < 4; ++q) { const int idx = q * 64 + lane; bf16* ob = OC + (size_t)(m0 + (idx >> 3)) * 2048 + h * 128 + HF * 64 + 8 * (idx & 7); \
            { v4u w_; w_.x = fa::cvtpk(lo[q][0], lo[q][1]); w_.y = fa::cvtpk(lo[q][2], lo[q][3]); w_.z = fa::cvtpk(hh[q][0], hh[q][1]); w_.w = fa::cvtpk(hh[q][2], hh[q][3]); *(GAS v4u*)ob = w_; } } } while (0)
        CMP_HALF(0); CMP_HALF(1);
#undef CMP_HALF
    }
#pragma unroll 1
    for (int tt = 0; tt < 4; ++tt) {
        const int tl = c.wave * 8 + tt * 2 + hi, j = r32, tq = 64 * tb + tl, cur = tq >> 6;
        float imp = (imps[(0 * 64 + tl) * 32 + j] + imps[(1 * 64 + tl) * 32 + j]) + (imps[(2 * 64 + tl) * 32 + j] + imps[(3 * 64 + tl) * 32 + j]);
        const bool forced = (j == 0) || (j == cur) || (j == cur - 1);
        float v = forced ? imp + 1e4f : imp;
        if (j > cur) v = NEG;
        int rank = 0;
        for (int jj = 0; jj < 32; ++jj) { const float vo = __shfl(v, (lane & 32) + jj); rank += (vo > v || (vo == v && jj < j)) ? 1 : 0; }
        const bool sel = (rank < TOPN) && (j <= cur);
        const unsigned long long bal = __ballot(sel);
        if (r32 == 0) SEL[bh * SEQ + tq] = (unsigned)(bal >> (32 * hi));
    }
    __syncthreads();
}
__device__ __forceinline__ void p3_cmp_mfma(const Args& a, const Ctx& c) {
    for (int it = c.bid; it < 512; it += c.G) {
        const int bh = (it >> 5) & 15, tb = (it & 31) ^ ((it >> 8) ? 31 : 0);
        cmp_item(a, c, bh >> 2, bh & 3, tb);
    }
}

__device__ __forceinline__ void p6_final(const Args& a, const Ctx& c) {
    const bf16* Y = (const bf16*)(a.ws + WS_Y);
    for (int m = c.gw; m < M; m += c.NGW) {
        const GAS v4u* yr = (const GAS v4u*)(Y + (size_t)m * DM) + c.lane;
        v4u yv[8]; float s = 0.f;
#pragma unroll
        for (int j = 0; j < 8; ++j) yv[j] = yr[64 * j];
        const GAS f32x4* xr = (const GAS f32x4*)(a.x + (size_t)m * DM) + 2 * c.lane;
        GAS f32x4* orow = (GAS f32x4*)(a.out + (size_t)m * DM) + 2 * c.lane;
#pragma unroll
        for (int j = 0; j < 8; ++j) { const float y0 = fa::bflo(yv[j].x), y1 = fa::bfhi(yv[j].x), y2 = fa::bflo(yv[j].y), y3 = fa::bfhi(yv[j].y),
                                                  y4 = fa::bflo(yv[j].z), y5 = fa::bfhi(yv[j].z), y6 = fa::bflo(yv[j].w), y7 = fa::bfhi(yv[j].w);
            s += ((y0 * y0 + y1 * y1) + (y2 * y2 + y3 * y3)) + ((y4 * y4 + y5 * y5) + (y6 * y6 + y7 * y7)); }
        const float rstd = 1.0f / sqrtf(wave_sum(s) * (1.0f / DM) + EPS);
#pragma unroll
        for (int j = 0; j < 8; ++j) {
            const f32x4 w0 = ((const GAS f32x4*)a.post_w)[2 * c.lane + 128 * j], w1 = ((const GAS f32x4*)a.post_w)[2 * c.lane + 128 * j + 1];
            const f32x4 x0 = xr[128 * j], x1 = xr[128 * j + 1];
            const f32x4 ya = {fa::bflo(yv[j].x), fa::bfhi(yv[j].x), fa::bflo(yv[j].y), fa::bfhi(yv[j].y)}, yb = {fa::bflo(yv[j].z), fa::bfhi(yv[j].z), fa::bflo(yv[j].w), fa::bfhi(yv[j].w)};
            orow[128 * j] = x0 + ya * rstd * w0; orow[128 * j + 1] = x1 + yb * rstd * w1; }
    }
}


#ifndef MK_SPLIT
#define MK_SPLIT 0
#endif
constexpr int NPHASE = 8;

__global__ void __launch_bounds__(NWAVES * 64, 2) fwd_kernel(Args args) {
    extern __shared__ __attribute__((aligned(16))) unsigned char lds_raw[];
    Ctx c;
    c.lds = (LAS unsigned char*)lds_raw;
    c.tid = threadIdx.x; c.lane = c.tid & 63; c.wave = __builtin_amdgcn_readfirstlane(c.tid >> 6);
    c.G = gridDim.x; c.bid = blockIdx.x; c.gw = c.bid * NWAVES + c.wave; c.NGW = c.G * NWAVES;
    unsigned char* ws = args.ws;
    gu32* ctl = (gu32*)(ws + WS_CTL);
    volatile LAS unsigned* MISC = (volatile LAS unsigned*)(c.lds + MISC_OFF);
    for (int u = c.tid; u < (LDS_BYTES - LDSCTL_OFF) / 4; u += NWAVES * 64) ((LAS unsigned*)(c.lds + LDSCTL_OFF))[u] = 0u;
    __syncthreads();
    XcdBarrier bar; bar.bar = (unsigned*)(ctl + CW_BAR); bar.x = 0; bar.st = nullptr;
    if (!MK_SPLIT) bar = xcd_barrier_post((unsigned*)(ctl + CW_BAR), MISC + 8);
    const int lo = args.ph_lo, hi = args.ph_hi;
#define IN(k) (lo <= (k) && (k) < hi)
#define SEAM(k) do { if (IN(k) && IN((k) + 1)) xcd_barrier(bar); } while (0)

    if (IN(0)) { p0_prologue(args, c); } SEAM(0);
    if (IN(1)) {
        pg8::Gemm g{(const pg8::bf16_t*)(ws + WS_HB), (const pg8::bf16_t*)(ws + WS_WIN), M, NP, DM, DM}; pg8::StaticOrder S; S.init(M, NP, c.G, c.bid);
        pg8::EpiP E{(pg8::bf16_t*)(ws + WS_P), NP, (pg8::bf16_t*)(ws + WS_QR), (pg8::bf16_t*)(ws + WS_XKV), (const float*)(ws + WS_COS), (const float*)(ws + WS_SIN)};
        pg8::gemm_phase<pg8::EpiP, pg8::StaticOrder, true, true>(c.lds + RING_OFF, g, S, E);
        {
            const int rem = ((M / 256) * (NP / 256)) % c.G, nt_ = rem ? c.G - rem : c.G, ti = rem ? c.bid - rem : c.bid;
            if (ti >= 0) p0_transposes(args, c, TI_IN, TI_ALL, ti * NWAVES + c.wave, nt_ * NWAVES);
        }
    } SEAM(1);
    if (IN(2)) {
        pg8::Gemm g{(const pg8::bf16_t*)(ws + WS_XKV), (const pg8::bf16_t*)(ws + WS_WLR), 4096, 1024, 256, 2048}; pg8::CmpOrder S{c.bid, c.G};
        pg8::EpiLR E{(float*)(ws + WS_LR), 1024, (size_t)4096 * 1024};
        pg8::gemm_phase<pg8::EpiLR, pg8::CmpOrder, false, true>(c.lds + RING_OFF, g, S, E);
    } SEAM(2);
    if (IN(3)) { p2c_stage2(args, c); } SEAM(3);
    if (IN(4)) { p3_cmp_mfma(args, c); } SEAM(4);
    if (IN(5)) {
        p4_nsa_mfma(args, c);
        p4_dil_mfma(args, c);
    } SEAM(5);
    if (IN(6)) {
        pg8::Gemm g{(const pg8::bf16_t*)(ws + WS_MIX), (const pg8::bf16_t*)(ws + WS_WOUT), M, DM, DM, DM}; pg8::StaticOrder S; S.init(M, DM, c.G, c.bid);
        pg8::EpiBf16<0> E{(pg8::bf16_t*)(ws + WS_Y), DM, nullptr, 0, 0, 1.f};
        pg8::gemm_phase<pg8::EpiBf16<0>, pg8::StaticOrder, true, true>(c.lds + RING_OFF, g, S, E);
    } SEAM(6);
    if (IN(7)) { p6_final(args, c); }
#undef IN
#undef SEAM
}

extern "C" void kernel_launch(void* const* d_in, const int* in_sizes, int n_in, void* d_out, int out_size, void* d_ws, size_t ws_size, hipStream_t stream) {
    static int grid = 0;
    if (grid == 0) {
        if (n_in != 13 || out_size != M * DM || ws_size < WS_END) { fprintf(stderr, "kernel_launch: unexpected shapes (n_in %d out %d ws %zu)\n", n_in, out_size, ws_size); grid = -1; return; }
        int dev = 0, cus = 0, per_cu = 0;
        if (hipGetDevice(&dev) != hipSuccess || hipDeviceGetAttribute(&cus, hipDeviceAttributeMultiprocessorCount, dev) != hipSuccess) { grid = -1; return; }
        if (hipFuncSetAttribute((const void*)fwd_kernel, hipFuncAttributeMaxDynamicSharedMemorySize, LDS_BYTES) != hipSuccess) { fprintf(stderr, "kernel_launch: hipFuncSetAttribute failed\n"); grid = -1; return; }
        if (hipOccupancyMaxActiveBlocksPerMultiprocessor(&per_cu, (const void*)fwd_kernel, NWAVES * 64, LDS_BYTES) != hipSuccess || per_cu < 1)
            fprintf(stderr, "kernel_launch: occupancy query reports %d\n", per_cu);
        (void)hipGetLastError();
        grid = cus;
    }
    if (grid < 0) return;
    if (hipMemsetAsync((char*)d_ws + WS_CTL, 0, CTL_ZERO_BYTES, stream) != hipSuccess) return;
    Args a{};
    a.x = (const float*)d_in[0]; a.pos = (const int*)d_in[1]; a.pre_w = (const float*)d_in[2]; a.post_w = (const float*)d_in[3];
    a.w_in = (const float*)d_in[4]; a.b_gate = (const float*)d_in[5]; a.pe_k = (const float*)d_in[6]; a.pe_v = (const float*)d_in[7];
    a.wk1 = (const float*)d_in[8]; a.wk2 = (const float*)d_in[9]; a.wv1 = (const float*)d_in[10]; a.wv2 = (const float*)d_in[11]; a.w_out = (const float*)d_in[12];
    a.out = (float*)d_out; a.ws = (unsigned char*)d_ws;
#if MK_SPLIT
    for (int p = 0; p < NPHASE; ++p) { a.ph_lo = p; a.ph_hi = p + 1; hipLaunchKernelGGL(fwd_kernel, dim3(grid), dim3(NWAVES * 64), LDS_BYTES, stream, a); }
#else
    a.ph_lo = 0; a.ph_hi = NPHASE;
    hipLaunchKernelGGL(fwd_kernel, dim3(grid), dim3(NWAVES * 64), LDS_BYTES, stream, a);
#endif
}
```

```cpp
#include <hip/hip_runtime.h>
#include <cstdio>
#include <cstdint>
namespace pg8 {
#define PG8_LAS __attribute__((address_space(3)))
typedef unsigned short bf16_t;
typedef short bf16x8 __attribute__((ext_vector_type(8)));
typedef float f32x4 __attribute__((ext_vector_type(4)));
typedef unsigned u32x4 __attribute__((ext_vector_type(4)));
constexpr int BM = 256, BK = 64, HALF = 128, HTB = HALF * BK * 2  , STAGE_BYTES = 8 * HTB, NXCD = 8, WGM = 8;

__host__ __device__ __forceinline__ int lds_byte(int r, int c) { const int st = (r >> 4) * 2 + (c >> 5), rr = r & 15, cc = c & 31, ob = rr * 64 + cc * 2; return st * 1024 + (ob ^ (((ob >> 9) & 1) << 5)); }
__host__ __device__ __forceinline__ void stage_rc(int b, int& R, int& C) { const int st = b / 1024, sb = b % 1024, swz = sb ^ (((sb >> 9) & 1) << 5); R = (st >> 1) * 16 + swz / 64; C = (st & 1) * 32 + (swz % 64) / 2; }
__host__ __device__ __forceinline__ int perm32(int rho) { const int n = rho >> 4, i = rho & 15; return 8 * (i >> 2) + 4 * n + (i & 3); }

struct Unit { int pm, pn, ko; };
struct Gemm { const bf16_t* A; const bf16_t* Bt; int M, N, K, ld; };

struct StaticOrder {
    int nM, nN, nwg, G, c;
    __host__ __device__ void init(int M, int N, int G_, int c_) { nM = M / BM; nN = N / BM; nwg = nM * nN; G = G_; c = c_; }
    __host__ __device__ bool next(int i, Unit& u) const {
        const long L = (long)i * G + c; if (L >= nwg) return false;
        int wgid = (int)L; { const int q = nwg / NXCD, r = nwg % NXCD, xcd = wgid % NXCD, off = wgid / NXCD; wgid = (xcd < r ? xcd * (q + 1) : r * (q + 1) + (xcd - r) * q) + off; }
        const int nig = WGM * nN, gid = wgid / nig, fm = gid * WGM, gsz = (nM - fm) < WGM ? (nM - fm) : WGM;
        u.pm = fm + ((wgid % nig) % gsz); u.pn = (wgid % nig) / gsz; u.ko = 0; return true;
    }
    __device__ __forceinline__ void a_ready(const Unit&) const {}
    __device__ __forceinline__ void done(const Unit&) const {}
};

__device__ __forceinline__ unsigned cvt_pk_bf16(float lo, float hi) { unsigned r; asm volatile("v_cvt_pk_bf16_f32 %0, %1, %2" : "=v"(r) : "v"(lo), "v"(hi)); return r; }
typedef float f32x2 __attribute__((ext_vector_type(2)));
__device__ __forceinline__ f32x2 gelu_pk(f32x2 v) {
    const f32x2 av = __builtin_elementwise_abs(v), d = av * 0.2316418882f + 1.0f;
    f32x2 t; t.x = __builtin_amdgcn_rcpf(d.x); t.y = __builtin_amdgcn_rcpf(d.y);
    f32x2 q = t * 0.5307027145f + (-0.7265760135f); q = q * t + 0.7107068705f; q = q * t + (-0.142248368f); q = q * t + 0.127414796f; q = q * t;
    const f32x2 s = (v * v) * (-0.72134752044f);
    f32x2 e; e.x = __builtin_amdgcn_exp2f(s.x); e.y = __builtin_amdgcn_exp2f(s.y);
    const f32x2 m = v * (q * e), r = v - m;
    f32x2 o; o.x = v.x < 0.f ? m.x : r.x; o.y = v.y < 0.f ? m.y : r.y; return o;
}

template <int ACT  > struct EpiBf16 {
    static constexpr bool PERM = true, AFTER_DRAIN = false; static_assert(ACT == 0 || ACT == 1, "EpiBf16: ACT is 0 (none) or 1 (gelu_pk)");
    bf16_t* O; int ldc; const float* bias; int split_cols; size_t split_stride; float scale0;
    __device__ __forceinline__ void operator()(const f32x4 (&acc)[2][2][4][2], const Unit& u, int wr, int wc, int fr, int fq) const {
        const int row0 = u.pm * BM + wr * 64 + fr; int colt = u.pn * BM; bf16_t* base = O;
        float sc = 1.f; if (split_cols) { const int t = colt / split_cols; base += (size_t)t * split_stride; colt -= t * split_cols; if (t == 0) sc = scale0; }
        const int col0 = colt + wc * 32 + 8 * fq, bcol0 = u.pn * BM + wc * 32 + 8 * fq;
        f32x4 bv[2][2];
#pragma unroll
        for (int bj = 0; bj < 2; ++bj)
#pragma unroll
            for (int n = 0; n < 2; ++n) bv[bj][n] = bias ? *(const f32x4*)(bias + bcol0 + bj * HALF + 4 * n) : (f32x4){0.f, 0.f, 0.f, 0.f};
#pragma unroll
        for (int ai = 0; ai < 2; ++ai)
#pragma unroll
            for (int m = 0; m < 4; ++m) { bf16_t* rowp = base + (size_t)(row0 + ai * HALF + m * 16) * ldc + col0;
#pragma unroll
                for (int bj = 0; bj < 2; ++bj) { f32x4 v0 = acc[ai][bj][m][0] + bv[bj][0], v1 = acc[ai][bj][m][1] + bv[bj][1];
                    if (ACT == 1) { f32x2 a = gelu_pk((f32x2){v0[0], v0[1]}), b = gelu_pk((f32x2){v0[2], v0[3]}), c = gelu_pk((f32x2){v1[0], v1[1]}), d = gelu_pk((f32x2){v1[2], v1[3]});
                        v0 = (f32x4){a.x, a.y, b.x, b.y}; v1 = (f32x4){c.x, c.y, d.x, d.y}; }
                    v0 = v0 * sc; v1 = v1 * sc; u32x4 w; w.x = cvt_pk_bf16(v0[0], v0[1]); w.y = cvt_pk_bf16(v0[2], v0[3]); w.z = cvt_pk_bf16(v1[0], v1[1]); w.w = cvt_pk_bf16(v1[2], v1[3]);
                    *(u32x4*)(rowp + bj * HALF) = w; } }
    }
};
struct EpiF32 {
    static constexpr bool PERM = false, AFTER_DRAIN = false;
    float* O; int ldc;
    __device__ __forceinline__ void operator()(const f32x4 (&acc)[2][2][4][2], const Unit& u, int wr, int wc, int fr, int fq) const {
        const int row0 = u.pm * BM + wr * 64 + fr, col0 = u.pn * BM + wc * 32 + 4 * fq;
#pragma unroll
        for (int ai = 0; ai < 2; ++ai)
#pragma unroll
            for (int m = 0; m < 4; ++m) { float* rowp = O + (size_t)(row0 + ai * HALF + m * 16) * ldc + col0;
#pragma unroll
                for (int bj = 0; bj < 2; ++bj)
#pragma unroll
                    for (int n = 0; n < 2; ++n) *(f32x4*)(rowp + bj * HALF + n * 16) = acc[ai][bj][m][n]; }
    }
};

struct EpiP {
    static constexpr bool PERM = true, AFTER_DRAIN = false;
    bf16_t* Pm; int ldc; bf16_t* QR; bf16_t* XKV; const float* COS; const float* SIN;
    __device__ __forceinline__ void operator()(const f32x4 (&acc)[2][2][4][2], const Unit& u, int wr, int wc, int fr, int fq) const {
        const int pn = u.pn;
        const bool is_qa = pn < 8, is_rope = is_qa || pn == 20 || pn == 21 || pn == 24 || pn == 25 || (pn >= 28 && pn < 44), is_x = pn >= 16 && pn < 20;
        const int row0 = u.pm * BM + wr * 64 + fr, colw = wc * 32 + 8 * fq;
#pragma unroll
        for (int ai = 0; ai < 2; ++ai)
#pragma unroll
            for (int m = 0; m < 4; ++m) {
                const int row = row0 + ai * HALF + m * 16;
                f32x4 cs = {1.f, 1.f, 1.f, 1.f}, sn = {0.f, 0.f, 0.f, 0.f};
                if (is_rope) { cs = *(const f32x4*)(COS + (size_t)row * 64 + 16 * wc + 4 * fq); sn = *(const f32x4*)(SIN + (size_t)row * 64 + 16 * wc + 4 * fq); }
#pragma unroll
                for (int bj = 0; bj < 2; ++bj) {
                    const f32x4 v0 = acc[ai][bj][m][0], v1 = acc[ai][bj][m][1];
                    u32x4 w;
                    if (!is_rope || is_qa) { w.x = cvt_pk_bf16(v0[0], v0[1]); w.y = cvt_pk_bf16(v0[2], v0[3]); w.z = cvt_pk_bf16(v1[0], v1[1]); w.w = cvt_pk_bf16(v1[2], v1[3]); }
                    if (is_x) { const int hq = (pn - 16) * 2 + bj, kv = hq >> 2, hk = hq & 3, b = row >> 11, tok = row & 2047;
                        *(u32x4*)(XKV + ((size_t)((kv * 16 + b * 4 + hk) * 2048 + tok)) * 128 + colw) = w; }
                    else if (!is_rope) { *(u32x4*)(Pm + (size_t)row * ldc + pn * BM + bj * HALF + colw) = w; }
                    else {
                        if (is_qa) *(u32x4*)(Pm + (size_t)row * ldc + pn * BM + bj * HALF + colw) = w;
                        const f32x4 r0 = v0 * cs - v1 * sn, r1 = v1 * cs + v0 * sn;
                        u32x4 wr_; wr_.x = cvt_pk_bf16(r0[0], r0[1]); wr_.y = cvt_pk_bf16(r0[2], r0[3]); wr_.z = cvt_pk_bf16(r1[0], r1[1]); wr_.w = cvt_pk_bf16(r1[2], r1[3]);
                        if (is_qa) *(u32x4*)(QR + (size_t)row * 2048 + pn * BM + bj * HALF + colw) = wr_;
                        else *(u32x4*)(Pm + (size_t)row * ldc + pn * BM + bj * HALF + colw) = wr_;
                    }
                }
            }
    }
};

struct EpiLR {
    static constexpr bool PERM = false, AFTER_DRAIN = false;
    float* O; int ldc; size_t ks_stride;
    __device__ __forceinline__ void operator()(const f32x4 (&acc)[2][2][4][2], const Unit& u, int wr, int wc, int fr, int fq) const {
        const int row0 = u.pm * BM + wr * 64 + fr, col0 = u.pn * BM + wc * 32 + 4 * fq; float* Ob = O + (size_t)(u.ko >> 8) * ks_stride;
#pragma unroll
        for (int ai = 0; ai < 2; ++ai)
#pragma unroll
            for (int m = 0; m < 4; ++m) { float* rowp = Ob + (size_t)(row0 + ai * HALF + m * 16) * ldc + col0;
#pragma unroll
                for (int bj = 0; bj < 2; ++bj)
#pragma unroll
                    for (int n = 0; n < 2; ++n) *(f32x4*)(rowp + bj * HALF + n * 16) = acc[ai][bj][m][n]; }
    }
};
struct CmpOrder { int c, G;
    __device__ __forceinline__ bool next(int i, Unit& u) const { const int L = i * G + c; if (L >= 256) return false;
        const int ks = L & 7, q = L >> 3, kv = q >> 4, pmi = (q >> 1) & 7, pni = q & 1; u.pm = kv * 8 + pmi; u.pn = kv * 2 + pni; u.ko = ks * 256; return true; }
    __device__ __forceinline__ void a_ready(const Unit&) const {}
    __device__ __forceinline__ void done(const Unit&) const {}
};

template <class Epi, class Sched, bool ALIGN_EPI = false, bool SP2 = false>
__device__ __forceinline__ void gemm_phase(PG8_LAS unsigned char* lds, const Gemm g, const Sched& S, const Epi& E) {
    const int tid = threadIdx.x, wid = __builtin_amdgcn_readfirstlane(tid >> 6), lane = tid & 63, wr = wid >> 2, wc = wid & 3, fr = lane & 15, fq = lane >> 4;
    const int K = g.K, nt = K / BK, ld = g.ld;
    unsigned voffA[2], voffB[2];
#pragma unroll
    for (int i = 0; i < 2; ++i) { int R, C; stage_rc(tid * 16 + i * 8192, R, C); const int Rb = Epi::PERM ? ((R & ~31) + perm32(R & 31)) : R;
        voffA[i] = (unsigned)(R * ld + C) * 2u; voffB[i] = (unsigned)(Rb * ld + C) * 2u; }
    const size_t kstep = (size_t)(BK * 2);
    const size_t hstep = (size_t)HALF * ld * 2;
    const size_t tstep = 2 * hstep;
    const unsigned ldsw = (unsigned)wid * 1024u;
    const int aoff = lds_byte(wr * 64 + fr, fq * 8), boff = lds_byte(wc * 32 + fr, fq * 8);
#define PG8_SA(b, h) (((b) * 2 + (h)) * HTB)
#define PG8_SB(b, h) ((4 + (b) * 2 + (h)) * HTB)
#define PG8_STAGE(bufoff, gbase, voff) do { _Pragma("unroll") for (int _i = 0; _i < 2; ++_i) \
        __builtin_amdgcn_global_load_lds((const unsigned*)((const char*)(gbase) + (voff)[_i]), (PG8_LAS unsigned*)(lds + (bufoff) + ldsw + _i * 8192), 16, 0, 0); } while (0)
#define PG8_LDA(dst, b, h) do { _Pragma("unroll") for (int m = 0; m < 4; ++m) _Pragma("unroll") for (int k = 0; k < 2; ++k) dst[m][k] = *(const PG8_LAS bf16x8*)(lds + PG8_SA(b, h) + aoff + m * 2048 + k * 1024); } while (0)
#define PG8_LDB(dst, b, h) do { _Pragma("unroll") for (int n = 0; n < 2; ++n) _Pragma("unroll") for (int k = 0; k < 2; ++k) dst[n][k] = *(const PG8_LAS bf16x8*)(lds + PG8_SB(b, h) + boff + n * 2048 + k * 1024); } while (0)
#define PG8_MMA(ai, bj, At, Bt) do { __builtin_amdgcn_s_setprio(1); _Pragma("unroll") for (int m = 0; m < 4; ++m) _Pragma("unroll") for (int n = 0; n < 2; ++n) _Pragma("unroll") for (int k = 0; k < 2; ++k) \
        acc[ai][bj][m][n] = __builtin_amdgcn_mfma_f32_16x16x32_bf16(Bt[n][k], At[m][k], acc[ai][bj][m][n], 0, 0, 0); __builtin_amdgcn_s_setprio(0); } while (0)
#define PG8_WAIT_V(n) asm volatile("s_waitcnt vmcnt(" #n ")" ::: "memory")
#define PG8_WAIT_L(n) asm volatile("s_waitcnt lgkmcnt(" #n ")" ::: "memory")
#define PG8_BAR __builtin_amdgcn_s_barrier()
#define PG8_SCHED __builtin_amdgcn_sched_barrier(0)
    Unit cur, nxt; int ui = 0;
    if (!S.next(0, cur)) return;
    f32x4 acc[2][2][4][2];
#pragma unroll
    for (int a = 0; a < 2; ++a)
#pragma unroll
        for (int b = 0; b < 2; ++b)
#pragma unroll
            for (int m = 0; m < 4; ++m)
#pragma unroll
                for (int n = 0; n < 2; ++n) acc[a][b][m][n] = (f32x4){0.f, 0.f, 0.f, 0.f};
    bf16x8 At[4][2], B0[2][2], B1[2][2];
    const char* cA = (const char*)g.A + (size_t)cur.pm * tstep + (size_t)cur.ko * 2; const char* cB = (const char*)g.Bt + (size_t)cur.pn * tstep + (size_t)cur.ko * 2;
    S.a_ready(cur);
    if constexpr (SP2) {
        PG8_STAGE(PG8_SB(0, 0), cB, voffB); PG8_STAGE(PG8_SB(0, 1), cB + hstep, voffB); PG8_STAGE(PG8_SA(0, 0), cA, voffA); PG8_STAGE(PG8_SA(0, 1), cA + hstep, voffA);
        if (wr == 1) PG8_BAR;
        PG8_WAIT_V(2); PG8_BAR;
        PG8_STAGE(PG8_SB(1, 0), cB + kstep, voffB); PG8_STAGE(PG8_SA(1, 0), cA + kstep, voffA); PG8_STAGE(PG8_SB(1, 1), cB + hstep + kstep, voffB);
        PG8_WAIT_V(6); PG8_BAR;
    } else {
        PG8_STAGE(PG8_SB(0, 0), cB, voffB); PG8_STAGE(PG8_SA(0, 0), cA, voffA); PG8_STAGE(PG8_SB(0, 1), cB + hstep, voffB); PG8_STAGE(PG8_SA(0, 1), cA + hstep, voffA);
        if (wr == 1) PG8_BAR;
        PG8_WAIT_V(4); PG8_BAR;
        PG8_STAGE(PG8_SB(1, 0), cB + kstep, voffB); PG8_STAGE(PG8_SA(1, 0), cA + kstep, voffA); PG8_STAGE(PG8_SB(1, 1), cB + hstep + kstep, voffB);
        PG8_WAIT_V(6); PG8_BAR;
    }
    for (;;) {
        const bool has_next = S.next(ui + 1, nxt);
        const char* nA = has_next ? (const char*)g.A + (size_t)nxt.pm * tstep + (size_t)nxt.ko * 2 : cA; const char* nB = has_next ? (const char*)g.Bt + (size_t)nxt.pn * tstep + (size_t)nxt.ko * 2 : cB;
        for (int t = 0; t < nt; t += 2) {
            const bool last = (t == nt - 2);
            const char* a1 = cA + (size_t)(t + 1) * kstep;
            const char* a2 = last ? nA : cA + (size_t)(t + 2) * kstep; const char* b2 = last ? nB : cB + (size_t)(t + 2) * kstep;
            const char* a3 = a2 + kstep; const char* b3 = b2 + kstep;
            if (last && has_next) S.a_ready(nxt);
            if constexpr (SP2) {
            PG8_LDB(B0, 0, 0); PG8_LDB(B1, 0, 1); PG8_SCHED; PG8_LDA(At, 0, 0); PG8_STAGE(PG8_SA(1, 1), a1 + hstep, voffA);
            PG8_WAIT_V(8); PG8_WAIT_L(0); PG8_BAR; PG8_MMA(0, 0, At, B0); PG8_MMA(0, 1, At, B1); PG8_BAR; PG8_SCHED;
            PG8_LDA(At, 0, 1); PG8_STAGE(PG8_SB(0, 0), b2, voffB); PG8_STAGE(PG8_SB(0, 1), b2 + hstep, voffB); PG8_STAGE(PG8_SA(0, 0), a2, voffA);
            PG8_WAIT_V(8); PG8_WAIT_L(0); PG8_BAR; PG8_MMA(1, 0, At, B0); PG8_MMA(1, 1, At, B1); PG8_BAR; PG8_SCHED;
            PG8_LDB(B0, 1, 0); PG8_LDB(B1, 1, 1); PG8_SCHED; PG8_LDA(At, 1, 0); PG8_STAGE(PG8_SA(0, 1), a2 + hstep, voffA);
            PG8_WAIT_V(8); PG8_WAIT_L(0); PG8_BAR; PG8_MMA(0, 0, At, B0); PG8_MMA(0, 1, At, B1); PG8_BAR; PG8_SCHED;
            PG8_LDA(At, 1, 1); PG8_STAGE(PG8_SB(1, 0), b3, voffB); PG8_STAGE(PG8_SB(1, 1), b3 + hstep, voffB); PG8_STAGE(PG8_SA(1, 0), a3, voffA);
            PG8_WAIT_V(8); PG8_WAIT_L(0); PG8_BAR; PG8_MMA(1, 0, At, B0); PG8_MMA(1, 1, At, B1); PG8_BAR; PG8_SCHED;
            } else {
            PG8_LDB(B0, 0, 0); PG8_SCHED; PG8_LDA(At, 0, 0); PG8_STAGE(PG8_SA(1, 1), a1 + hstep, voffA);
            PG8_WAIT_L(8); PG8_BAR; PG8_WAIT_L(0); PG8_MMA(0, 0, At, B0); PG8_BAR; PG8_SCHED;
            PG8_LDB(B1, 0, 1); PG8_STAGE(PG8_SB(0, 0), b2, voffB);
            PG8_BAR; PG8_WAIT_L(0); PG8_MMA(0, 1, At, B1); PG8_BAR;
            PG8_LDA(At, 0, 1); PG8_STAGE(PG8_SA(0, 0), a2, voffA);
            PG8_BAR; PG8_WAIT_L(0); PG8_MMA(1, 0, At, B0); PG8_BAR; PG8_SCHED;
            PG8_STAGE(PG8_SB(0, 1), b2 + hstep, voffB);
            PG8_WAIT_V(6); PG8_BAR; PG8_MMA(1, 1, At, B1); PG8_BAR;
            PG8_LDB(B0, 1, 0); PG8_SCHED; PG8_LDA(At, 1, 0); PG8_STAGE(PG8_SA(0, 1), a2 + hstep, voffA);
            PG8_WAIT_L(8); PG8_BAR; PG8_WAIT_L(0); PG8_MMA(0, 0, At, B0); PG8_BAR; PG8_SCHED;
            PG8_LDB(B1, 1, 1); PG8_STAGE(PG8_SB(1, 0), b3, voffB);
            PG8_BAR; PG8_WAIT_L(0); PG8_MMA(0, 1, At, B1); PG8_BAR;
            PG8_LDA(At, 1, 1); PG8_STAGE(PG8_SA(1, 0), a3, voffA);
            PG8_BAR; PG8_WAIT_L(0); PG8_MMA(1, 0, At, B0); PG8_BAR; PG8_SCHED;
            PG8_STAGE(PG8_SB(1, 1), b3 + hstep, voffB);
            PG8_WAIT_V(6); PG8_BAR; PG8_MMA(1, 1, At, B1); PG8_BAR;
            }
        }
        if constexpr (ALIGN_EPI) { if (wr == 0) PG8_BAR; }
        if constexpr (!Epi::AFTER_DRAIN) { E(acc, cur, wr, wc, fr, fq); S.done(cur); }
        if (!has_next) break;
#pragma unroll
        for (int a = 0; a < 2; ++a)
#pragma unroll
            for (int b = 0; b < 2; ++b)
#pragma unroll
                for (int m = 0; m < 4; ++m)
#pragma unroll
                    for (int n = 0; n < 2; ++n) acc[a][b][m][n] = (f32x4){0.f, 0.f, 0.f, 0.f};
        cur = nxt; cA = nA; cB = nB; ++ui;
        if constexpr (ALIGN_EPI) { if (wr == 1) PG8_BAR; }
    }
    PG8_WAIT_V(0);
    if constexpr (!ALIGN_EPI) { if (wr == 0) PG8_BAR; }
    PG8_BAR;
    if constexpr (Epi::AFTER_DRAIN) { E.fused(acc, cur, wr, wc, fr, fq, lds, wid, lane); S.done(cur); }
#undef PG8_SA
#undef PG8_SB
#undef PG8_STAGE
#undef PG8_LDA
#undef PG8_LDB
#undef PG8_MMA
#undef PG8_WAIT_V
#undef PG8_WAIT_L
#undef PG8_BAR
#undef PG8_SCHED
}
}
#define GAS __attribute__((address_space(1)))
#define LAS __attribute__((address_space(3)))
typedef unsigned short bf16;
typedef unsigned v4u __attribute__((ext_vector_type(4)));
typedef float f32x4 __attribute__((ext_vector_type(4)));
typedef short bf16x8 __attribute__((ext_vector_type(8)));
typedef GAS unsigned gu32;
typedef GAS unsigned long long gu64;
#define RLX_AGENT __ATOMIC_RELAXED, __HIP_MEMORY_SCOPE_AGENT
#define LDS_WAIT() asm volatile("s_waitcnt lgkmcnt(0)" ::: "memory")
#define VM_WAIT() asm volatile("s_waitcnt vmcnt(0)" ::: "memory")
__device__ __forceinline__ unsigned long long rt() { return __builtin_amdgcn_s_memrealtime(); }
__device__ __forceinline__ unsigned f2bf(float f) { unsigned u = __builtin_bit_cast(unsigned, f); return (u + 0x7fffu + ((u >> 16) & 1u)) >> 16; }
__device__ __forceinline__ unsigned pk2(float lo, float hi) { return f2bf(lo) | (f2bf(hi) << 16); }

#define XB_TMO      128
#define XB_XCNT(j)  (256  + 64 * (j))
#define XB_XSUB(j)  (1280 + 64 * (j))
#define XB_XGEN(j)  (2304 + 64 * (j))
#define XB_TOP      3328
#define XB_TOPGEN   3392
#define XCD_BAR_WORDS 3456
#define XB_SPIN_CAP (1u << 24)

__device__ __forceinline__ unsigned xb_ld(unsigned* p)              { return __hip_atomic_load(p, __ATOMIC_RELAXED, __HIP_MEMORY_SCOPE_AGENT); }
__device__ __forceinline__ unsigned xb_add(unsigned* p, unsigned v) { return __hip_atomic_fetch_add(p, v, __ATOMIC_RELAXED, __HIP_MEMORY_SCOPE_AGENT); }
__device__ __forceinline__ unsigned xb_xcc_id() { return (unsigned)__builtin_amdgcn_s_getreg((3 << 11) | 20) & 0xFu; }
#define XB_SPIN(cond, bar) do { unsigned _sp = 0; while (cond) { __builtin_amdgcn_s_sleep(1); \
    if ((++_sp & 255u) == 0u) { if (xb_ld(&(bar)[XB_TMO])) break; if (_sp > XB_SPIN_CAP) { atomicAdd(&(bar)[XB_TMO], 1u); break; } } } } while (0)

struct XcdBarrier {
    unsigned* bar; unsigned x;
    volatile LAS unsigned* st;
};

__device__ __forceinline__ XcdBarrier xcd_barrier_post(unsigned* bar, volatile LAS unsigned* st) {
    XcdBarrier b; b.bar = bar; b.x = xb_xcc_id(); b.st = st;
    if (threadIdx.x == 0) (void)xb_add(&bar[XB_XCNT(b.x)], 1u);
    return b;
}
__device__ __forceinline__ void xcd_barrier_complete(unsigned* bar, unsigned x, unsigned& nloc, unsigned& nx) {
    const unsigned G = gridDim.x * gridDim.y * gridDim.z;
    unsigned sum, cnt, mine, sp = 0u;
    for (;;) {
        sum = 0u; cnt = 0u; mine = 0u;
#pragma unroll
        for (unsigned j = 0; j < 16; ++j) { const unsigned c = xb_ld(&bar[XB_XCNT(j)]); sum += c; cnt += (c > 0u) ? 1u : 0u; mine = (j == x) ? c : mine; }
        if (sum == G) break;
        __builtin_amdgcn_s_sleep(1);
        if ((++sp & 255u) == 0u) { if (xb_ld(&bar[XB_TMO])) break; if (sp > XB_SPIN_CAP) { atomicAdd(&bar[XB_TMO], 1u); break; } }
    }
    nloc = mine > 0u ? mine : 1u; nx = cnt > 0u ? cnt : 1u;
}

__device__ __forceinline__ void xcd_barrier(const XcdBarrier& b) {
    asm volatile("s_waitcnt vmcnt(0)" ::: "memory");
    __syncthreads();
    if (threadIdx.x == 0) {
        unsigned* bar = b.bar;
        __builtin_amdgcn_s_waitcnt(0);
        unsigned nloc = b.st[0], nx = b.st[1];
        if (nloc == 0u) { xcd_barrier_complete(bar, b.x, nloc, nx); b.st[0] = nloc; b.st[1] = nx; }
        const unsigned old = xb_add(&bar[XB_XSUB(b.x)], 1u);
        const unsigned gen = old / nloc;
        if (old + 1u == (gen + 1u) * nloc) {
            __builtin_amdgcn_fence(__ATOMIC_RELEASE, "agent");
            asm volatile("s_waitcnt vmcnt(0)" ::: "memory");
            const unsigned og = xb_add(&bar[XB_TOP], 1u);
            const unsigned tg = og / nx;
            if (og + 1u == (tg + 1u) * nx) xb_add(&bar[XB_TOPGEN], 1u);
            else XB_SPIN(xb_ld(&bar[XB_TOPGEN]) == tg, bar);
            __builtin_amdgcn_fence(__ATOMIC_ACQUIRE, "agent");
            xb_add(&bar[XB_XGEN(b.x)], 1u);
            asm volatile("s_waitcnt vmcnt(0)" ::: "memory");
        } else {
            XB_SPIN(xb_ld(&bar[XB_XGEN(b.x)]) == gen, bar);
            __builtin_amdgcn_fence(__ATOMIC_ACQUIRE, "agent");
            asm volatile("s_waitcnt vmcnt(0)" ::: "memory");
        }
    }
    __syncthreads();
}

constexpr int NWAVES = 8;
constexpr int BATCH = 4, SEQ = 2048, DM = 4096, M = BATCH * SEQ;
constexpr int HD = 128, NHA = 16, NKV = 4, GRP = 4, NHB = 16;
constexpr int CIN = 15408, NP = 15616;
constexpr int LDP = NP;
constexpr int C_QA = 0, C_ZA = 2048, C_KC = 4096, C_VC = 4608, C_KSL = 5120, C_VSL = 5632, C_KW = 6144, C_VW = 6656,
              C_QB = 7168, C_KB = 9216, C_VB = 11264, C_ZB = 13312, C_GA = 15360;
constexpr int NCMP = 127, NSEL = 32, TOPN = 16;
constexpr float EPS = 1e-6f;
constexpr float QSCALE = 0.08838834764831845f;

constexpr size_t MiB = 1u << 20;
constexpr size_t WS_CTL = 0, CTL_ZERO_BYTES = 1 * MiB;
constexpr size_t WS_WIN = 2 * MiB;
constexpr size_t WS_WOUT = 124 * MiB;
constexpr size_t WS_HB = 160 * MiB;
constexpr size_t WS_P = 224 * MiB;
constexpr size_t WS_QR = 468 * MiB;
constexpr size_t WS_COS = 500 * MiB;
constexpr size_t WS_SIN = 502 * MiB;
constexpr size_t WS_MIX = 504 * MiB;
constexpr size_t WS_Y = 568 * MiB;
constexpr size_t WS_KCMP = 696 * MiB;
constexpr size_t WS_VCMP = 697 * MiB;
constexpr size_t WS_BIAS1 = 698 * MiB;
constexpr size_t WS_SEL = 699 * MiB;
constexpr size_t WS_OC = 704 * MiB;
constexpr size_t WS_OS = 768 * MiB;
constexpr size_t WS_XKV = 832 * MiB;
constexpr size_t WS_WLR = 848 * MiB;
constexpr size_t WS_KCB = 852 * MiB;
constexpr size_t WS_VCB = 853 * MiB;
constexpr size_t WS_LR = WS_Y;
constexpr size_t WS_END = 854 * MiB;
constexpr int CW_BAR = 4096;

constexpr int RING_OFF = 0, RING_BYTES = 131072;
constexpr int LDSCTL_OFF = RING_BYTES, MISC_OFF = LDSCTL_OFF + 320;
constexpr int LDS_BYTES = 147456;

__device__ __forceinline__ float bf2f(unsigned short u) { return __builtin_bit_cast(float, (unsigned)u << 16); }
__device__ __forceinline__ float wave_sum(float v) {
#pragma unroll
    for (int o = 1; o < 64; o <<= 1) v += __shfl_xor(v, o);
    return v;
}
__device__ __forceinline__ float wave_max(float v) {
#pragma unroll
    for (int o = 1; o < 64; o <<= 1) v = fmaxf(v, __shfl_xor(v, o));
    return v;
}

struct Args {
    const float* x; const int* pos; const float* pre_w; const float* post_w; const float* w_in; const float* b_gate;
    const float* pe_k; const float* pe_v; const float* wk1; const float* wk2; const float* wv1; const float* wv2; const float* w_out;
    float* out; unsigned char* ws; int ph_lo, ph_hi;
};

struct Ctx {
    LAS unsigned char* lds; int tid, lane, wave, G, bid, gw, NGW;
};

__host__ __device__ __forceinline__ int rope_phi(int d) { const int dd = d & 63; return 32 * (dd >> 4) + 8 * ((dd >> 2) & 3) + 4 * (d >> 6) + (dd & 3); }
__device__ __forceinline__ void transpose_item(const float* W, int ldw, int K, int k0, int c0, int ncols, bf16* WT, int r0, LAS float* scr, int lane, bool perm = false) {
#pragma unroll 8
    for (int i = 0; i < 32; ++i) { const int kk = 2 * i + (lane >> 5), n = lane & 31; scr[kk * 33 + n] = (n < ncols) ? W[(size_t)(k0 + kk) * ldw + c0 + n] : 0.f; }
    LDS_WAIT(); asm volatile("" ::: "memory");
    const int c = lane & 7;
#pragma unroll
    for (int j = 0; j < 4; ++j) { const int n = (lane >> 3) + 8 * j; const LAS float* s = scr + (8 * c) * 33 + n;
        v4u o; o.x = pk2(s[0 * 33], s[1 * 33]); o.y = pk2(s[2 * 33], s[3 * 33]); o.z = pk2(s[4 * 33], s[5 * 33]); o.w = pk2(s[6 * 33], s[7 * 33]);
        const int drow = perm ? (r0 & ~127) + rope_phi((r0 & 127) + n) : r0 + n;
        if (n < ncols) *(GAS v4u*)(WT + (size_t)drow * K + k0 + 8 * c) = o; }
    LDS_WAIT(); asm volatile("" ::: "memory");
}

__device__ __forceinline__ void p0_transposes(const Args& a, const Ctx& c, int it0, int it1, int widx, int nw) {
    unsigned char* ws = a.ws;
    bf16* WinT = (bf16*)(ws + WS_WIN); bf16* WoutT = (bf16*)(ws + WS_WOUT);
    LAS float* scr = (LAS float*)(c.lds + RING_OFF + c.wave * 16384);
    constexpr int NB_IN = 482, I_IN = 64 * NB_IN, I_OUT = 64 * 128, I_LR = 4 * 32 * 8, I_ALL = I_IN + I_OUT + I_LR;
    bf16* WLR = (bf16*)(ws + WS_WLR);
    struct TItem { const float* src; bf16* dst; int ldw, K, ncols; bool perm; int r0; };
    auto decode = [&](int it) -> TItem {
        TItem t;
        if (it < I_IN) {
            const int kb = it / NB_IN, nb = it % NB_IN; int c0, r0, nc = 32;
            if (nb < 128) { c0 = nb * 32; r0 = nb * 32; }
            else if (nb < 224) { c0 = 4144 + (nb - 128) * 32; r0 = 4096 + (nb - 128) * 32; }
            else if (nb < 480) { c0 = 7216 + (nb - 224) * 32; r0 = 7168 + (nb - 224) * 32; }
            else { c0 = 4096 + (nb - 480) * 32; r0 = C_GA + (nb - 480) * 32; nc = (nb == 480) ? 32 : 16; }
            t.perm = (r0 < 2048) || (r0 >= C_KSL && r0 < C_VSL) || (r0 >= C_KW && r0 < C_VW) || (r0 >= C_QB && r0 < C_VB);
            t.src = a.w_in + (size_t)(kb * 64) * CIN + c0; t.ldw = CIN; t.K = DM; t.ncols = nc; t.dst = WinT + kb * 64; t.r0 = r0;
        } else if (it < I_IN + I_OUT) {
            const int r = it - I_IN, kb = r / 128, nb = r % 128;
            t.perm = false; t.src = a.w_out + (size_t)(kb * 64) * DM + nb * 32; t.ldw = DM; t.K = DM; t.ncols = 32; t.dst = WoutT + kb * 64; t.r0 = nb * 32;
        } else {
            const int r = it - I_IN - I_OUT, part = r >> 8, kb = (r >> 3) & 31, nb = r & 7;
            t.perm = false; t.src = ((part >> 1) ? a.wv1 : a.wk1) + (size_t)((part & 1) * 2048 + kb * 64) * 256 + nb * 32; t.ldw = 256; t.K = 2048; t.ncols = 32;
            t.dst = WLR + kb * 64; t.r0 = part * 256 + nb * 32;
        }
        return t;
    };
    {
        const int kr = c.lane >> 3, nq = (c.lane & 7) * 4;
        f32x4 v[8];
        int it = it0 + widx; bool have = it < it1; TItem cur{};
        if (have) { cur = decode(it);
#pragma unroll
            for (int i = 0; i < 8; ++i) v[i] = (nq < cur.ncols) ? __builtin_nontemporal_load((const GAS f32x4*)(cur.src + (size_t)(8 * i + kr) * cur.ldw + nq)) : (f32x4){0.f, 0.f, 0.f, 0.f}; }
        while (have) {
#pragma unroll
            for (int i = 0; i < 8; ++i) { LAS float* d = scr + (8 * i + kr) * 33 + nq; d[0] = v[i].x; d[1] = v[i].y; d[2] = v[i].z; d[3] = v[i].w; }
            const int nit = it + nw; const bool hn = nit < it1; TItem nx{};
            if (hn) { nx = decode(nit);
#pragma unroll
                for (int i = 0; i < 8; ++i) v[i] = (nq < nx.ncols) ? __builtin_nontemporal_load((const GAS f32x4*)(nx.src + (size_t)(8 * i + kr) * nx.ldw + nq)) : (f32x4){0.f, 0.f, 0.f, 0.f}; }
            LDS_WAIT(); asm volatile("" ::: "memory");
            const int cc = c.lane & 7;
#pragma unroll
            for (int j = 0; j < 4; ++j) { const int n = (c.lane >> 3) + 8 * j; const LAS float* sp = scr + (8 * cc) * 33 + n;
                v4u o; o.x = pk2(sp[0 * 33], sp[1 * 33]); o.y = pk2(sp[2 * 33], sp[3 * 33]); o.z = pk2(sp[4 * 33], sp[5 * 33]); o.w = pk2(sp[6 * 33], sp[7 * 33]);
                const int drow = cur.perm ? (cur.r0 & ~127) + rope_phi((cur.r0 & 127) + n) : cur.r0 + n;
                if (n < cur.ncols) *(GAS v4u*)(cur.dst + (size_t)drow * cur.K + 8 * cc) = o; }
            LDS_WAIT(); asm volatile("" ::: "memory");
            it = nit; have = hn; cur = nx;
        }
    }
}
constexpr int TI_IN = 64 * 482, TI_ALL = TI_IN + 64 * 128 + 4 * 32 * 8;

__device__ __forceinline__ void p0_prologue(const Args& a, const Ctx& c) {
    unsigned char* ws = a.ws;
    bf16* WinT = (bf16*)(ws + WS_WIN); bf16* HB = (bf16*)(ws + WS_HB);
    p0_transposes(a, c, 0, TI_IN, c.gw, c.NGW);
    for (int e = c.gw * 64 + c.lane; e < (NP - CIN) * (DM / 8); e += c.NGW * 64)
        *(GAS v4u*)(WinT + (size_t)CIN * DM + (size_t)e * 8) = (v4u){0u, 0u, 0u, 0u};
    for (int m = c.gw; m < M; m += c.NGW) {
        const GAS f32x4* xr = (const GAS f32x4*)(a.x + (size_t)m * DM) + c.lane;
        f32x4 v[16]; float s = 0.f;
#pragma unroll
        for (int j = 0; j < 16; ++j) { v[j] = __builtin_nontemporal_load(xr + 64 * j); s += (v[j].x * v[j].x + v[j].y * v[j].y) + (v[j].z * v[j].z + v[j].w * v[j].w); }
        const float rstd = 1.0f / sqrtf(wave_sum(s) * (1.0f / DM) + EPS);
        GAS unsigned long long* o8 = (GAS unsigned long long*)(HB + (size_t)m * DM) + c.lane;
#pragma unroll
        for (int j = 0; j < 16; ++j) { const f32x4 w = ((const GAS f32x4*)a.pre_w)[c.lane + 64 * j];
            o8[64 * j] = (unsigned long long)pk2(v[j].x * rstd * w.x, v[j].y * rstd * w.y) | ((unsigned long long)pk2(v[j].z * rstd * w.z, v[j].w * rstd * w.w) << 32); }
    }
    {
        float* COS = (float*)(ws + WS_COS); float* SIN = (float*)(ws + WS_SIN);
        for (int e = c.gw * 64 + c.lane; e < M * 64; e += c.NGW * 64) {
            const int m = e >> 6, i = e & 63;
            double inv = 1.0; for (int k = 0; k < i; ++k) inv *= 0.8659643233600653;
            const double ang = (double)a.pos[m] * inv;
            const double TWO_PI = 6.283185307179586476925286766559;
            const double n = __builtin_rint(ang / TWO_PI);
            const double r = ang - n * TWO_PI;
            const double r2 = r * r;
            double sn = 0.0, cs = 0.0;
            double ts = r, tc = 1.0;
#pragma unroll
            for (int k = 0; k < 14; ++k) { sn += ts; cs += tc; ts *= -r2 / (double)((2 * k + 2) * (2 * k + 3)); tc *= -r2 / (double)((2 * k + 1) * (2 * k + 2)); }
            COS[e] = (float)cs; SIN[e] = (float)sn;
        }
    }
    {
        float* BP = (float*)(ws + WS_BIAS1);
        for (int o = c.NGW - 1 - c.gw; o < 128; o += c.NGW) {
            const int kv = o >> 6, ch = o & 63; const float* pe = (kv ? a.pe_v : a.pe_k) + ch * 64; const float* w1 = (kv ? a.wv1 : a.wk1) + (size_t)ch * 64 * 256;
            float s0 = 0.f, s1 = 0.f, s2 = 0.f, s3 = 0.f;
#pragma unroll 16
            for (int i = 0; i < 64; ++i) { const float p = pe[i]; const float* wr = w1 + i * 256 + c.lane; s0 += p * wr[0]; s1 += p * wr[64]; s2 += p * wr[128]; s3 += p * wr[192]; }
            float* d = BP + (size_t)o * 256 + c.lane; d[0] = s0; d[64] = s1; d[128] = s2; d[192] = s3;
        }
    }
}

__device__ __forceinline__ float gelu_tanh(float x) {
    const float u = 0.7978845608028654f * (x + 0.044715f * x * x * x);
    const float e = __expf(2.0f * u);
    const float th = 1.0f - 2.0f / (e + 1.0f);
    return 0.5f * x * (1.0f + th);
}

__device__ __forceinline__ void p2c_stage2(const Args& a, const Ctx& c) {
    unsigned char* ws = a.ws;
    const float* LR = (const float*)(ws + WS_LR); const float* B1 = (const float*)(ws + WS_BIAS1);
    LAS float* Gs = (LAS float*)(c.lds + RING_OFF);
    bf16* KCB = (bf16*)(ws + WS_KCB); bf16* VCB = (bf16*)(ws + WS_VCB);
    for (int e = c.gw * 64 + c.lane; e < 2 * 16 * 128; e += c.NGW * 64) { bf16* dst = (e >> 11) ? VCB : KCB; dst[(size_t)((e >> 7) & 15) * 128 * 128 + 127 * 128 + (e & 127)] = 0; }
    for (int it = c.bid; it < 2 * 127; it += c.G) {
        const int kv = it / 127, rb = it % 127;
        const float* w2 = kv ? a.wv2 : a.wk2;
        float* OUT = (float*)(ws + (kv ? WS_VCMP : WS_KCMP)); bf16* OUTB = kv ? VCB : KCB;
        const int n = c.tid & 255, half = c.tid >> 8;
        float b1 = 0.f;
        for (int ch = 0; ch < 64; ++ch) b1 += B1[(size_t)(kv * 64 + ch) * 256 + n];
        __syncthreads();
#pragma unroll
        for (int r = 0; r < 8; ++r) { const int R = rb * 16 + half * 8 + r, bh = R / 127, cc = R % 127; const size_t rowL = (size_t)kv * 2048 + bh * 128 + cc;
            float h = b1;
#pragma unroll
            for (int ks = 0; ks < 8; ++ks) { const float* p = LR + (size_t)ks * 4096 * 1024 + rowL * 1024 + kv * 512 + n; h += p[0] + p[1024 + 256]; }
            Gs[(half * 8 + r) * 256 + n] = gelu_tanh(h); }
        __syncthreads();
        const int d = c.tid & 127, rq = c.tid >> 7;
        float o[4] = {0.f, 0.f, 0.f, 0.f};
        for (int nn = 0; nn < 256; ++nn) { const float w = w2[nn * 128 + d];
#pragma unroll
            for (int r = 0; r < 4; ++r) o[r] += Gs[(rq * 4 + r) * 256 + nn] * w; }
#pragma unroll
        for (int r = 0; r < 4; ++r) { const int R = rb * 16 + rq * 4 + r, bh = R / 127, cc = R % 127; const int dd = kv ? d : rope_phi(d);
            OUT[(size_t)(bh * 128 + cc) * 128 + dd] = o[r]; OUTB[(size_t)(bh * 128 + cc) * 128 + dd] = (bf16)f2bf(o[r]); }
    }
}

namespace fa {
typedef short s16x4 __attribute__((ext_vector_type(4)));
typedef float f32x16 __attribute__((ext_vector_type(16)));
typedef unsigned u32x4 __attribute__((ext_vector_type(4)));
constexpr int KVBLK = 64, SHM_K = KVBLK * 128 * 2, SHM_V = SHM_K;
constexpr int BUFS = SHM_V + SHM_K, A_V = 0, A_K = SHM_V, A_WS = 3 * BUFS;
constexpr float SCALE = 0.08838834764831845f, THR = 8.f;
constexpr float C2 = 1.4426950408889634f * SCALE;
constexpr float DBL = 1.0f / C2;
#define FA_KSWZ(row, colB) ((row) * 256 + ((colB) ^ (((row) & 7) << 4)))
#define FA_SBAR() __builtin_amdgcn_sched_barrier(0)
__device__ __forceinline__ int v_st(int k, int c) { const int kk = (k & ~0xC) | ((k & 4) << 1) | ((k & 8) >> 1); return ((kk >> 3) * 4 + (c >> 5)) * 512 + ((kk & 7) * 32 + (c & 31)) * 2; }
__device__ __forceinline__ int v_rd_base(int lane) { return ((lane & 3) << 3) | (((lane >> 2) & 3) << 6) | (((lane >> 4) & 1) << 5) | (((lane >> 5) & 1) << 8); }
constexpr int v_rd_off(int d0, int ks, int half) { return d0 * 512 + ks * 4096 + half * 2048; }
__device__ __forceinline__ int crow(int r, int hi) { return (r & 3) + 8 * (r >> 2) + 4 * hi; }
__device__ __forceinline__ unsigned cvtpk(float lo, float hi) { unsigned r; asm volatile("v_cvt_pk_bf16_f32 %0, %1, %2" : "=v"(r) : "v"(lo), "v"(hi)); return r; }

__device__ __forceinline__ void mask_tile(f32x16& p0, f32x16& p1, int dq, unsigned W) {
    const float NEG = -__builtin_inff();
#pragma unroll
    for (int r = 0; r < 16; ++r) {
        const int c = (r & 3) + 8 * (r >> 2);
        if ((unsigned)(dq - c) >= W) p0[r] = NEG;
        if ((unsigned)(dq - c - 32) >= W) p1[r] = NEG;
    }
}
__device__ __forceinline__ void mask_dil(f32x16& p0, f32x16& p1, int dq) {
    const float NEG = -__builtin_inff();
#pragma unroll
    for (int r = 0; r < 16; ++r) {
        const int c = (r & 3) + 8 * (r >> 2);
        { const int dl = dq - c; const bool nr = (unsigned)dl <= 128u, m4 = dl >= 0 && (dl & 3) == 0; const float v = p0[r];
          p0[r] = nr ? (m4 ? v + DBL : v) : (m4 ? v : NEG); }
        { const int dl = dq - c - 32; const bool nr = (unsigned)dl <= 128u, m4 = dl >= 0 && (dl & 3) == 0; const float v = p1[r];
          p1[r] = nr ? (m4 ? v + DBL : v) : (m4 ? v : NEG); }
    }
}
__device__ __forceinline__ void partialSM(f32x16& p0, f32x16& p1, float& m_reg, float& mn, float& alpha, bool drop) {
    float pmax = p0[0];
#pragma unroll
    for (int r = 1; r < 16; ++r) pmax = fmaxf(pmax, p0[r]);
#pragma unroll
    for (int r = 0; r < 16; ++r) pmax = fmaxf(pmax, p1[r]);
    { auto rr = __builtin_amdgcn_permlane32_swap(__float_as_uint(pmax), __float_as_uint(pmax), false, false);
      pmax = fmaxf(__uint_as_float(rr[0]), __uint_as_float(rr[1])); }
    if (drop) pmax = -__builtin_inff();
    if (__builtin_expect(__all((pmax - m_reg) * SCALE <= THR), 1)) { mn = m_reg; alpha = 1.f; }
    else { mn = fmaxf(m_reg, pmax); alpha = __builtin_amdgcn_exp2f((m_reg - mn) * C2); m_reg = mn; }
    const float mnL = drop ? -__builtin_inff() : -mn * C2;
#pragma unroll
    for (int r = 0; r < 16; ++r) p0[r] = fmaf(p0[r], C2, mnL);
#pragma unroll
    for (int r = 0; r < 16; ++r) p1[r] = fmaf(p1[r], C2, mnL);
#pragma unroll
    for (int r = 0; r < 16; ++r) p0[r] = __builtin_amdgcn_exp2f(p0[r]);
}
__device__ __forceinline__ void finishSM(f32x16& p0, f32x16& p1, float alpha, float& l_reg, bf16x8& pa0, bf16x8& pa1, bf16x8& pa2, bf16x8& pa3) {
#pragma unroll
    for (int r = 0; r < 16; ++r) p1[r] = __builtin_amdgcn_exp2f(p1[r]);
    float ps = 0;
#pragma unroll
    for (int r = 0; r < 16; ++r) ps += p0[r];
#pragma unroll
    for (int r = 0; r < 16; ++r) ps += p1[r];
    { auto rr = __builtin_amdgcn_permlane32_swap(__float_as_uint(ps), __float_as_uint(ps), false, false);
      ps = __uint_as_float(rr[0]) + __uint_as_float(rr[1]); }
    l_reg = l_reg * alpha + ps;
#define FA_PK4(P, B_, OUT) do { unsigned a0 = cvtpk(P[B_+0], P[B_+1]), a1 = cvtpk(P[B_+2], P[B_+3]);                          \
        unsigned b0 = cvtpk(P[B_+4], P[B_+5]), b1 = cvtpk(P[B_+6], P[B_+7]);                                             \
        auto r0 = __builtin_amdgcn_permlane32_swap(a0, b0, false, false); auto r1 = __builtin_amdgcn_permlane32_swap(a1, b1, false, false); \
        u32x4 w = {r0[0], r1[0], r0[1], r1[1]}; OUT = __builtin_bit_cast(bf16x8, w); } while (0)
    FA_PK4(p0, 0, pa0); FA_PK4(p0, 8, pa1); FA_PK4(p1, 0, pa2); FA_PK4(p1, 8, pa3);
#undef FA_PK4
}
__device__ __forceinline__ void pack_p(const f32x16& p0, const f32x16& p1, bf16x8& pa0, bf16x8& pa1, bf16x8& pa2, bf16x8& pa3) {
#define FA_PK4(P, B_, OUT) do { unsigned a0 = cvtpk(P[B_+0], P[B_+1]), a1 = cvtpk(P[B_+2], P[B_+3]);                          \
        unsigned b0 = cvtpk(P[B_+4], P[B_+5]), b1 = cvtpk(P[B_+6], P[B_+7]);                                             \
        auto r0 = __builtin_amdgcn_permlane32_swap(a0, b0, false, false); auto r1 = __builtin_amdgcn_permlane32_swap(a1, b1, false, false); \
        u32x4 w = {r0[0], r1[0], r0[1], r1[1]}; OUT = __builtin_bit_cast(bf16x8, w); } while (0)
    FA_PK4(p0, 0, pa0); FA_PK4(p0, 8, pa1); FA_PK4(p1, 0, pa2); FA_PK4(p1, 8, pa3);
#undef FA_PK4
}
template <int KB>
__device__ __forceinline__ void qkt(f32x16& p0, f32x16& p1, const LAS char* K_lds, int r32, int hi, const bf16x8 (&qr)[8]) {
#pragma unroll
    for (int r = 0; r < 16; ++r) { p0[r] = 0.f; p1[r] = 0.f; }
    const LAS char* kb[4];
#pragma unroll
    for (int dd = 0; dd < 4; ++dd) kb[dd] = K_lds + KB * BUFS + FA_KSWZ(r32, (dd * 16 + hi * 8) * 2);
#pragma unroll
    for (int d0 = 0; d0 < 8; ++d0) { const LAS char* a = kb[d0 & 3] + (d0 >> 2) * 128;
        const bf16x8 b0 = *(const LAS bf16x8*)a;
        const bf16x8 b1 = *(const LAS bf16x8*)(a + 32 * 256);
        p0 = __builtin_amdgcn_mfma_f32_32x32x16_bf16(b0, qr[d0], p0, 0, 0, 0);
        p1 = __builtin_amdgcn_mfma_f32_32x32x16_bf16(b1, qr[d0], p1, 0, 0, 0); }
}
template <int VB>
__device__ __forceinline__ void pv_tile(f32x16 (&o)[4], int vb0, bf16x8 pa0, bf16x8 pa1, bf16x8 pa2, bf16x8 pa3) {
#define FA_TRRD(dst, off) asm volatile("ds_read_b64_tr_b16 %0, %1 offset:%2" : "=&v"(dst) : "v"(vb0), "i"(off) : "memory")
#define FA_PV_D0(d0) do { s16x4 l0, l1, l2, l3, h0, h1, h2, h3; constexpr int b_ = A_V + VB * BUFS + v_rd_off(d0, 0, 0); \
        FA_TRRD(l0, b_); FA_TRRD(h0, b_ + 2048); FA_TRRD(l1, b_ + 4096); FA_TRRD(h1, b_ + 6144); FA_TRRD(l2, b_ + 8192); FA_TRRD(h2, b_ + 10240); FA_TRRD(l3, b_ + 12288); FA_TRRD(h3, b_ + 14336); \
        asm volatile("s_waitcnt lgkmcnt(0)" ::: "memory"); FA_SBAR(); \
        o[d0] = __builtin_amdgcn_mfma_f32_32x32x16_bf16(pa0, (bf16x8){l0[0], l0[1], l0[2], l0[3], h0[0], h0[1], h0[2], h0[3]}, o[d0], 0, 0, 0);   \
        o[d0] = __builtin_amdgcn_mfma_f32_32x32x16_bf16(pa1, (bf16x8){l1[0], l1[1], l1[2], l1[3], h1[0], h1[1], h1[2], h1[3]}, o[d0], 0, 0, 0);   \
        o[d0] = __builtin_amdgcn_mfma_f32_32x32x16_bf16(pa2, (bf16x8){l2[0], l2[1], l2[2], l2[3], h2[0], h2[1], h2[2], h2[3]}, o[d0], 0, 0, 0);   \
        o[d0] = __builtin_amdgcn_mfma_f32_32x32x16_bf16(pa3, (bf16x8){l3[0], l3[1], l3[2], l3[3], h3[0], h3[1], h3[2], h3[3]}, o[d0], 0, 0, 0); } while (0)
    FA_PV_D0(0); FA_PV_D0(1); FA_PV_D0(2); FA_PV_D0(3);
#undef FA_PV_D0
#undef FA_TRRD
}

__device__ __forceinline__ void mask_half(f32x16& p, int dq, unsigned W) {
    const float NEG = -__builtin_inff();
#pragma unroll
    for (int r = 0; r < 16; ++r) { const int c = (r & 3) + 8 * (r >> 2); if ((unsigned)(dq - c) >= W) p[r] = NEG; }
}
__device__ __forceinline__ void mask_dil_half(f32x16& p, int dq) {
    const float NEG = -__builtin_inff();
#pragma unroll
    for (int r = 0; r < 16; ++r) { const int c = (r & 3) + 8 * (r >> 2); const int dl = dq - c; const bool nr = (unsigned)dl <= 128u, m4 = dl >= 0 && (dl & 3) == 0; const float v = p[r];
        p[r] = nr ? (m4 ? v + DBL : v) : (m4 ? v : NEG); }
}
template <int KB, int H>
__device__ __forceinline__ void qk_half(f32x16& p, const LAS char* K_lds, int r32, int hi, const bf16x8 (&qr)[8]) {
#pragma unroll
    for (int r = 0; r < 16; ++r) p[r] = 0.f;
    const LAS char* kb[4];
#pragma unroll
    for (int dd = 0; dd < 4; ++dd) kb[dd] = K_lds + KB * BUFS + H * 32 * 256 + FA_KSWZ(r32, (dd * 16 + hi * 8) * 2);
#pragma unroll
    for (int d0 = 0; d0 < 8; ++d0) { const bf16x8 b0 = *(const LAS bf16x8*)(kb[d0 & 3] + (d0 >> 2) * 128); p = __builtin_amdgcn_mfma_f32_32x32x16_bf16(b0, qr[d0], p, 0, 0, 0); }
}
template <int KB, int H>
__device__ __forceinline__ void k_reads(const LAS char* K_lds, int r32, int hi, bf16x8 (&kf)[8]) {
    const unsigned a0 = (unsigned)(uintptr_t)(K_lds + KB * BUFS + FA_KSWZ(r32, (0 * 16 + hi * 8) * 2)), a1 = (unsigned)(uintptr_t)(K_lds + KB * BUFS + FA_KSWZ(r32, (1 * 16 + hi * 8) * 2)),
                   a2 = (unsigned)(uintptr_t)(K_lds + KB * BUFS + FA_KSWZ(r32, (2 * 16 + hi * 8) * 2)), a3 = (unsigned)(uintptr_t)(K_lds + KB * BUFS + FA_KSWZ(r32, (3 * 16 + hi * 8) * 2));
#define FA_KRD(dst, ad, off) asm volatile("ds_read_b128 %0, %1 offset:%2" : "=&v"(dst) : "v"(ad), "i"(off) : "memory")
    FA_KRD(kf[0], a0, H * 8192); FA_KRD(kf[1], a1, H * 8192); FA_KRD(kf[2], a2, H * 8192); FA_KRD(kf[3], a3, H * 8192);
    FA_KRD(kf[4], a0, H * 8192 + 128); FA_KRD(kf[5], a1, H * 8192 + 128); FA_KRD(kf[6], a2, H * 8192 + 128); FA_KRD(kf[7], a3, H * 8192 + 128);
#undef FA_KRD
}
__device__ __forceinline__ void qk_mma(f32x16& p, const bf16x8 (&kf)[8], const bf16x8 (&qr)[8]) {
#pragma unroll
    for (int r = 0; r < 16; ++r) p[r] = 0.f;
#pragma unroll
    for (int d0 = 0; d0 < 8; ++d0) p = __builtin_amdgcn_mfma_f32_32x32x16_bf16(kf[d0], qr[d0], p, 0, 0, 0);
}
__device__ __forceinline__ float sm_max(const f32x16& p, float& m_reg, bool drop, float& mnL) {
    float pmax = p[0];
#pragma unroll
    for (int r = 1; r < 16; ++r) pmax = fmaxf(pmax, p[r]);
    { auto rr = __builtin_amdgcn_permlane32_swap(__float_as_uint(pmax), __float_as_uint(pmax), false, false); pmax = fmaxf(__uint_as_float(rr[0]), __uint_as_float(rr[1])); }
    if (drop) pmax = -__builtin_inff();
    const bool keep = __all((pmax - m_reg) * SCALE <= THR);
    const float mn = keep ? m_reg : fmaxf(m_reg, pmax);
    const float alpha = __builtin_amdgcn_exp2f((m_reg - mn) * C2);
    m_reg = mn; mnL = drop ? -__builtin_inff() : -mn * C2;
    return alpha;
}
__device__ __forceinline__ void sm_exp(f32x16& p, float mnL, float alpha, float& l_reg, bf16x8& paA, bf16x8& paB) {
    float ps = 0.f;
#pragma unroll
    for (int r = 0; r < 16; ++r) { p[r] = __builtin_amdgcn_exp2f(fmaf(p[r], C2, mnL)); ps += p[r]; }
    { auto rr = __builtin_amdgcn_permlane32_swap(__float_as_uint(ps), __float_as_uint(ps), false, false); ps = __uint_as_float(rr[0]) + __uint_as_float(rr[1]); }
    l_reg = l_reg * alpha + ps;
#define FA_PK4(P, B_, OUT) do { unsigned a0 = cvtpk(P[B_+0], P[B_+1]), a1 = cvtpk(P[B_+2], P[B_+3]);                          \
        unsigned b0 = cvtpk(P[B_+4], P[B_+5]), b1 = cvtpk(P[B_+6], P[B_+7]);                                             \
        auto r0 = __builtin_amdgcn_permlane32_swap(a0, b0, false, false); auto r1 = __builtin_amdgcn_permlane32_swap(a1, b1, false, false); \
        u32x4 w = {r0[0], r1[0], r0[1], r1[1]}; OUT = __builtin_bit_cast(bf16x8, w); } while (0)
    FA_PK4(p, 0, paA); FA_PK4(p, 8, paB);
#undef FA_PK4
}
template <int VB, int H, int D0A = 0, int D0B = 4>
__device__ __forceinline__ void pv_reads(int vb0, s16x4 (&vl)[8], s16x4 (&vh)[8]) {
    const int vbb = vb0 + VB * BUFS;
#define FA_TRRD(dst, off) asm volatile("ds_read_b64_tr_b16 %0, %1 offset:%2" : "=&v"(dst) : "v"(vbb), "i"(off) : "memory")
#define FA_RD_D0(d0) do { constexpr int b_ = A_V + v_rd_off(d0, 2 * H, 0); \
        FA_TRRD(vl[2 * d0], b_); FA_TRRD(vh[2 * d0], b_ + 2048); FA_TRRD(vl[2 * d0 + 1], b_ + 4096); FA_TRRD(vh[2 * d0 + 1], b_ + 6144); } while (0)
    if constexpr (D0A <= 0 && 0 < D0B) FA_RD_D0(0); if constexpr (D0A <= 1 && 1 < D0B) FA_RD_D0(1); if constexpr (D0A <= 2 && 2 < D0B) FA_RD_D0(2); if constexpr (D0A <= 3 && 3 < D0B) FA_RD_D0(3);
#undef FA_RD_D0
#undef FA_TRRD
}
__device__ __forceinline__ void pv_mma(f32x16 (&o)[4], const s16x4 (&vl)[8], const s16x4 (&vh)[8], bf16x8 paA, bf16x8 paB) {
#pragma unroll
    for (int d0 = 0; d0 < 4; ++d0) {
        o[d0] = __builtin_amdgcn_mfma_f32_32x32x16_bf16(paA, (bf16x8){vl[2 * d0][0], vl[2 * d0][1], vl[2 * d0][2], vl[2 * d0][3], vh[2 * d0][0], vh[2 * d0][1], vh[2 * d0][2], vh[2 * d0][3]}, o[d0], 0, 0, 0);
        o[d0] = __builtin_amdgcn_mfma_f32_32x32x16_bf16(paB, (bf16x8){vl[2 * d0 + 1][0], vl[2 * d0 + 1][1], vl[2 * d0 + 1][2], vl[2 * d0 + 1][3], vh[2 * d0 + 1][0], vh[2 * d0 + 1][1], vh[2 * d0 + 1][2], vh[2 * d0 + 1][3]}, o[d0], 0, 0, 0); }
}

struct St { float m, l; f32x16 o[4]; };
__device__ __forceinline__ void st_init(St& S) { S.m = -1e30f; S.l = 0.f;
#pragma unroll
    for (int d = 0; d < 4; ++d)
#pragma unroll
        for (int r = 0; r < 16; ++r) S.o[d][r] = 0.f; }

struct MaskWin { int qlo, qm;
    __device__ __forceinline__ bool act(int t) const { const int kb = t * 64; return kb <= qlo + 31 && kb + 63 >= qlo - 511; }
    __device__ __forceinline__ void apply(f32x16& p0, f32x16& p1, int t) const { const int kb = t * 64; if (kb + 63 > qlo || kb <= qlo + 31 - 512) mask_tile(p0, p1, qm - kb, 512u); }
    __device__ __forceinline__ bool needs_mask(int t) const { const int kb = t * 64; return kb + 63 > qlo || kb <= qlo + 31 - 512; }
    __device__ __forceinline__ void apply_half(f32x16& p, int t, int H) const { mask_half(p, qm - t * 64 - 32 * H, 512u); }
    __device__ __forceinline__ bool drop(int) const { return false; } };
struct MaskSel { int qlo, qm; unsigned selw;
    __device__ __forceinline__ bool act(int t) const { return t * 64 <= qlo + 31; }
    __device__ __forceinline__ void apply(f32x16& p0, f32x16& p1, int t) const { const int kb = t * 64; if (kb + 63 > qlo) mask_tile(p0, p1, qm - kb, 0x40000000u); }
    __device__ __forceinline__ bool needs_mask(int t) const { return t * 64 + 63 > qlo; }
    __device__ __forceinline__ void apply_half(f32x16& p, int t, int H) const { mask_half(p, qm - t * 64 - 32 * H, 0x40000000u); }
    __device__ __forceinline__ bool drop(int t) const { return ((selw >> t) & 1u) == 0u; } };
struct MaskDilA { int plo, pm;
    __device__ __forceinline__ bool act(int t) const { return t * 64 <= plo + 31; }
    __device__ __forceinline__ void apply(f32x16& p0, f32x16& p1, int t) const { mask_dil(p0, p1, pm - t * 64); }
    __device__ __forceinline__ bool needs_mask(int) const { return true; }
    __device__ __forceinline__ void apply_half(f32x16& p, int t, int H) const { mask_dil_half(p, pm - t * 64 - 32 * H); }
    __device__ __forceinline__ bool drop(int) const { return false; } };
struct MaskDilB { int tlo, tm;
    __device__ __forceinline__ bool act(int t) const { const int kb = t * 64; return kb <= tlo + 124 && kb + 63 >= tlo - 128; }
    __device__ __forceinline__ void apply(f32x16& p0, f32x16& p1, int t) const { mask_tile(p0, p1, tm - t * 64, 129u); }
    __device__ __forceinline__ bool needs_mask(int) const { return true; }
    __device__ __forceinline__ void apply_half(f32x16& p, int t, int H) const { mask_half(p, tm - t * 64 - 32 * H, 129u); }
    __device__ __forceinline__ bool drop(int) const { return false; } };

template <class MK>
__device__ __forceinline__ void attn_pass(St& S, const bf16x8 (&qr)[8], const bf16* Kg, const bf16* Vg, int pitch, int t0, int t1, LAS char* lds, const MK& mk, int tid, int wid, int lane) {
    if (t0 >= t1) return;
    const int r32 = lane & 31, hi = lane >> 5;
    LAS char* K_lds = lds + A_K;
    LAS float* al_l = (LAS float*)(lds + A_WS) + wid * 64 + 32;
    const int vb0 = (int)(unsigned)(uintptr_t)lds + v_rd_base(lane);
    unsigned kso[2], vso[2];
#pragma unroll
    for (int j = 0; j < 2; ++j) { const int ch = 2 * wid + j;
        const int row = ch * 4 + (lane >> 4), chunk = (lane & 15) ^ (row & 7); kso[j] = (unsigned)(row * pitch + chunk * 8);
        const int sub = ch * 2 + (lane >> 5), kk = (sub >> 2) * 8 + ((lane & 31) >> 2), key = (kk & ~0xC) | ((kk & 4) << 1) | ((kk & 8) >> 1), col = (sub & 3) * 32 + (lane & 3) * 8;
        vso[j] = (unsigned)(key * pitch + col); }
    const unsigned ldsw = (unsigned)wid * 2048u;
#define FA_DMA(t, bf) do { const bf16* kt_ = Kg + (size_t)((t) * 64) * pitch; const bf16* vt_ = Vg + (size_t)((t) * 64) * pitch; \
        _Pragma("unroll") for (int j_ = 0; j_ < 2; ++j_) { \
            __builtin_amdgcn_global_load_lds((const GAS unsigned*)(kt_ + kso[j_]), (LAS unsigned*)(lds + (bf) * BUFS + A_K + ldsw + j_ * 1024), 16, 0, 0); \
            __builtin_amdgcn_global_load_lds((const GAS unsigned*)(vt_ + vso[j_]), (LAS unsigned*)(lds + (bf) * BUFS + A_V + ldsw + j_ * 1024), 16, 0, 0); } } while (0)
#define FA_BAR() do { asm volatile("s_waitcnt lgkmcnt(0)" ::: "memory"); __builtin_amdgcn_s_barrier(); asm volatile("" ::: "memory"); } while (0)
#define FA_RESC(al_) do { if (__any((al_) < 1.f)) { if (hi == 0) al_l[r32] = (al_); asm volatile("s_waitcnt lgkmcnt(0)" ::: "memory"); \
            _Pragma("unroll") for (int d_ = 0; d_ < 4; ++d_) _Pragma("unroll") for (int r = 0; r < 16; ++r) S.o[d_][r] *= al_l[crow(r, hi)]; \
            asm volatile("s_waitcnt lgkmcnt(0)" ::: "memory"); } } while (0)
#define FA_LWAIT() do { asm volatile("s_waitcnt lgkmcnt(0)" ::: "memory"); FA_SBAR(); } while (0)
#define FA_BODY(t, B) do { f32x16 p0, p1; bf16x8 pa0, pa1, pa2, pa3; float mnL0, mnL1; const bool dr_ = mk.drop(t), nm_ = mk.needs_mask(t); \
            { bf16x8 kfa[8], kfb[8]; k_reads<B, 0>(K_lds, r32, hi, kfa); FA_LWAIT(); \
              k_reads<B, 1>(K_lds, r32, hi, kfb); qk_mma(p0, kfa, qr); FA_LWAIT(); \
              if (nm_) mk.apply_half(p0, (t), 0); \
              s16x4 vl[8], vh[8]; pv_reads<B, 0>(vb0, vl, vh); \
              qk_mma(p1, kfb, qr); const float al0 = sm_max(p0, S.m, dr_, mnL0); sm_exp(p0, mnL0, al0, S.l, pa0, pa1); \
              FA_LWAIT(); FA_RESC(al0); FA_SBAR(); \
              if (nm_) mk.apply_half(p1, (t), 1); \
              pv_mma(S.o, vl, vh, pa0, pa1); const float al1 = sm_max(p1, S.m, dr_, mnL1); sm_exp(p1, mnL1, al1, S.l, pa2, pa3); \
              FA_SBAR(); FA_RESC(al1); \
              pv_reads<B, 1>(vb0, vl, vh); FA_LWAIT(); \
              pv_mma(S.o, vl, vh, pa2, pa3); } } while (0)
#define FA_STEP(t, B) do { const bool more2_ = (t) + 2 < t1; \
        if (more2_) FA_DMA((t) + 2, ((B) + 2) % 3); \
        if (mk.act(t)) { FA_BODY(t, B); } \
        if (more2_) asm volatile("s_waitcnt vmcnt(4)" ::: "memory"); else asm volatile("s_waitcnt vmcnt(0)" ::: "memory"); \
        FA_BAR(); } while (0)
    FA_DMA(t0, 0);
    if (t0 + 1 < t1) { FA_DMA(t0 + 1, 1); asm volatile("s_waitcnt vmcnt(4)" ::: "memory"); } else asm volatile("s_waitcnt vmcnt(0)" ::: "memory");
    FA_BAR();
    for (int t = t0; t < t1; t += 3) {
        FA_STEP(t, 0);
        if (t + 1 < t1) FA_STEP(t + 1, 1);
        if (t + 2 < t1) FA_STEP(t + 2, 2);
    }
#undef FA_STEP
#undef FA_BODY
#undef FA_LWAIT
#undef FA_RESC
#undef FA_BAR
#undef FA_DMA
}
__device__ __forceinline__ void row_factors(float f, float (&rli)[16], LAS char* lds, int wid, int r32, int hi) {
    LAS float* li_l = (LAS float*)(lds + A_WS) + wid * 64;
    if (hi == 0) li_l[r32] = f;
    asm volatile("s_waitcnt lgkmcnt(0)" ::: "memory");
#pragma unroll
    for (int r = 0; r < 16; ++r) rli[r] = li_l[crow(r, hi)];
    asm volatile("s_waitcnt lgkmcnt(0)" ::: "memory");
}
template <int HALF>
__device__ __forceinline__ void stage_half(const f32x16 (&o)[4], const float (&rli)[16], LAS float* st, int r32, int hi, int lane, f32x4 (&lo)[4], f32x4 (&hh)[4]) {
    asm volatile("s_waitcnt lgkmcnt(0)" ::: "memory");
#pragma unroll
    for (int r = 0; r < 16; ++r) { const int row = crow(r, hi); st[row * 64 + r32] = o[2 * HALF][r] * rli[r]; st[row * 64 + 32 + r32] = o[2 * HALF + 1][r] * rli[r]; }
    asm volatile("s_waitcnt lgkmcnt(0)" ::: "memory");
#pragma unroll
    for (int q = 0; q < 4; ++q) { const int idx = q * 64 + lane; const LAS float* p = st + (idx >> 3) * 64 + 8 * (idx & 7); lo[q] = *(const LAS f32x4*)p; hh[q] = *(const LAS f32x4*)(p + 4); }
    asm volatile("s_waitcnt lgkmcnt(0)" ::: "memory");
}
__device__ __forceinline__ float bflo(unsigned w) { return __builtin_bit_cast(float, w << 16); }
__device__ __forceinline__ float bfhi(unsigned w) { return __builtin_bit_cast(float, w & 0xffff0000u); }
__device__ __forceinline__ float silu_mul(float v, float z) { return v * z / (1.0f + __expf(-z)); }
}

__device__ __forceinline__ float sigm(float x) { return 1.0f / (1.0f + __expf(-x)); }

__device__ __forceinline__ void nsa_block(const Args& a, const Ctx& c, int b, int h, int qb) {
    unsigned char* ws = a.ws;
    const bf16* P = (const bf16*)(ws + WS_P); const bf16* QR = (const bf16*)(ws + WS_QR);
    const bf16* OC = (const bf16*)(ws + WS_OC); bf16* OS = (bf16*)(ws + WS_OS); const unsigned* SEL = (const unsigned*)(ws + WS_SEL);
    bf16* MIX = (bf16*)(ws + WS_MIX);
    LAS char* lds = (LAS char*)(c.lds + RING_OFF);
    int lane = c.lane, tid = c.tid; asm volatile("" : "+v"(lane), "+v"(tid));
    const int hk = h >> 2, r32 = lane & 31, hi = lane >> 5;
    const int qlo = qb * 256 + c.wave * 32, t_row = qlo + r32, m0 = b * SEQ + qlo;
    bf16x8 qr[8];
    { const bf16* qb_ = QR + (size_t)m0 * 2048 + h * 128; const unsigned lq = (unsigned)(r32 * 2048 + hi * 8);
#pragma unroll
      for (int d0 = 0; d0 < 8; ++d0) qr[d0] = *(const GAS bf16x8*)(qb_ + lq + d0 * 16); }
    const bf16* Pb = P + (size_t)b * SEQ * LDP;
    const bf16* grow = P + (size_t)m0 * LDP + C_GA + h * 3;

    {
        fa::St S; fa::st_init(S);
        fa::MaskSel mk{qlo, t_row - 4 * hi, (SEL + (b * 4 + hk) * SEQ + qlo)[r32]};
        fa::attn_pass(S, qr, Pb + C_KSL + hk * 128, Pb + C_VSL + hk * 128, LDP, 0, 4 * qb + 4, lds, mk, tid, c.wave, lane);
        const float g1 = sigm(bf2f(grow[(unsigned)(r32 * LDP + 1)]) + a.b_gate[h * 3 + 1]);
        float rli[16]; fa::row_factors(g1 / S.l, rli, lds, c.wave, r32, hi);
        __syncthreads();
        LAS float* st = (LAS float*)lds + c.wave * 2048;
#define SEL_HALF(HF) do { f32x4 lo[4], hh[4]; fa::stage_half<HF>(S.o, rli, st, r32, hi, lane, lo, hh); \
        _Pragma("unroll") for (int q = 0; q < 4; ++q) { const int idx = q * 64 + lane; bf16* ob = OS + (size_t)(m0 + (idx >> 3)) * 2048 + h * 128 + HF * 64 + 8 * (idx & 7); \
            { v4u w_; w_.x = fa::cvtpk(lo[q][0], lo[q][1]); w_.y = fa::cvtpk(lo[q][2], lo[q][3]); w_.z = fa::cvtpk(hh[q][0], hh[q][1]); w_.w = fa::cvtpk(hh[q][2], hh[q][3]); *(GAS v4u*)ob = w_; } } } while (0)
        SEL_HALF(0); SEL_HALF(1);
#undef SEL_HALF
        __syncthreads();
    }
    {
        fa::St S; fa::st_init(S);
        fa::MaskWin mk{qlo, t_row - 4 * hi};
        const int t0 = 4 * qb - 8 > 0 ? 4 * qb - 8 : 0;
        fa::attn_pass(S, qr, Pb + C_KW + hk * 128, Pb + C_VW + hk * 128, LDP, t0, 4 * qb + 4, lds, mk, tid, c.wave, lane);
        const float g2 = sigm(bf2f(grow[(unsigned)(r32 * LDP + 2)]) + a.b_gate[h * 3 + 2]);
        float rli[16]; fa::row_factors(g2 / S.l, rli, lds, c.wave, r32, hi);
        __syncthreads();
        LAS float* st = (LAS float*)lds + c.wave * 2048;
#define WIN_HALF(HF) do { f32x4 lo[4], hh[4]; v4u zz[4], cc_[4], ss_[4]; \
        _Pragma("unroll") for (int q = 0; q < 4; ++q) { const int idx = q * 64 + lane; const size_t mr = (size_t)(m0 + (idx >> 3)); const int gcol = h * 128 + HF * 64 + 8 * (idx & 7); \
            zz[q] = *(const GAS v4u*)(P + mr * LDP + C_ZA + gcol); cc_[q] = *(const GAS v4u*)(OC + mr * 2048 + gcol); ss_[q] = *(const GAS v4u*)(OS + mr * 2048 + gcol); } \
        fa::stage_half<HF>(S.o, rli, st, r32, hi, lane, lo, hh); \
        _Pragma("unroll") for (int q = 0; q < 4; ++q) { const int idx = q * 64 + lane; const size_t mr = (size_t)(m0 + (idx >> 3)); const int gcol = h * 128 + HF * 64 + 8 * (idx & 7); \
            const f32x4 c0 = {fa::bflo(cc_[q].x), fa::bfhi(cc_[q].x), fa::bflo(cc_[q].y), fa::bfhi(cc_[q].y)}, c1 = {fa::bflo(cc_[q].z), fa::bfhi(cc_[q].z), fa::bflo(cc_[q].w), fa::bfhi(cc_[q].w)}; \
            const f32x4 s0 = {fa::bflo(ss_[q].x), fa::bfhi(ss_[q].x), fa::bflo(ss_[q].y), fa::bfhi(ss_[q].y)}, s1 = {fa::bflo(ss_[q].z), fa::bfhi(ss_[q].z), fa::bflo(ss_[q].w), fa::bfhi(ss_[q].w)}; \
            const f32x4 a0 = lo[q] + c0 + s0, a1 = hh[q] + c1 + s1; v4u w; \
            w.x = fa::cvtpk(fa::silu_mul(a0[0], fa::bflo(zz[q].x)), fa::silu_mul(a0[1], fa::bfhi(zz[q].x))); w.y = fa::cvtpk(fa::silu_mul(a0[2], fa::bflo(zz[q].y)), fa::silu_mul(a0[3], fa::bfhi(zz[q].y))); \
            w.z = fa::cvtpk(fa::silu_mul(a1[0], fa::bflo(zz[q].z)), fa::silu_mul(a1[1], fa::bfhi(zz[q].z))); w.w = fa::cvtpk(fa::silu_mul(a1[2], fa::bflo(zz[q].w)), fa::silu_mul(a1[3], fa::bfhi(zz[q].w))); \
            *(GAS v4u*)(MIX + mr * DM + gcol) = w; } } while (0)
        WIN_HALF(0); WIN_HALF(1);
#undef WIN_HALF
        __syncthreads();
    }
}
__device__ __forceinline__ void p4_nsa_mfma(const Args& a, const Ctx& c) {
    for (int it = c.bid; it < 256; it += c.G) {
        const int x = it & 7, y = it >> 3, grp = 2 * x + (y >> 4), idx = y & 15;
        const int b = grp >> 2, hk = grp & 3, g = idx >> 2, pr = idx & 3, h = hk * 4 + g;
        nsa_block(a, c, b, h, pr);
        nsa_block(a, c, b, h, 7 - pr);
    }
}

__device__ __forceinline__ void dil_block(const Args& a, const Ctx& c, int b, int h, int r4, int pb) {
    unsigned char* ws = a.ws;
    const bf16* P = (const bf16*)(ws + WS_P); bf16* MIX = (bf16*)(ws + WS_MIX);
    LAS char* lds = (LAS char*)(c.lds + RING_OFF);
    int lane = c.lane, tid = c.tid; asm volatile("" : "+v"(lane), "+v"(tid));
    const int r32 = lane & 31, hi = lane >> 5;
    const int plo = pb * 256 + c.wave * 32, p_row = plo + r32, tok = 4 * p_row + r4, mrow0 = b * SEQ + 4 * plo + r4;
    bf16x8 qr[8];
    { const bf16* qb_ = P + (size_t)mrow0 * LDP + C_QB + h * 128; const unsigned lq = (unsigned)(r32 * 4 * LDP + hi * 8);
#pragma unroll
      for (int d0 = 0; d0 < 8; ++d0) qr[d0] = *(const GAS bf16x8*)(qb_ + lq + d0 * 16); }
    const bf16* Pb = P + (size_t)b * SEQ * LDP;
    fa::St S; fa::st_init(S);
    {   fa::MaskDilA mk{plo, p_row - 4 * hi};
        fa::attn_pass(S, qr, Pb + (size_t)r4 * LDP + C_KB + h * 128, Pb + (size_t)r4 * LDP + C_VB + h * 128, 4 * LDP, 0, 4 * pb + 4, lds, mk, tid, c.wave, lane); }
    {   const int tmin = 1024 * pb + r4, tmax = 1024 * pb + 1020 + r4;
        const int t0 = tmin - 128 > 0 ? (tmin - 128) >> 6 : 0, t1 = (tmax >> 6) + 1;
        fa::MaskDilB mk{4 * plo + r4, tok - 4 * hi};
        fa::attn_pass(S, qr, Pb + C_KB + h * 128, Pb + C_VB + h * 128, LDP, t0, t1, lds, mk, tid, c.wave, lane); }
    float rli[16]; fa::row_factors(1.0f / S.l, rli, lds, c.wave, r32, hi);
    __syncthreads();
    LAS float* st = (LAS float*)lds + c.wave * 2048;
#define DIL_HALF(HF) do { f32x4 lo[4], hh[4]; v4u zz[4]; \
        _Pragma("unroll") for (int q = 0; q < 4; ++q) { const int idx = q * 64 + lane; const size_t mr = (size_t)(mrow0 + 4 * (idx >> 3)); const int gcol = h * 128 + HF * 64 + 8 * (idx & 7); \
            zz[q] = *(const GAS v4u*)(P + mr * LDP + C_ZB + gcol); } \
        fa::stage_half<HF>(S.o, rli, st, r32, hi, lane, lo, hh); \
        _Pragma("unroll") for (int q = 0; q < 4; ++q) { const int idx = q * 64 + lane; const size_t mr = (size_t)(mrow0 + 4 * (idx >> 3)); const int gcol = h * 128 + HF * 64 + 8 * (idx & 7); \
            const f32x4 a0 = lo[q], a1 = hh[q]; v4u w; \
            w.x = fa::cvtpk(fa::silu_mul(a0[0], fa::bflo(zz[q].x)), fa::silu_mul(a0[1], fa::bfhi(zz[q].x))); w.y = fa::cvtpk(fa::silu_mul(a0[2], fa::bflo(zz[q].y)), fa::silu_mul(a0[3], fa::bfhi(zz[q].y))); \
            w.z = fa::cvtpk(fa::silu_mul(a1[0], fa::bflo(zz[q].z)), fa::silu_mul(a1[1], fa::bfhi(zz[q].z))); w.w = fa::cvtpk(fa::silu_mul(a1[2], fa::bflo(zz[q].w)), fa::silu_mul(a1[3], fa::bfhi(zz[q].w))); \
            *(GAS v4u*)(MIX + mr * DM + 2048 + gcol) = w; } } while (0)
    DIL_HALF(0); DIL_HALF(1);
#undef DIL_HALF
    __syncthreads();
}
__device__ __forceinline__ void p4_dil_mfma(const Args& a, const Ctx& c) {
    for (int it = c.bid; it < 256; it += c.G) {
        const int x = it & 7, y = it >> 3, bh = 8 * x + (y >> 2), r4 = y & 3, b = bh >> 4, h = bh & 15;
        dil_block(a, c, b, h, r4, 0);
        dil_block(a, c, b, h, r4, 1);
    }
}

__device__ __forceinline__ void cmp_item(const Args& a, const Ctx& c, int b, int hk, int tb) {
    unsigned char* ws = a.ws;
    const bf16* P = (const bf16*)(ws + WS_P); const bf16* KCB = (const bf16*)(ws + WS_KCB); const bf16* VCB = (const bf16*)(ws + WS_VCB);
    bf16* OC = (bf16*)(ws + WS_OC); unsigned* SEL = (unsigned*)(ws + WS_SEL);
    LAS char* lds = (LAS char*)(c.lds + RING_OFF);
    LAS float* imps = (LAS float*)(lds + 2 * fa::BUFS);
    int lane = c.lane, tid = c.tid; asm volatile("" : "+v"(lane), "+v"(tid));
    const int r32 = lane & 31, hi = lane >> 5, g = c.wave >> 1, h = hk * 4 + g, bh = b * 4 + hk;
    const int tl0 = 32 * (c.wave & 1), tw0 = 64 * tb + tl0, t = tw0 + r32, m0 = b * SEQ + tw0;
    const int nt = tb >= 16 ? 2 : 1;
    LAS char* V_lds = lds + fa::A_V; LAS char* K_lds = lds + fa::A_K;
    {   const int sr = tid >> 4, sc = (tid & 15) * 8; const int kws = FA_KSWZ(sr, sc * 2), vst0 = fa::v_st(sr, sc), vst1 = fa::v_st(32 + sr, sc);
        const bf16* Kg = KCB + (size_t)bh * 128 * 128; const bf16* Vg = VCB + (size_t)bh * 128 * 128; const unsigned lo = (unsigned)(sr * 128 + sc);
        for (int tt = 0; tt < nt; ++tt) {
            const bf16x8 k0 = *(const GAS bf16x8*)(Kg + tt * 8192 + lo), k1 = *(const GAS bf16x8*)(Kg + tt * 8192 + 4096 + lo);
            const bf16x8 v0 = *(const GAS bf16x8*)(Vg + tt * 8192 + lo), v1 = *(const GAS bf16x8*)(Vg + tt * 8192 + 4096 + lo);
            *(LAS bf16x8*)(K_lds + tt * fa::BUFS + kws) = k0; *(LAS bf16x8*)(K_lds + tt * fa::BUFS + kws + 32 * 256) = k1;
            *(LAS bf16x8*)(V_lds + tt * fa::BUFS + vst0) = v0; *(LAS bf16x8*)(V_lds + tt * fa::BUFS + vst1) = v1; } }
    bf16x8 qr[8];
    { const bf16* qb_ = P + (size_t)m0 * LDP + C_QA + h * 128; const unsigned lq = (unsigned)(r32 * LDP + hi * 8);
#pragma unroll
      for (int d0 = 0; d0 < 8; ++d0) qr[d0] = *(const GAS bf16x8*)(qb_ + lq + d0 * 16); }
    __syncthreads();
    const float NEG = -__builtin_inff();
    fa::f32x16 p0, p1, p2, p3;
    fa::qkt<0>(p0, p1, K_lds, r32, hi, qr);
    const int cmax = (t - 31) >> 4;
    fa::mask_tile(p0, p1, cmax - 4 * hi, 0x40000000u);
    if (nt == 2) { fa::qkt<1>(p2, p3, K_lds, r32, hi, qr); fa::mask_tile(p2, p3, cmax - 4 * hi - 64, 0x40000000u); }
    else {
#pragma unroll
        for (int r = 0; r < 16; ++r) { p2[r] = NEG; p3[r] = NEG; } }
    float mx = p0[0];
#pragma unroll
    for (int r = 0; r < 16; ++r) mx = fmaxf(fmaxf(mx, p0[r]), fmaxf(p1[r], fmaxf(p2[r], p3[r])));
    { auto rr = __builtin_amdgcn_permlane32_swap(__float_as_uint(mx), __float_as_uint(mx), false, false); mx = fmaxf(__uint_as_float(rr[0]), __uint_as_float(rr[1])); }
    const float mL = (mx == NEG) ? 0.f : -mx * fa::C2;
    float l = 0.f;
#pragma unroll
    for (int r = 0; r < 16; ++r) { p0[r] = __builtin_amdgcn_exp2f(fmaf(p0[r], fa::C2, mL)); p1[r] = __builtin_amdgcn_exp2f(fmaf(p1[r], fa::C2, mL));
        p2[r] = __builtin_amdgcn_exp2f(fmaf(p2[r], fa::C2, mL)); p3[r] = __builtin_amdgcn_exp2f(fmaf(p3[r], fa::C2, mL)); l += (p0[r] + p1[r]) + (p2[r] + p3[r]); }
    { auto rr = __builtin_amdgcn_permlane32_swap(__float_as_uint(l), __float_as_uint(l), false, false); l = __uint_as_float(rr[0]) + __uint_as_float(rr[1]); }
    const float inv = l > 0.f ? 1.0f / l : 0.f;
    {   fa::f32x16 o[4];
#pragma unroll
        for (int d = 0; d < 4; ++d)
#pragma unroll
            for (int r = 0; r < 16; ++r) o[d][r] = 0.f;
        const int vb0 = (int)(unsigned)(uintptr_t)lds + fa::v_rd_base(lane);
        bf16x8 pa0, pa1, pa2, pa3;
        fa::pack_p(p0, p1, pa0, pa1, pa2, pa3); FA_SBAR(); fa::pv_tile<0>(o, vb0, pa0, pa1, pa2, pa3);
        if (nt == 2) { fa::pack_p(p2, p3, pa0, pa1, pa2, pa3); FA_SBAR(); fa::pv_tile<1>(o, vb0, pa0, pa1, pa2, pa3); }
        float own[16], last[16];
#pragma unroll
        for (int k = 0; k < 16; ++k) { const int q = k & 3; const fa::f32x16& px = (k >> 2) == 0 ? p0 : (k >> 2) == 1 ? p1 : (k >> 2) == 2 ? p2 : p3;
            own[k] = ((px[4 * q] + px[4 * q + 1]) + (px[4 * q + 2] + px[4 * q + 3])) * inv; last[k] = px[4 * q + 3] * inv; }
        LAS float* dst = imps + ((g * 64 + tl0 + r32) * 32 + hi);
#pragma unroll
        for (int k = 0; k < 16; ++k) { const float x = __shfl_xor(last[k], 32); const float xp = (k > 0) ? __shfl_xor(last[k > 0 ? k - 1 : 0], 32) : 0.f;
            dst[2 * k] = own[k] + (hi ? x : xp); }
        const float g0 = sigm(bf2f((P + (size_t)m0 * LDP + C_GA + h * 3)[(unsigned)(r32 * LDP)]) + a.b_gate[h * 3]);
        float rli[16]; fa::row_factors(inv * g0, rli, lds, c.wave, r32, hi);
        __syncthreads();
        LAS float* st = (LAS float*)lds + c.wave * 2048;
#define CMP_HALF(HF) do { f32x4 lo[4], hh[4]; fa::stage_half<HF>(o, rli, st, r32, hi, lane, lo, hh); \
        _Pragma("unroll") for (int q = 0; q < 4; ++q) { const int idx = q * 64 + lane; bf16* ob = OC + (size_t)(m0 + (idx >> 3)) * 2048 + h * 128 + HF * 64 + 8 * (idx & 7); \
            { v4u w_; w_.x = fa::cvtpk(lo[q][0], lo[q][1]); w_.y = fa::cvtpk(lo[q][2], lo[q][3]); w_.z = fa::cvtpk(hh[q][0], hh[q][1]); w_.w = fa::cvtpk(hh[q][2], hh[q][3]); *(GAS v4u*)ob = w_; } } } while (0)
        CMP_HALF(0); CMP_HALF(1);
#undef CMP_HALF
    }
#pragma unroll 1
    for (int tt = 0; tt < 4; ++tt) {
        const int tl = c.wave * 8 + tt * 2 + hi, j = r32, tq = 64 * tb + tl, cur = tq >> 6;
        float imp = (imps[(0 * 64 + tl) * 32 + j] + imps[(1 * 64 + tl) * 32 + j]) + (imps[(2 * 64 + tl) * 32 + j] + imps[(3 * 64 + tl) * 32 + j]);
        const bool forced = (j == 0) || (j == cur) || (j == cur - 1);
        float v = forced ? imp + 1e4f : imp;
        if (j > cur) v = NEG;
        int rank = 0;
        for (int jj = 0; jj < 32; ++jj) { const float vo = __shfl(v, (lane & 32) + jj); rank += (vo > v || (vo == v && jj < j)) ? 1 : 0; }
        const bool sel = (rank < TOPN) && (j <= cur);
        const unsigned long long bal = __ballot(sel);
        if (r32 == 0) SEL[bh * SEQ + tq] = (unsigned)(bal >> (32 * hi));
    }
    __syncthreads();
}
__device__ __forceinline__ void p3_cmp_mfma(const Args& a, const Ctx& c) {
    for (int it = c.bid; it < 512; it += c.G) {
        const int bh = (it >> 5) & 15, tb = (it & 31) ^ ((it >> 8) ? 31 : 0);
        cmp_item(a, c, bh >> 2, bh & 3, tb);
    }
}

__device__ __forceinline__ void p6_final(const Args& a, const Ctx& c) {
    const bf16* Y = (const bf16*)(a.ws + WS_Y);
    for (int m = c.gw; m < M; m += c.NGW) {
        const GAS v4u* yr = (const GAS v4u*)(Y + (size_t)m * DM) + c.lane;
        v4u yv[8]; float s = 0.f;
#pragma unroll
        for (int j = 0; j < 8; ++j) yv[j] = yr[64 * j];
        const GAS f32x4* xr = (const GAS f32x4*)(a.x + (size_t)m * DM) + 2 * c.lane;
        GAS f32x4* orow = (GAS f32x4*)(a.out + (size_t)m * DM) + 2 * c.lane;
#pragma unroll
        for (int j = 0; j < 8; ++j) { const float y0 = fa::bflo(yv[j].x), y1 = fa::bfhi(yv[j].x), y2 = fa::bflo(yv[j].y), y3 = fa::bfhi(yv[j].y),
                                                  y4 = fa::bflo(yv[j].z), y5 = fa::bfhi(yv[j].z), y6 = fa::bflo(yv[j].w), y7 = fa::bfhi(yv[j].w);
            s += ((y0 * y0 + y1 * y1) + (y2 * y2 + y3 * y3)) + ((y4 * y4 + y5 * y5) + (y6 * y6 + y7 * y7)); }
        const float rstd = 1.0f / sqrtf(wave_sum(s) * (1.0f / DM) + EPS);
#pragma unroll
        for (int j = 0; j < 8; ++j) {
            const f32x4 w0 = ((const GAS f32x4*)a.post_w)[2 * c.lane + 128 * j], w1 = ((const GAS f32x4*)a.post_w)[2 * c.lane + 128 * j + 1];
            const f32x4 x0 = xr[128 * j], x1 = xr[128 * j + 1];
            const f32x4 ya = {fa::bflo(yv[j].x), fa::bfhi(yv[j].x), fa::bflo(yv[j].y), fa::bfhi(yv[j].y)}, yb = {fa::bflo(yv[j].z), fa::bfhi(yv[j].z), fa::bflo(yv[j].w), fa::bfhi(yv[j].w)};
            orow[128 * j] = x0 + ya * rstd * w0; orow[128 * j + 1] = x1 + yb * rstd * w1; }
    }
}


#ifndef MK_SPLIT
#define MK_SPLIT 0
#endif
constexpr int NPHASE = 8;

__global__ void __launch_bounds__(NWAVES * 64, 2) fwd_kernel(Args args) {
    extern __shared__ __attribute__((aligned(16))) unsigned char lds_raw[];
    Ctx c;
    c.lds = (LAS unsigned char*)lds_raw;
    c.tid = threadIdx.x; c.lane = c.tid & 63; c.wave = __builtin_amdgcn_readfirstlane(c.tid >> 6);
    c.G = gridDim.x; c.bid = blockIdx.x; c.gw = c.bid * NWAVES + c.wave; c.NGW = c.G * NWAVES;
    unsigned char* ws = args.ws;
    gu32* ctl = (gu32*)(ws + WS_CTL);
    volatile LAS unsigned* MISC = (volatile LAS unsigned*)(c.lds + MISC_OFF);
    for (int u = c.tid; u < (LDS_BYTES - LDSCTL_OFF) / 4; u += NWAVES * 64) ((LAS unsigned*)(c.lds + LDSCTL_OFF))[u] = 0u;
    __syncthreads();
    XcdBarrier bar; bar.bar = (unsigned*)(ctl + CW_BAR); bar.x = 0; bar.st = nullptr;
    if (!MK_SPLIT) bar = xcd_barrier_post((unsigned*)(ctl + CW_BAR), MISC + 8);
    const int lo = args.ph_lo, hi = args.ph_hi;
#define IN(k) (lo <= (k) && (k) < hi)
#define SEAM(k) do { if (IN(k) && IN((k) + 1)) xcd_barrier(bar); } while (0)

    if (IN(0)) { p0_prologue(args, c); } SEAM(0);
    if (IN(1)) {
        pg8::Gemm g{(const pg8::bf16_t*)(ws + WS_HB), (const pg8::bf16_t*)(ws + WS_WIN), M, NP, DM, DM}; pg8::StaticOrder S; S.init(M, NP, c.G, c.bid);
        pg8::EpiP E{(pg8::bf16_t*)(ws + WS_P), NP, (pg8::bf16_t*)(ws + WS_QR), (pg8::bf16_t*)(ws + WS_XKV), (const float*)(ws + WS_COS), (const float*)(ws + WS_SIN)};
        pg8::gemm_phase<pg8::EpiP, pg8::StaticOrder, true, true>(c.lds + RING_OFF, g, S, E);
        {
            const int rem = ((M / 256) * (NP / 256)) % c.G, nt_ = rem ? c.G - rem : c.G, ti = rem ? c.bid - rem : c.bid;
            if (ti >= 0) p0_transposes(args, c, TI_IN, TI_ALL, ti * NWAVES + c.wave, nt_ * NWAVES);
        }
    } SEAM(1);
    if (IN(2)) {
        pg8::Gemm g{(const pg8::bf16_t*)(ws + WS_XKV), (const pg8::bf16_t*)(ws + WS_WLR), 4096, 1024, 256, 2048}; pg8::CmpOrder S{c.bid, c.G};
        pg8::EpiLR E{(float*)(ws + WS_LR), 1024, (size_t)4096 * 1024};
        pg8::gemm_phase<pg8::EpiLR, pg8::CmpOrder, false, true>(c.lds + RING_OFF, g, S, E);
    } SEAM(2);
    if (IN(3)) { p2c_stage2(args, c); } SEAM(3);
    if (IN(4)) { p3_cmp_mfma(args, c); } SEAM(4);
    if (IN(5)) {
        p4_nsa_mfma(args, c);
        p4_dil_mfma(args, c);
    } SEAM(5);
    if (IN(6)) {
        pg8::Gemm g{(const pg8::bf16_t*)(ws + WS_MIX), (const pg8::bf16_t*)(ws + WS_WOUT), M, DM, DM, DM}; pg8::StaticOrder S; S.init(M, DM, c.G, c.bid);
        pg8::EpiBf16<0> E{(pg8::bf16_t*)(ws + WS_Y), DM, nullptr, 0, 0, 1.f};
        pg8::gemm_phase<pg8::EpiBf16<0>, pg8::StaticOrder, true, true>(c.lds + RING_OFF, g, S, E);
    } SEAM(6);
    if (IN(7)) { p6_final(args, c); }
#undef IN
#undef SEAM
}

extern "C" void kernel_launch(void* const* d_in, const int* in_sizes, int n_in, void* d_out, int out_size, void* d_ws, size_t ws_size, hipStream_t stream) {
    static int grid = 0;
    if (grid == 0) {
        if (n_in != 13 || out_size != M * DM || ws_size < WS_END) { fprintf(stderr, "kernel_launch: unexpected shapes (n_in %d out %d ws %zu)\n", n_in, out_size, ws_size); grid = -1; return; }
        int dev = 0, cus = 0, per_cu = 0;
        if (hipGetDevice(&dev) != hipSuccess || hipDeviceGetAttribute(&cus, hipDeviceAttributeMultiprocessorCount, dev) != hipSuccess) { grid = -1; return; }
        if (hipFuncSetAttribute((const void*)fwd_kernel, hipFuncAttributeMaxDynamicSharedMemorySize, LDS_BYTES) != hipSuccess) { fprintf(stderr, "kernel_launch: hipFuncSetAttribute failed\n"); grid = -1; return; }
        if (hipOccupancyMaxActiveBlocksPerMultiprocessor(&per_cu, (const void*)fwd_kernel, NWAVES * 64, LDS_BYTES) != hipSuccess || per_cu < 1)
            fprintf(stderr, "kernel_launch: occupancy query reports %d\n", per_cu);
        (void)hipGetLastError();
        grid = cus;
    }
    if (grid < 0) return;
    if (hipMemsetAsync((char*)d_ws + WS_CTL, 0, CTL_ZERO_BYTES, stream) != hipSuccess) return;
    Args a{};
    a.x = (const float*)d_in[0]; a.pos = (const int*)d_in[1]; a.pre_w = (const float*)d_in[2]; a.post_w = (const float*)d_in[3];
    a.w_in = (const float*)d_in[4]; a.b_gate = (const float*)d_in[5]; a.pe_k = (const float*)d_in[6]; a.pe_v = (const float*)d_in[7];
    a.wk1 = (const float*)d_in[8]; a.wk2 = (const float*)d_in[9]; a.wv1 = (const float*)d_in[10]; a.wv2 = (const float*)d_in[11]; a.w_out = (const float*)d_in[12];
    a.out = (float*)d_out; a.ws = (unsigned char*)d_ws;
#if MK_SPLIT
    for (int p = 0; p < NPHASE; ++p) { a.ph_lo = p; a.ph_hi = p + 1; hipLaunchKernelGGL(fwd_kernel, dim3(grid), dim3(NWAVES * 64), LDS_BYTES, stream, a); }
#else
    a.ph_lo = 0; a.ph_hi = NPHASE;
    hipLaunchKernelGGL(fwd_kernel, dim3(grid), dim3(NWAVES * 64), LDS_BYTES, stream, a);
#endif
}
```

```cpp
#include <hip/hip_runtime.h>
#include <cstdio>
#include <cstdint>
namespace pg8 {
#define PG8_LAS __attribute__((address_space(3)))
typedef unsigned short bf16_t;
typedef short bf16x8 __attribute__((ext_vector_type(8)));
typedef float f32x4 __attribute__((ext_vector_type(4)));
typedef unsigned u32x4 __attribute__((ext_vector_type(4)));
constexpr int BM = 256, BK = 64, HALF = 128, HTB = HALF * BK * 2  , STAGE_BYTES = 8 * HTB, NXCD = 8, WGM = 8;

__host__ __device__ __forceinline__ int lds_byte(int r, int c) { const int st = (r >> 4) * 2 + (c >> 5), rr = r & 15, cc = c & 31, ob = rr * 64 + cc * 2; return st * 1024 + (ob ^ (((ob >> 9) & 1) << 5)); }
__host__ __device__ __forceinline__ void stage_rc(int b, int& R, int& C) { const int st = b / 1024, sb = b % 1024, swz = sb ^ (((sb >> 9) & 1) << 5); R = (st >> 1) * 16 + swz / 64; C = (st & 1) * 32 + (swz % 64) / 2; }
__host__ __device__ __forceinline__ int perm32(int rho) { const int n = rho >> 4, i = rho & 15; return 8 * (i >> 2) + 4 * n + (i & 3); }

struct Unit { int pm, pn, ko; };
struct Gemm { const bf16_t* A; const bf16_t* Bt; int M, N, K, ld; };

struct StaticOrder {
    int nM, nN, nwg, G, c;
    __host__ __device__ void init(int M, int N, int G_, int c_) { nM = M / BM; nN = N / BM; nwg = nM * nN; G = G_; c = c_; }
    __host__ __device__ bool next(int i, Unit& u) const {
        const long L = (long)i * G + c; if (L >= nwg) return false;
        int wgid = (int)L; { const int q = nwg / NXCD, r = nwg % NXCD, xcd = wgid % NXCD, off = wgid / NXCD; wgid = (xcd < r ? xcd * (q + 1) : r * (q + 1) + (xcd - r) * q) + off; }
        const int nig = WGM * nN, gid = wgid / nig, fm = gid * WGM, gsz = (nM - fm) < WGM ? (nM - fm) : WGM;
        u.pm = fm + ((wgid % nig) % gsz); u.pn = (wgid % nig) / gsz; u.ko = 0; return true;
    }
    __device__ __forceinline__ void a_ready(const Unit&) const {}
    __device__ __forceinline__ void done(const Unit&) const {}
};

__device__ __forceinline__ unsigned cvt_pk_bf16(float lo, float hi) { unsigned r; asm volatile("v_cvt_pk_bf16_f32 %0, %1, %2" : "=v"(r) : "v"(lo), "v"(hi)); return r; }
typedef float f32x2 __attribute__((ext_vector_type(2)));
__device__ __forceinline__ f32x2 gelu_pk(f32x2 v) {
    const f32x2 av = __builtin_elementwise_abs(v), d = av * 0.2316418882f + 1.0f;
    f32x2 t; t.x = __builtin_amdgcn_rcpf(d.x); t.y = __builtin_amdgcn_rcpf(d.y);
    f32x2 q = t * 0.5307027145f + (-0.7265760135f); q = q * t + 0.7107068705f; q = q * t + (-0.142248368f); q = q * t + 0.127414796f; q = q * t;
    const f32x2 s = (v * v) * (-0.72134752044f);
    f32x2 e; e.x = __builtin_amdgcn_exp2f(s.x); e.y = __builtin_amdgcn_exp2f(s.y);
    const f32x2 m = v * (q * e), r = v - m;
    f32x2 o; o.x = v.x < 0.f ? m.x : r.x; o.y = v.y < 0.f ? m.y : r.y; return o;
}

template <int ACT  > struct EpiBf16 {
    static constexpr bool PERM = true, AFTER_DRAIN = false; static_assert(ACT == 0 || ACT == 1, "EpiBf16: ACT is 0 (none) or 1 (gelu_pk)");
    bf16_t* O; int ldc; const float* bias; int split_cols; size_t split_stride; float scale0;
    __device__ __forceinline__ void operator()(const f32x4 (&acc)[2][2][4][2], const Unit& u, int wr, int wc, int fr, int fq) const {
        const int row0 = u.pm * BM + wr * 64 + fr; int colt = u.pn * BM; bf16_t* base = O;
        float sc = 1.f; if (split_cols) { const int t = colt / split_cols; base += (size_t)t * split_stride; colt -= t * split_cols; if (t == 0) sc = scale0; }
        const int col0 = colt + wc * 32 + 8 * fq, bcol0 = u.pn * BM + wc * 32 + 8 * fq;
        f32x4 bv[2][2];
#pragma unroll
        for (int bj = 0; bj < 2; ++bj)
#pragma unroll
            for (int n = 0; n < 2; ++n) bv[bj][n] = bias ? *(const f32x4*)(bias + bcol0 + bj * HALF + 4 * n) : (f32x4){0.f, 0.f, 0.f, 0.f};
#pragma unroll
        for (int ai = 0; ai < 2; ++ai)
#pragma unroll
            for (int m = 0; m < 4; ++m) { bf16_t* rowp = base + (size_t)(row0 + ai * HALF + m * 16) * ldc + col0;
#pragma unroll
                for (int bj = 0; bj < 2; ++bj) { f32x4 v0 = acc[ai][bj][m][0] + bv[bj][0], v1 = acc[ai][bj][m][1] + bv[bj][1];
                    if (ACT == 1) { f32x2 a = gelu_pk((f32x2){v0[0], v0[1]}), b = gelu_pk((f32x2){v0[2], v0[3]}), c = gelu_pk((f32x2){v1[0], v1[1]}), d = gelu_pk((f32x2){v1[2], v1[3]});
                        v0 = (f32x4){a.x, a.y, b.x, b.y}; v1 = (f32x4){c.x, c.y, d.x, d.y}; }
                    v0 = v0 * sc; v1 = v1 * sc; u32x4 w; w.x = cvt_pk_bf16(v0[0], v0[1]); w.y = cvt_pk_bf16(v0[2], v0[3]); w.z = cvt_pk_bf16(v1[0], v1[1]); w.w = cvt_pk_bf16(v1[2], v1[3]);
                    *(u32x4*)(rowp + bj * HALF) = w; } }
    }
};
struct EpiF32 {
    static constexpr bool PERM = false, AFTER_DRAIN = false;
    float* O; int ldc;
    __device__ __forceinline__ void operator()(const f32x4 (&acc)[2][2][4][2], const Unit& u, int wr, int wc, int fr, int fq) const {
        const int row0 = u.pm * BM + wr * 64 + fr, col0 = u.pn * BM + wc * 32 + 4 * fq;
#pragma unroll
        for (int ai = 0; ai < 2; ++ai)
#pragma unroll
            for (int m = 0; m < 4; ++m) { float* rowp = O + (size_t)(row0 + ai * HALF + m * 16) * ldc + col0;
#pragma unroll
                for (int bj = 0; bj < 2; ++bj)
#pragma unroll
                    for (int n = 0; n < 2; ++n) *(f32x4*)(rowp + bj * HALF + n * 16) = acc[ai][bj][m][n]; }
    }
};

struct EpiP {
    static constexpr bool PERM = true, AFTER_DRAIN = false;
    bf16_t* Pm; int ldc; bf16_t* QR; bf16_t* XKV; const float* COS; const float* SIN;
    __device__ __forceinline__ void operator()(const f32x4 (&acc)[2][2][4][2], const Unit& u, int wr, int wc, int fr, int fq) const {
        const int pn = u.pn;
        const bool is_qa = pn < 8, is_rope = is_qa || pn == 20 || pn == 21 || pn == 24 || pn == 25 || (pn >= 28 && pn < 44), is_x = pn >= 16 && pn < 20;
        const int row0 = u.pm * BM + wr * 64 + fr, colw = wc * 32 + 8 * fq;
#pragma unroll
        for (int ai = 0; ai < 2; ++ai)
#pragma unroll
            for (int m = 0; m < 4; ++m) {
                const int row = row0 + ai * HALF + m * 16;
                f32x4 cs = {1.f, 1.f, 1.f, 1.f}, sn = {0.f, 0.f, 0.f, 0.f};
                if (is_rope) { cs = *(const f32x4*)(COS + (size_t)row * 64 + 16 * wc + 4 * fq); sn = *(const f32x4*)(SIN + (size_t)row * 64 + 16 * wc + 4 * fq); }
#pragma unroll
                for (int bj = 0; bj < 2; ++bj) {
                    const f32x4 v0 = acc[ai][bj][m][0], v1 = acc[ai][bj][m][1];
                    u32x4 w;
                    if (!is_rope || is_qa) { w.x = cvt_pk_bf16(v0[0], v0[1]); w.y = cvt_pk_bf16(v0[2], v0[3]); w.z = cvt_pk_bf16(v1[0], v1[1]); w.w = cvt_pk_bf16(v1[2], v1[3]); }
                    if (is_x) { const int hq = (pn - 16) * 2 + bj, kv = hq >> 2, hk = hq & 3, b = row >> 11, tok = row & 2047;
                        *(u32x4*)(XKV + ((size_t)((kv * 16 + b * 4 + hk) * 2048 + tok)) * 128 + colw) = w; }
                    else if (!is_rope) { *(u32x4*)(Pm + (size_t)row * ldc + pn * BM + bj * HALF + colw) = w; }
                    else {
                        if (is_qa) *(u32x4*)(Pm + (size_t)row * ldc + pn * BM + bj * HALF + colw) = w;
                        const f32x4 r0 = v0 * cs - v1 * sn, r1 = v1 * cs + v0 * sn;
                        u32x4 wr_; wr_.x = cvt_pk_bf16(r0[0], r0[1]); wr_.y = cvt_pk_bf16(r0[2], r0[3]); wr_.z = cvt_pk_bf16(r1[0], r1[1]); wr_.w = cvt_pk_bf16(r1[2], r1[3]);
                        if (is_qa) *(u32x4*)(QR + (size_t)row * 2048 + pn * BM + bj * HALF + colw) = wr_;
                        else *(u32x4*)(Pm + (size_t)row * ldc + pn * BM + bj * HALF + colw) = wr_;
                    }
                }
            }
    }
};

struct EpiLR {
    static constexpr bool PERM = false, AFTER_DRAIN = false;
    float* O; int ldc; size_t ks_stride;
    __device__ __forceinline__ void operator()(const f32x4 (&acc)[2][2][4][2], const Unit& u, int wr, int wc, int fr, int fq) const {
        const int row0 = u.pm * BM + wr * 64 + fr, col0 = u.pn * BM + wc * 32 + 4 * fq; float* Ob = O + (size_t)(u.ko >> 8) * ks_stride;
#pragma unroll
        for (int ai = 0; ai < 2; ++ai)
#pragma unroll
            for (int m = 0; m < 4; ++m) { float* rowp = Ob + (size_t)(row0 + ai * HALF + m * 16) * ldc + col0;
#pragma unroll
                for (int bj = 0; bj < 2; ++bj)
#pragma unroll
                    for (int n = 0; n < 2; ++n) *(f32x4*)(rowp + bj * HALF + n * 16) = acc[ai][bj][m][n]; }
    }
};
struct CmpOrder { int c, G;
    __device__ __forceinline__ bool next(int i, Unit& u) const { const int L = i * G + c; if (L >= 256) return false;
        const int ks = L & 7, q = L >> 3, kv = q >> 4, pmi = (q >> 1) & 7, pni = q & 1; u.pm = kv * 8 + pmi; u.pn = kv * 2 + pni; u.ko = ks * 256; return true; }
    __device__ __forceinline__ void a_ready(const Unit&) const {}
    __device__ __forceinline__ void done(const Unit&) const {}
};

template <class Epi, class Sched, bool ALIGN_EPI = false, bool SP2 = false>
__device__ __forceinline__ void gemm_phase(PG8_LAS unsigned char* lds, const Gemm g, const Sched& S, const Epi& E) {
    const int tid = threadIdx.x, wid = __builtin_amdgcn_readfirstlane(tid >> 6), lane = tid & 63, wr = wid >> 2, wc = wid & 3, fr = lane & 15, fq = lane >> 4;
    const int K = g.K, nt = K / BK, ld = g.ld;
    unsigned voffA[2], voffB[2];
#pragma unroll
    for (int i = 0; i < 2; ++i) { int R, C; stage_rc(tid * 16 + i * 8192, R, C); const int Rb = Epi::PERM ? ((R & ~31) + perm32(R & 31)) : R;
        voffA[i] = (unsigned)(R * ld + C) * 2u; voffB[i] = (unsigned)(Rb * ld + C) * 2u; }
    const size_t kstep = (size_t)(BK * 2);
    const size_t hstep = (size_t)HALF * ld * 2;
    const size_t tstep = 2 * hstep;
    const unsigned ldsw = (unsigned)wid * 1024u;
    const int aoff = lds_byte(wr * 64 + fr, fq * 8), boff = lds_byte(wc * 32 + fr, fq * 8);
#define PG8_SA(b, h) (((b) * 2 + (h)) * HTB)
#define PG8_SB(b, h) ((4 + (b) * 2 + (h)) * HTB)
#define PG8_STAGE(bufoff, gbase, voff) do { _Pragma("unroll") for (int _i = 0; _i < 2; ++_i) \
        __builtin_amdgcn_global_load_lds((const unsigned*)((const char*)(gbase) + (voff)[_i]), (PG8_LAS unsigned*)(lds + (bufoff) + ldsw + _i * 8192), 16, 0, 0); } while (0)
#define PG8_LDA(dst, b, h) do { _Pragma("unroll") for (int m = 0; m < 4; ++m) _Pragma("unroll") for (int k = 0; k < 2; ++k) dst[m][k] = *(const PG8_LAS bf16x8*)(lds + PG8_SA(b, h) + aoff + m * 2048 + k * 1024); } while (0)
#define PG8_LDB(dst, b, h) do { _Pragma("unroll") for (int n = 0; n < 2; ++n) _Pragma("unroll") for (int k = 0; k < 2; ++k) dst[n][k] = *(const PG8_LAS bf16x8*)(lds + PG8_SB(b, h) + boff + n * 2048 + k * 1024); } while (0)
#define PG8_MMA(ai, bj, At, Bt) do { __builtin_amdgcn_s_setprio(1); _Pragma("unroll") for (int m = 0; m < 4; ++m) _Pragma("unroll") for (int n = 0; n < 2; ++n) _Pragma("unroll") for (int k = 0; k < 2; ++k) \
        acc[ai][bj][m][n] = __builtin_amdgcn_mfma_f32_16x16x32_bf16(Bt[n][k], At[m][k], acc[ai][bj][m][n], 0, 0, 0); __builtin_amdgcn_s_setprio(0); } while (0)
#define PG8_WAIT_V(n) asm volatile("s_waitcnt vmcnt(" #n ")" ::: "memory")
#define PG8_WAIT_L(n) asm volatile("s_waitcnt lgkmcnt(" #n ")" ::: "memory")
#define PG8_BAR __builtin_amdgcn_s_barrier()
#define PG8_SCHED __builtin_amdgcn_sched_barrier(0)
    Unit cur, nxt; int ui = 0;
    if (!S.next(0, cur)) return;
    f32x4 acc[2][2][4][2];
#pragma unroll
    for (int a = 0; a < 2; ++a)
#pragma unroll
        for (int b = 0; b < 2; ++b)
#pragma unroll
            for (int m = 0; m < 4; ++m)
#pragma unroll
                for (int n = 0; n < 2; ++n) acc[a][b][m][n] = (f32x4){0.f, 0.f, 0.f, 0.f};
    bf16x8 At[4][2], B0[2][2], B1[2][2];
    const char* cA = (const char*)g.A + (size_t)cur.pm * tstep + (size_t)cur.ko * 2; const char* cB = (const char*)g.Bt + (size_t)cur.pn * tstep + (size_t)cur.ko * 2;
    S.a_ready(cur);
    if constexpr (SP2) {
        PG8_STAGE(PG8_SB(0, 0), cB, voffB); PG8_STAGE(PG8_SB(0, 1), cB + hstep, voffB); PG8_STAGE(PG8_SA(0, 0), cA, voffA); PG8_STAGE(PG8_SA(0, 1), cA + hstep, voffA);
        if (wr == 1) PG8_BAR;
        PG8_WAIT_V(2); PG8_BAR;
        PG8_STAGE(PG8_SB(1, 0), cB + kstep, voffB); PG8_STAGE(PG8_SA(1, 0), cA + kstep, voffA); PG8_STAGE(PG8_SB(1, 1), cB + hstep + kstep, voffB);
        PG8_WAIT_V(6); PG8_BAR;
    } else {
        PG8_STAGE(PG8_SB(0, 0), cB, voffB); PG8_STAGE(PG8_SA(0, 0), cA, voffA); PG8_STAGE(PG8_SB(0, 1), cB + hstep, voffB); PG8_STAGE(PG8_SA(0, 1), cA + hstep, voffA);
        if (wr == 1) PG8_BAR;
        PG8_WAIT_V(4); PG8_BAR;
        PG8_STAGE(PG8_SB(1, 0), cB + kstep, voffB); PG8_STAGE(PG8_SA(1, 0), cA + kstep, voffA); PG8_STAGE(PG8_SB(1, 1), cB + hstep + kstep, voffB);
        PG8_WAIT_V(6); PG8_BAR;
    }
    for (;;) {
        const bool has_next = S.next(ui + 1, nxt);
        const char* nA = has_next ? (const char*)g.A + (size_t)nxt.pm * tstep + (size_t)nxt.ko * 2 : cA; const char* nB = has_next ? (const char*)g.Bt + (size_t)nxt.pn * tstep + (size_t)nxt.ko * 2 : cB;
        for (int t = 0; t < nt; t += 2) {
            const bool last = (t == nt - 2);
            const char* a1 = cA + (size_t)(t + 1) * kstep;
            const char* a2 = last ? nA : cA + (size_t)(t + 2) * kstep; const char* b2 = last ? nB : cB + (size_t)(t + 2) * kstep;
            const char* a3 = a2 + kstep; const char* b3 = b2 + kstep;
            if (last && has_next) S.a_ready(nxt);
            if constexpr (SP2) {
            PG8_LDB(B0, 0, 0); PG8_LDB(B1, 0, 1); PG8_SCHED; PG8_LDA(At, 0, 0); PG8_STAGE(PG8_SA(1, 1), a1 + hstep, voffA);
            PG8_WAIT_V(8); PG8_WAIT_L(0); PG8_BAR; PG8_MMA(0, 0, At, B0); PG8_MMA(0, 1, At, B1); PG8_BAR; PG8_SCHED;
            PG8_LDA(At, 0, 1); PG8_STAGE(PG8_SB(0, 0), b2, voffB); PG8_STAGE(PG8_SB(0, 1), b2 + hstep, voffB); PG8_STAGE(PG8_SA(0, 0), a2, voffA);
            PG8_WAIT_V(8); PG8_WAIT_L(0); PG8_BAR; PG8_MMA(1, 0, At, B0); PG8_MMA(1, 1, At, B1); PG8_BAR; PG8_SCHED;
            PG8_LDB(B0, 1, 0); PG8_LDB(B1, 1, 1); PG8_SCHED; PG8_LDA(At, 1, 0); PG8_STAGE(PG8_SA(0, 1), a2 + hstep, voffA);
            PG8_WAIT_V(8); PG8_WAIT_L(0); PG8_BAR; PG8_MMA(0, 0, At, B0); PG8_MMA(0, 1, At, B1); PG8_BAR; PG8_SCHED;
            PG8_LDA(At, 1, 1); PG8_STAGE(PG8_SB(1, 0), b3, voffB); PG8_STAGE(PG8_SB(1, 1), b3 + hstep, voffB); PG8_STAGE(PG8_SA(1, 0), a3, voffA);
            PG8_WAIT_V(8); PG8_WAIT_L(0); PG8_BAR; PG8_MMA(1, 0, At, B0); PG8_MMA(1, 1, At, B1); PG8_BAR; PG8_SCHED;
            } else {
            PG8_LDB(B0, 0, 0); PG8_SCHED; PG8_LDA(At, 0, 0); PG8_STAGE(PG8_SA(1, 1), a1 + hstep, voffA);
            PG8_WAIT_L(8); PG8_BAR; PG8_WAIT_L(0); PG8_MMA(0, 0, At, B0); PG8_BAR; PG8_SCHED;
            PG8_LDB(B1, 0, 1); PG8_STAGE(PG8_SB(0, 0), b2, voffB);
            PG8_BAR; PG8_WAIT_L(0); PG8_MMA(0, 1, At, B1); PG8_BAR;
            PG8_LDA(At, 0, 1); PG8_STAGE(PG8_SA(0, 0), a2, voffA);
            PG8_BAR; PG8_WAIT_L(0); PG8_MMA(1, 0, At, B0); PG8_BAR; PG8_SCHED;
            PG8_STAGE(PG8_SB(0, 1), b2 + hstep, voffB);
            PG8_WAIT_V(6); PG8_BAR; PG8_MMA(1, 1, At, B1); PG8_BAR;
            PG8_LDB(B0, 1, 0); PG8_SCHED; PG8_LDA(At, 1, 0); PG8_STAGE(PG8_SA(0, 1), a2 + hstep, voffA);
            PG8_WAIT_L(8); PG8_BAR; PG8_WAIT_L(0); PG8_MMA(0, 0, At, B0); PG8_BAR; PG8_SCHED;
            PG8_LDB(B1, 1, 1); PG8_STAGE(PG8_SB(1, 0), b3, voffB);
            PG8_BAR; PG8_WAIT_L(0); PG8_MMA(0, 1, At, B1); PG8_BAR;
            PG8_LDA(At, 1, 1); PG8_STAGE(PG8_SA(1, 0), a3, voffA);
            PG8_BAR; PG8_WAIT_L(0); PG8_MMA(1, 0, At, B0); PG8_BAR; PG8_SCHED;
            PG8_STAGE(PG8_SB(1, 1), b3 + hstep, voffB);
            PG8_WAIT_V(6); PG8_BAR; PG8_MMA(1, 1, At, B1); PG8_BAR;
            }
        }
        if constexpr (ALIGN_EPI) { if (wr == 0) PG8_BAR; }
        if constexpr (!Epi::AFTER_DRAIN) { E(acc, cur, wr, wc, fr, fq); S.done(cur); }
        if (!has_next) break;
#pragma unroll
        for (int a = 0; a < 2; ++a)
#pragma unroll
            for (int b = 0; b < 2; ++b)
#pragma unroll
                for (int m = 0; m < 4; ++m)
#pragma unroll
                    for (int n = 0; n < 2; ++n) acc[a][b][m][n] = (f32x4){0.f, 0.f, 0.f, 0.f};
        cur = nxt; cA = nA; cB = nB; ++ui;
        if constexpr (ALIGN_EPI) { if (wr == 1) PG8_BAR; }
    }
    PG8_WAIT_V(0);
    if constexpr (!ALIGN_EPI) { if (wr == 0) PG8_BAR; }
    PG8_BAR;
    if constexpr (Epi::AFTER_DRAIN) { E.fused(acc, cur, wr, wc, fr, fq, lds, wid, lane); S.done(cur); }
#undef PG8_SA
#undef PG8_SB
#undef PG8_STAGE
#undef PG8_LDA
#undef PG8_LDB
#undef PG8_MMA
#undef PG8_WAIT_V
#undef PG8_WAIT_L
#undef PG8_BAR
#undef PG8_SCHED
}
}
#define GAS __attribute__((address_space(1)))
#define LAS __attribute__((address_space(3)))
typedef unsigned short bf16;
typedef unsigned v4u __attribute__((ext_vector_type(4)));
typedef float f32x4 __attribute__((ext_vector_type(4)));
typedef short bf16x8 __attribute__((ext_vector_type(8)));
typedef GAS unsigned gu32;
typedef GAS unsigned long long gu64;
#define RLX_AGENT __ATOMIC_RELAXED, __HIP_MEMORY_SCOPE_AGENT
#define LDS_WAIT() asm volatile("s_waitcnt lgkmcnt(0)" ::: "memory")
#define VM_WAIT() asm volatile("s_waitcnt vmcnt(0)" ::: "memory")
__device__ __forceinline__ unsigned long long rt() { return __builtin_amdgcn_s_memrealtime(); }
__device__ __forceinline__ unsigned f2bf(float f) { unsigned u = __builtin_bit_cast(unsigned, f); return (u + 0x7fffu + ((u >> 16) & 1u)) >> 16; }
__device__ __forceinline__ unsigned pk2(float lo, float hi) { return f2bf(lo) | (f2bf(hi) << 16); }

#define XB_TMO      128
#define XB_XCNT(j)  (256  + 64 * (j))
#define XB_XSUB(j)  (1280 + 64 * (j))
#define XB_XGEN(j)  (2304 + 64 * (j))
#define XB_TOP      3328
#define XB_TOPGEN   3392
#define XCD_BAR_WORDS 3456
#define XB_SPIN_CAP (1u << 24)

__device__ __forceinline__ unsigned xb_ld(unsigned* p)              { return __hip_atomic_load(p, __ATOMIC_RELAXED, __HIP_MEMORY_SCOPE_AGENT); }
__device__ __forceinline__ unsigned xb_add(unsigned* p, unsigned v) { return __hip_atomic_fetch_add(p, v, __ATOMIC_RELAXED, __HIP_MEMORY_SCOPE_AGENT); }
__device__ __forceinline__ unsigned xb_xcc_id() { return (unsigned)__builtin_amdgcn_s_getreg((3 << 11) | 20) & 0xFu; }
#define XB_SPIN(cond, bar) do { unsigned _sp = 0; while (cond) { __builtin_amdgcn_s_sleep(1); \
    if ((++_sp & 255u) == 0u) { if (xb_ld(&(bar)[XB_TMO])) break; if (_sp > XB_SPIN_CAP) { atomicAdd(&(bar)[XB_TMO], 1u); break; } } } } while (0)

struct XcdBarrier {
    unsigned* bar; unsigned x;
    volatile LAS unsigned* st;
};

__device__ __forceinline__ XcdBarrier xcd_barrier_post(unsigned* bar, volatile LAS unsigned* st) {
    XcdBarrier b; b.bar = bar; b.x = xb_xcc_id(); b.st = st;
    if (threadIdx.x == 0) (void)xb_add(&bar[XB_XCNT(b.x)], 1u);
    return b;
}
__device__ __forceinline__ void xcd_barrier_complete(unsigned* bar, unsigned x, unsigned& nloc, unsigned& nx) {
    const unsigned G = gridDim.x * gridDim.y * gridDim.z;
    unsigned sum, cnt, mine, sp = 0u;
    for (;;) {
        sum = 0u; cnt = 0u; mine = 0u;
#pragma unroll
        for (unsigned j = 0; j < 16; ++j) { const unsigned c = xb_ld(&bar[XB_XCNT(j)]); sum += c; cnt += (c > 0u) ? 1u : 0u; mine = (j == x) ? c : mine; }
        if (sum == G) break;
        __builtin_amdgcn_s_sleep(1);
        if ((++sp & 255u) == 0u) { if (xb_ld(&bar[XB_TMO])) break; if (sp > XB_SPIN_CAP) { atomicAdd(&bar[XB_TMO], 1u); break; } }
    }
    nloc = mine > 0u ? mine : 1u; nx = cnt > 0u ? cnt : 1u;
}

__device__ __forceinline__ void xcd_barrier(const XcdBarrier& b) {
    asm volatile("s_waitcnt vmcnt(0)" ::: "memory");
    __syncthreads();
    if (threadIdx.x == 0) {
        unsigned* bar = b.bar;
        __builtin_amdgcn_s_waitcnt(0);
        unsigned nloc = b.st[0], nx = b.st[1];
        if (nloc == 0u) { xcd_barrier_complete(bar, b.x, nloc, nx); b.st[0] = nloc; b.st[1] = nx; }
        const unsigned old = xb_add(&bar[XB_XSUB(b.x)], 1u);
        const unsigned gen = old / nloc;
        if (old + 1u == (gen + 1u) * nloc) {
            __builtin_amdgcn_fence(__ATOMIC_RELEASE, "agent");
            asm volatile("s_waitcnt vmcnt(0)" ::: "memory");
            const unsigned og = xb_add(&bar[XB_TOP], 1u);
            const unsigned tg = og / nx;
            if (og + 1u == (tg + 1u) * nx) xb_add(&bar[XB_TOPGEN], 1u);
            else XB_SPIN(xb_ld(&bar[XB_TOPGEN]) == tg, bar);
            __builtin_amdgcn_fence(__ATOMIC_ACQUIRE, "agent");
            xb_add(&bar[XB_XGEN(b.x)], 1u);
            asm volatile("s_waitcnt vmcnt(0)" ::: "memory");
        } else {
            XB_SPIN(xb_ld(&bar[XB_XGEN(b.x)]) == gen, bar);
            __builtin_amdgcn_fence(__ATOMIC_ACQUIRE, "agent");
            asm volatile("s_waitcnt vmcnt(0)" ::: "memory");
        }
    }
    __syncthreads();
}

constexpr int NWAVES = 8;
constexpr int BATCH = 4, SEQ = 2048, DM = 4096, M = BATCH * SEQ;
constexpr int HD = 128, NHA = 16, NKV = 4, GRP = 4, NHB = 16;
constexpr int CIN = 15408, NP = 15616;
constexpr int LDP = NP;
constexpr int C_QA = 0, C_ZA = 2048, C_KC = 4096, C_VC = 4608, C_KSL = 5120, C_VSL = 5632, C_KW = 6144, C_VW = 6656,
              C_QB = 7168, C_KB = 9216, C_VB = 11264, C_ZB = 13312, C_GA = 15360;
constexpr int NCMP = 127, NSEL = 32, TOPN = 16;
constexpr float EPS = 1e-6f;
constexpr float QSCALE = 0.08838834764831845f;

constexpr size_t MiB = 1u << 20;
constexpr size_t WS_CTL = 0, CTL_ZERO_BYTES = 1 * MiB;
constexpr size_t WS_WIN = 2 * MiB;
constexpr size_t WS_WOUT = 124 * MiB;
constexpr size_t WS_HB = 160 * MiB;
constexpr size_t WS_P = 224 * MiB;
constexpr size_t WS_QR = 468 * MiB;
constexpr size_t WS_COS = 500 * MiB;
constexpr size_t WS_SIN = 502 * MiB;
constexpr size_t WS_MIX = 504 * MiB;
constexpr size_t WS_Y = 568 * MiB;
constexpr size_t WS_KCMP = 696 * MiB;
constexpr size_t WS_VCMP = 697 * MiB;
constexpr size_t WS_BIAS1 = 698 * MiB;
constexpr size_t WS_SEL = 699 * MiB;
constexpr size_t WS_OC = 704 * MiB;
constexpr size_t WS_OS = 768 * MiB;
constexpr size_t WS_XKV = 832 * MiB;
constexpr size_t WS_WLR = 848 * MiB;
constexpr size_t WS_KCB = 852 * MiB;
constexpr size_t WS_VCB = 853 * MiB;
constexpr size_t WS_LR = WS_Y;
constexpr size_t WS_END = 854 * MiB;
constexpr int CW_BAR = 4096;

constexpr int RING_OFF = 0, RING_BYTES = 131072;
constexpr int LDSCTL_OFF = RING_BYTES, MISC_OFF = LDSCTL_OFF + 320;
constexpr int LDS_BYTES = 147456;

__device__ __forceinline__ float bf2f(unsigned short u) { return __builtin_bit_cast(float, (unsigned)u << 16); }
__device__ __forceinline__ float wave_sum(float v) {
#pragma unroll
    for (int o = 1; o < 64; o <<= 1) v += __shfl_xor(v, o);
    return v;
}
__device__ __forceinline__ float wave_max(float v) {
#pragma unroll
    for (int o = 1; o < 64; o <<= 1) v = fmaxf(v, __shfl_xor(v, o));
    return v;
}

struct Args {
    const float* x; const int* pos; const float* pre_w; const float* post_w; const float* w_in; const float* b_gate;
    const float* pe_k; const float* pe_v; const float* wk1; const float* wk2; const float* wv1; const float* wv2; const float* w_out;
    float* out; unsigned char* ws; int ph_lo, ph_hi;
};

struct Ctx {
    LAS unsigned char* lds; int tid, lane, wave, G, bid, gw, NGW;
};

__host__ __device__ __forceinline__ int rope_phi(int d) { const int dd = d & 63; return 32 * (dd >> 4) + 8 * ((dd >> 2) & 3) + 4 * (d >> 6) + (dd & 3); }
__device__ __forceinline__ void transpose_item(const float* W, int ldw, int K, int k0, int c0, int ncols, bf16* WT, int r0, LAS float* scr, int lane, bool perm = false) {
#pragma unroll 8
    for (int i = 0; i < 32; ++i) { const int kk = 2 * i + (lane >> 5), n = lane & 31; scr[kk * 33 + n] = (n < ncols) ? W[(size_t)(k0 + kk) * ldw + c0 + n] : 0.f; }
    LDS_WAIT(); asm volatile("" ::: "memory");
    const int c = lane & 7;
#pragma unroll
    for (int j = 0; j < 4; ++j) { const int n = (lane >> 3) + 8 * j; const LAS float* s = scr + (8 * c) * 33 + n;
        v4u o; o.x = pk2(s[0 * 33], s[1 * 33]); o.y = pk2(s[2 * 33], s[3 * 33]); o.z = pk2(s[4 * 33], s[5 * 33]); o.w = pk2(s[6 * 33], s[7 * 33]);
        const int drow = perm ? (r0 & ~127) + rope_phi((r0 & 127) + n) : r0 + n;
        if (n < ncols) *(GAS v4u*)(WT + (size_t)drow * K + k0 + 8 * c) = o; }
    LDS_WAIT(); asm volatile("" ::: "memory");
}

__device__ __forceinline__ void p0_transposes(const Args& a, const Ctx& c, int it0, int it1, int widx, int nw) {
    unsigned char* ws = a.ws;
    bf16* WinT = (bf16*)(ws + WS_WIN); bf16* WoutT = (bf16*)(ws + WS_WOUT);
    LAS float* scr = (LAS float*)(c.lds + RING_OFF + c.wave * 16384);
    constexpr int NB_IN = 482, I_IN = 64 * NB_IN, I_OUT = 64 * 128, I_LR = 4 * 32 * 8, I_ALL = I_IN + I_OUT + I_LR;
    bf16* WLR = (bf16*)(ws + WS_WLR);
    struct TItem { const float* src; bf16* dst; int ldw, K, ncols; bool perm; int r0; };
    auto decode = [&](int it) -> TItem {
        TItem t;
        if (it < I_IN) {
            const int kb = it / NB_IN, nb = it % NB_IN; int c0, r0, nc = 32;
            if (nb < 128) { c0 = nb * 32; r0 = nb * 32; }
            else if (nb < 224) { c0 = 4144 + (nb - 128) * 32; r0 = 4096 + (nb - 128) * 32; }
            else if (nb < 480) { c0 = 7216 + (nb - 224) * 32; r0 = 7168 + (nb - 224) * 32; }
            else { c0 = 4096 + (nb - 480) * 32; r0 = C_GA + (nb - 480) * 32; nc = (nb == 480) ? 32 : 16; }
            t.perm = (r0 < 2048) || (r0 >= C_KSL && r0 < C_VSL) || (r0 >= C_KW && r0 < C_VW) || (r0 >= C_QB && r0 < C_VB);
            t.src = a.w_in + (size_t)(kb * 64) * CIN + c0; t.ldw = CIN; t.K = DM; t.ncols = nc; t.dst = WinT + kb * 64; t.r0 = r0;
        } else if (it < I_IN + I_OUT) {
            const int r = it - I_IN, kb = r / 128, nb = r % 128;
            t.perm = false; t.src = a.w_out + (size_t)(kb * 64) * DM + nb * 32; t.ldw = DM; t.K = DM; t.ncols = 32; t.dst = WoutT + kb * 64; t.r0 = nb * 32;
        } else {
            const int r = it - I_IN - I_OUT, part = r >> 8, kb = (r >> 3) & 31, nb = r & 7;
            t.perm = false; t.src = ((part >> 1) ? a.wv1 : a.wk1) + (size_t)((part & 1) * 2048 + kb * 64) * 256 + nb * 32; t.ldw = 256; t.K = 2048; t.ncols = 32;
            t.dst = WLR + kb * 64; t.r0 = part * 256 + nb * 32;
        }
        return t;
    };
    {
        const int kr = c.lane >> 3, nq = (c.lane & 7) * 4;
        f32x4 v[8];
        int it = it0 + widx; bool have = it < it1; TItem cur{};
        if (have) { cur = decode(it);
#pragma unroll
            for (int i = 0; i < 8; ++i) v[i] = (nq < cur.ncols) ? __builtin_nontemporal_load((const GAS f32x4*)(cur.src + (size_t)(8 * i + kr) * cur.ldw + nq)) : (f32x4){0.f, 0.f, 0.f, 0.f}; }
        while (have) {
#pragma unroll
            for (int i = 0; i < 8; ++i) { LAS float* d = scr + (8 * i + kr) * 33 + nq; d[0] = v[i].x; d[1] = v[i].y; d[2] = v[i].z; d[3] = v[i].w; }
            const int nit = it + nw; const bool hn = nit < it1; TItem nx{};
            if (hn) { nx = decode(nit);
#pragma unroll
                for (int i = 0; i < 8; ++i) v[i] = (nq < nx.ncols) ? __builtin_nontemporal_load((const GAS f32x4*)(nx.src + (size_t)(8 * i + kr) * nx.ldw + nq)) : (f32x4){0.f, 0.f, 0.f, 0.f}; }
            LDS_WAIT(); asm volatile("" ::: "memory");
            const int cc = c.lane & 7;
#pragma unroll
            for (int j = 0; j < 4; ++j) { const int n = (c.lane >> 3) + 8 * j; const LAS float* sp = scr + (8 * cc) * 33 + n;
                v4u o; o.x = pk2(sp[0 * 33], sp[1 * 33]); o.y = pk2(sp[2 * 33], sp[3 * 33]); o.z = pk2(sp[4 * 33], sp[5 * 33]); o.w = pk2(sp[6 * 33], sp[7 * 33]);
                const int drow = cur.perm ? (cur.r0 & ~127) + rope_phi((cur.r0 & 127) + n) : cur.r0 + n;
                if (n < cur.ncols) *(GAS v4u*)(cur.dst + (size_t)drow * cur.K + 8 * cc) = o; }
            LDS_WAIT(); asm volatile("" ::: "memory");
            it = nit; have = hn; cur = nx;
        }
    }
}
constexpr int TI_IN = 64 * 482, TI_ALL = TI_IN + 64 * 128 + 4 * 32 * 8;

__device__ __forceinline__ void p0_prologue(const Args& a, const Ctx& c) {
    unsigned char* ws = a.ws;
    bf16* WinT = (bf16*)(ws + WS_WIN); bf16* HB = (bf16*)(ws + WS_HB);
    p0_transposes(a, c, 0, TI_IN, c.gw, c.NGW);
    for (int e = c.gw * 64 + c.lane; e < (NP - CIN) * (DM / 8); e += c.NGW * 64)
        *(GAS v4u*)(WinT + (size_t)CIN * DM + (size_t)e * 8) = (v4u){0u, 0u, 0u, 0u};
    for (int m = c.gw; m < M; m += c.NGW) {
        const GAS f32x4* xr = (const GAS f32x4*)(a.x + (size_t)m * DM) + c.lane;
        f32x4 v[16]; float s = 0.f;
#pragma unroll
        for (int j = 0; j < 16; ++j) { v[j] = __builtin_nontemporal_load(xr + 64 * j); s += (v[j].x * v[j].x + v[j].y * v[j].y) + (v[j].z * v[j].z + v[j].w * v[j].w); }
        const float rstd = 1.0f / sqrtf(wave_sum(s) * (1.0f / DM) + EPS);
        GAS unsigned long long* o8 = (GAS unsigned long long*)(HB + (size_t)m * DM) + c.lane;
#pragma unroll
        for (int j = 0; j < 16; ++j) { const f32x4 w = ((const GAS f32x4*)a.pre_w)[c.lane + 64 * j];
            o8[64 * j] = (unsigned long long)pk2(v[j].x * rstd * w.x, v[j].y * rstd * w.y) | ((unsigned long long)pk2(v[j].z * rstd * w.z, v[j].w * rstd * w.w) << 32); }
    }
    {
        float* COS = (float*)(ws + WS_COS); float* SIN = (float*)(ws + WS_SIN);
        for (int e = c.gw * 64 + c.lane; e < M * 64; e += c.NGW * 64) {
            const int m = e >> 6, i = e & 63;
            double inv = 1.0; for (int k = 0; k < i; ++k) inv *= 0.8659643233600653;
            const double ang = (double)a.pos[m] * inv;
            const double TWO_PI = 6.283185307179586476925286766559;
            const double n = __builtin_rint(ang / TWO_PI);
            const double r = ang - n * TWO_PI;
            const double r2 = r * r;
            double sn = 0.0, cs = 0.0;
            double ts = r, tc = 1.0;
#pragma unroll
            for (int k = 0; k < 14; ++k) { sn += ts; cs += tc; ts *= -r2 / (double)((2 * k + 2) * (2 * k + 3)); tc *= -r2 / (double)((2 * k + 1) * (2 * k + 2)); }
            COS[e] = (float)cs; SIN[e] = (float)sn;
        }
    }
    {
        float* BP = (float*)(ws + WS_BIAS1);
        for (int o = c.NGW - 1 - c.gw; o < 128; o += c.NGW) {
            const int kv = o >> 6, ch = o & 63; const float* pe = (kv ? a.pe_v : a.pe_k) + ch * 64; const float* w1 = (kv ? a.wv1 : a.wk1) + (size_t)ch * 64 * 256;
            float s0 = 0.f, s1 = 0.f, s2 = 0.f, s3 = 0.f;
#pragma unroll 16
            for (int i = 0; i < 64; ++i) { const float p = pe[i]; const float* wr = w1 + i * 256 + c.lane; s0 += p * wr[0]; s1 += p * wr[64]; s2 += p * wr[128]; s3 += p * wr[192]; }
            float* d = BP + (size_t)o * 256 + c.lane; d[0] = s0; d[64] = s1; d[128] = s2; d[192] = s3;
        }
    }
}

__device__ __forceinline__ float gelu_tanh(float x) {
    const float u = 0.7978845608028654f * (x + 0.044715f * x * x * x);
    const float e = __expf(2.0f * u);
    const float th = 1.0f - 2.0f / (e + 1.0f);
    return 0.5f * x * (1.0f + th);
}

__device__ __forceinline__ void p2c_stage2(const Args& a, const Ctx& c) {
    unsigned char* ws = a.ws;
    const float* LR = (const float*)(ws + WS_LR); const float* B1 = (const float*)(ws + WS_BIAS1);
    LAS float* Gs = (LAS float*)(c.lds + RING_OFF);
    bf16* KCB = (bf16*)(ws + WS_KCB); bf16* VCB = (bf16*)(ws + WS_VCB);
    for (int e = c.gw * 64 + c.lane; e < 2 * 16 * 128; e += c.NGW * 64) { bf16* dst = (e >> 11) ? VCB : KCB; dst[(size_t)((e >> 7) & 15) * 128 * 128 + 127 * 128 + (e & 127)] = 0; }
    for (int it = c.bid; it < 2 * 127; it += c.G) {
        const int kv = it / 127, rb = it % 127;
        const float* w2 = kv ? a.wv2 : a.wk2;
        float* OUT = (float*)(ws + (kv ? WS_VCMP : WS_KCMP)); bf16* OUTB = kv ? VCB : KCB;
        const int n = c.tid & 255, half = c.tid >> 8;
        float b1 = 0.f;
#pragma unroll 16
        for (int ch = 0; ch < 64; ++ch) b1 += B1[(size_t)(kv * 64 + ch) * 256 + n];
        __syncthreads();
#pragma unroll
        for (int r = 0; r < 8; ++r) { const int R = rb * 16 + half * 8 + r, bh = R / 127, cc = R % 127; const size_t rowL = (size_t)kv * 2048 + bh * 128 + cc;
            float h = b1;
#pragma unroll
            for (int ks = 0; ks < 8; ++ks) { const float* p = LR + (size_t)ks * 4096 * 1024 + rowL * 1024 + kv * 512 + n; h += p[0] + p[1024 + 256]; }
            Gs[(half * 8 + r) * 256 + n] = gelu_tanh(h); }
        __syncthreads();
        const int d = c.tid & 127, rq = c.tid >> 7;
        float o[4] = {0.f, 0.f, 0.f, 0.f};
#pragma unroll 16
        for (int nn = 0; nn < 256; ++nn) { const float w = w2[nn * 128 + d];
#pragma unroll
            for (int r = 0; r < 4; ++r) o[r] += Gs[(rq * 4 + r) * 256 + nn] * w; }
#pragma unroll
        for (int r = 0; r < 4; ++r) { const int R = rb * 16 + rq * 4 + r, bh = R / 127, cc = R % 127; const int dd = kv ? d : rope_phi(d);
            OUT[(size_t)(bh * 128 + cc) * 128 + dd] = o[r]; OUTB[(size_t)(bh * 128 + cc) * 128 + dd] = (bf16)f2bf(o[r]); }
    }
}

namespace fa {
typedef short s16x4 __attribute__((ext_vector_type(4)));
typedef float f32x16 __attribute__((ext_vector_type(16)));
typedef unsigned u32x4 __attribute__((ext_vector_type(4)));
constexpr int KVBLK = 64, SHM_K = KVBLK * 128 * 2, SHM_V = SHM_K;
constexpr int BUFS = SHM_V + SHM_K, A_V = 0, A_K = SHM_V, A_WS = 3 * BUFS;
constexpr float SCALE = 0.08838834764831845f, THR = 8.f;
constexpr float C2 = 1.4426950408889634f * SCALE;
constexpr float DBL = 1.0f / C2;
#define FA_KSWZ(row, colB) ((row) * 256 + ((colB) ^ (((row) & 7) << 4)))
#define FA_SBAR() __builtin_amdgcn_sched_barrier(0)
__device__ __forceinline__ int v_st(int k, int c) { const int kk = (k & ~0xC) | ((k & 4) << 1) | ((k & 8) >> 1); return ((kk >> 3) * 4 + (c >> 5)) * 512 + ((kk & 7) * 32 + (c & 31)) * 2; }
__device__ __forceinline__ int v_rd_base(int lane) { return ((lane & 3) << 3) | (((lane >> 2) & 3) << 6) | (((lane >> 4) & 1) << 5) | (((lane >> 5) & 1) << 8); }
constexpr int v_rd_off(int d0, int ks, int half) { return d0 * 512 + ks * 4096 + half * 2048; }
__device__ __forceinline__ int crow(int r, int hi) { return (r & 3) + 8 * (r >> 2) + 4 * hi; }
__device__ __forceinline__ unsigned cvtpk(float lo, float hi) { unsigned r; asm volatile("v_cvt_pk_bf16_f32 %0, %1, %2" : "=v"(r) : "v"(lo), "v"(hi)); return r; }

__device__ __forceinline__ void mask_tile(f32x16& p0, f32x16& p1, int dq, unsigned W) {
    const float NEG = -__builtin_inff();
#pragma unroll
    for (int r = 0; r < 16; ++r) {
        const int c = (r & 3) + 8 * (r >> 2);
        if ((unsigned)(dq - c) >= W) p0[r] = NEG;
        if ((unsigned)(dq - c - 32) >= W) p1[r] = NEG;
    }
}
__device__ __forceinline__ void mask_dil(f32x16& p0, f32x16& p1, int dq) {
    const float NEG = -__builtin_inff();
#pragma unroll
    for (int r = 0; r < 16; ++r) {
        const int c = (r & 3) + 8 * (r >> 2);
        { const int dl = dq - c; const bool nr = (unsigned)dl <= 128u, m4 = dl >= 0 && (dl & 3) == 0; const float v = p0[r];
          p0[r] = nr ? (m4 ? v + DBL : v) : (m4 ? v : NEG); }
        { const int dl = dq - c - 32; const bool nr = (unsigned)dl <= 128u, m4 = dl >= 0 && (dl & 3) == 0; const float v = p1[r];
          p1[r] = nr ? (m4 ? v + DBL : v) : (m4 ? v : NEG); }
    }
}
__device__ __forceinline__ void partialSM(f32x16& p0, f32x16& p1, float& m_reg, float& mn, float& alpha, bool drop) {
    float pmax = p0[0];
#pragma unroll
    for (int r = 1; r < 16; ++r) pmax = fmaxf(pmax, p0[r]);
#pragma unroll
    for (int r = 0; r < 16; ++r) pmax = fmaxf(pmax, p1[r]);
    { auto rr = __builtin_amdgcn_permlane32_swap(__float_as_uint(pmax), __float_as_uint(pmax), false, false);
      pmax = fmaxf(__uint_as_float(rr[0]), __uint_as_float(rr[1])); }
    if (drop) pmax = -__builtin_inff();
    if (__builtin_expect(__all((pmax - m_reg) * SCALE <= THR), 1)) { mn = m_reg; alpha = 1.f; }
    else { mn = fmaxf(m_reg, pmax); alpha = __builtin_amdgcn_exp2f((m_reg - mn) * C2); m_reg = mn; }
    const float mnL = drop ? -__builtin_inff() : -mn * C2;
#pragma unroll
    for (int r = 0; r < 16; ++r) p0[r] = fmaf(p0[r], C2, mnL);
#pragma unroll
    for (int r = 0; r < 16; ++r) p1[r] = fmaf(p1[r], C2, mnL);
#pragma unroll
    for (int r = 0; r < 16; ++r) p0[r] = __builtin_amdgcn_exp2f(p0[r]);
}
__device__ __forceinline__ void finishSM(f32x16& p0, f32x16& p1, float alpha, float& l_reg, bf16x8& pa0, bf16x8& pa1, bf16x8& pa2, bf16x8& pa3) {
#pragma unroll
    for (int r = 0; r < 16; ++r) p1[r] = __builtin_amdgcn_exp2f(p1[r]);
    float ps = 0;
#pragma unroll
    for (int r = 0; r < 16; ++r) ps += p0[r];
#pragma unroll
    for (int r = 0; r < 16; ++r) ps += p1[r];
    { auto rr = __builtin_amdgcn_permlane32_swap(__float_as_uint(ps), __float_as_uint(ps), false, false);
      ps = __uint_as_float(rr[0]) + __uint_as_float(rr[1]); }
    l_reg = l_reg * alpha + ps;
#define FA_PK4(P, B_, OUT) do { unsigned a0 = cvtpk(P[B_+0], P[B_+1]), a1 = cvtpk(P[B_+2], P[B_+3]);                          \
        unsigned b0 = cvtpk(P[B_+4], P[B_+5]), b1 = cvtpk(P[B_+6], P[B_+7]);                                             \
        auto r0 = __builtin_amdgcn_permlane32_swap(a0, b0, false, false); auto r1 = __builtin_amdgcn_permlane32_swap(a1, b1, false, false); \
        u32x4 w = {r0[0], r1[0], r0[1], r1[1]}; OUT = __builtin_bit_cast(bf16x8, w); } while (0)
    FA_PK4(p0, 0, pa0); FA_PK4(p0, 8, pa1); FA_PK4(p1, 0, pa2); FA_PK4(p1, 8, pa3);
#undef FA_PK4
}
__device__ __forceinline__ void pack_p(const f32x16& p0, const f32x16& p1, bf16x8& pa0, bf16x8& pa1, bf16x8& pa2, bf16x8& pa3) {
#define FA_PK4(P, B_, OUT) do { unsigned a0 = cvtpk(P[B_+0], P[B_+1]), a1 = cvtpk(P[B_+2], P[B_+3]);                          \
        unsigned b0 = cvtpk(P[B_+4], P[B_+5]), b1 = cvtpk(P[B_+6], P[B_+7]);                                             \
        auto r0 = __builtin_amdgcn_permlane32_swap(a0, b0, false, false); auto r1 = __builtin_amdgcn_permlane32_swap(a1, b1, false, false); \
        u32x4 w = {r0[0], r1[0], r0[1], r1[1]}; OUT = __builtin_bit_cast(bf16x8, w); } while (0)
    FA_PK4(p0, 0, pa0); FA_PK4(p0, 8, pa1); FA_PK4(p1, 0, pa2); FA_PK4(p1, 8, pa3);
#undef FA_PK4
}
template <int KB>
__device__ __forceinline__ void qkt(f32x16& p0, f32x16& p1, const LAS char* K_lds, int r32, int hi, const bf16x8 (&qr)[8]) {
#pragma unroll
    for (int r = 0; r < 16; ++r) { p0[r] = 0.f; p1[r] = 0.f; }
    const LAS char* kb[4];
#pragma unroll
    for (int dd = 0; dd < 4; ++dd) kb[dd] = K_lds + KB * BUFS + FA_KSWZ(r32, (dd * 16 + hi * 8) * 2);
#pragma unroll
    for (int d0 = 0; d0 < 8; ++d0) { const LAS char* a = kb[d0 & 3] + (d0 >> 2) * 128;
        const bf16x8 b0 = *(const LAS bf16x8*)a;
        const bf16x8 b1 = *(const LAS bf16x8*)(a + 32 * 256);
        p0 = __builtin_amdgcn_mfma_f32_32x32x16_bf16(b0, qr[d0], p0, 0, 0, 0);
        p1 = __builtin_amdgcn_mfma_f32_32x32x16_bf16(b1, qr[d0], p1, 0, 0, 0); }
}
template <int VB>
__device__ __forceinline__ void pv_tile(f32x16 (&o)[4], int vb0, bf16x8 pa0, bf16x8 pa1, bf16x8 pa2, bf16x8 pa3) {
#define FA_TRRD(dst, off) asm volatile("ds_read_b64_tr_b16 %0, %1 offset:%2" : "=&v"(dst) : "v"(vb0), "i"(off) : "memory")
#define FA_PV_D0(d0) do { s16x4 l0, l1, l2, l3, h0, h1, h2, h3; constexpr int b_ = A_V + VB * BUFS + v_rd_off(d0, 0, 0); \
        FA_TRRD(l0, b_); FA_TRRD(h0, b_ + 2048); FA_TRRD(l1, b_ + 4096); FA_TRRD(h1, b_ + 6144); FA_TRRD(l2, b_ + 8192); FA_TRRD(h2, b_ + 10240); FA_TRRD(l3, b_ + 12288); FA_TRRD(h3, b_ + 14336); \
        asm volatile("s_waitcnt lgkmcnt(0)" ::: "memory"); FA_SBAR(); \
        o[d0] = __builtin_amdgcn_mfma_f32_32x32x16_bf16(pa0, (bf16x8){l0[0], l0[1], l0[2], l0[3], h0[0], h0[1], h0[2], h0[3]}, o[d0], 0, 0, 0);   \
        o[d0] = __builtin_amdgcn_mfma_f32_32x32x16_bf16(pa1, (bf16x8){l1[0], l1[1], l1[2], l1[3], h1[0], h1[1], h1[2], h1[3]}, o[d0], 0, 0, 0);   \
        o[d0] = __builtin_amdgcn_mfma_f32_32x32x16_bf16(pa2, (bf16x8){l2[0], l2[1], l2[2], l2[3], h2[0], h2[1], h2[2], h2[3]}, o[d0], 0, 0, 0);   \
        o[d0] = __builtin_amdgcn_mfma_f32_32x32x16_bf16(pa3, (bf16x8){l3[0], l3[1], l3[2], l3[3], h3[0], h3[1], h3[2], h3[3]}, o[d0], 0, 0, 0); } while (0)
    FA_PV_D0(0); FA_PV_D0(1); FA_PV_D0(2); FA_PV_D0(3);
#undef FA_PV_D0
#undef FA_TRRD
}

__device__ __forceinline__ void mask_half(f32x16& p, int dq, unsigned W) {
    const float NEG = -__builtin_inff();
#pragma unroll
    for (int r = 0; r < 16; ++r) { const int c = (r & 3) + 8 * (r >> 2); if ((unsigned)(dq - c) >= W) p[r] = NEG; }
}
__device__ __forceinline__ void mask_dil_half(f32x16& p, int dq) {
    const float NEG = -__builtin_inff();
#pragma unroll
    for (int r = 0; r < 16; ++r) { const int c = (r & 3) + 8 * (r >> 2); const int dl = dq - c; const bool nr = (unsigned)dl <= 128u, m4 = dl >= 0 && (dl & 3) == 0; const float v = p[r];
        p[r] = nr ? (m4 ? v + DBL : v) : (m4 ? v : NEG); }
}
template <int KB, int H>
__device__ __forceinline__ void qk_half(f32x16& p, const LAS char* K_lds, int r32, int hi, const bf16x8 (&qr)[8]) {
#pragma unroll
    for (int r = 0; r < 16; ++r) p[r] = 0.f;
    const LAS char* kb[4];
#pragma unroll
    for (int dd = 0; dd < 4; ++dd) kb[dd] = K_lds + KB * BUFS + H * 32 * 256 + FA_KSWZ(r32, (dd * 16 + hi * 8) * 2);
#pragma unroll
    for (int d0 = 0; d0 < 8; ++d0) { const bf16x8 b0 = *(const LAS bf16x8*)(kb[d0 & 3] + (d0 >> 2) * 128); p = __builtin_amdgcn_mfma_f32_32x32x16_bf16(b0, qr[d0], p, 0, 0, 0); }
}
template <int KB, int H>
__device__ __forceinline__ void k_reads(const LAS char* K_lds, int r32, int hi, bf16x8 (&kf)[8]) {
    const unsigned a0 = (unsigned)(uintptr_t)(K_lds + KB * BUFS + FA_KSWZ(r32, (0 * 16 + hi * 8) * 2)), a1 = (unsigned)(uintptr_t)(K_lds + KB * BUFS + FA_KSWZ(r32, (1 * 16 + hi * 8) * 2)),
                   a2 = (unsigned)(uintptr_t)(K_lds + KB * BUFS + FA_KSWZ(r32, (2 * 16 + hi * 8) * 2)), a3 = (unsigned)(uintptr_t)(K_lds + KB * BUFS + FA_KSWZ(r32, (3 * 16 + hi * 8) * 2));
#define FA_KRD(dst, ad, off) asm volatile("ds_read_b128 %0, %1 offset:%2" : "=&v"(dst) : "v"(ad), "i"(off) : "memory")
    FA_KRD(kf[0], a0, H * 8192); FA_KRD(kf[1], a1, H * 8192); FA_KRD(kf[2], a2, H * 8192); FA_KRD(kf[3], a3, H * 8192);
    FA_KRD(kf[4], a0, H * 8192 + 128); FA_KRD(kf[5], a1, H * 8192 + 128); FA_KRD(kf[6], a2, H * 8192 + 128); FA_KRD(kf[7], a3, H * 8192 + 128);
#undef FA_KRD
}
__device__ __forceinline__ void qk_mma(f32x16& p, const bf16x8 (&kf)[8], const bf16x8 (&qr)[8]) {
#pragma unroll
    for (int r = 0; r < 16; ++r) p[r] = 0.f;
#pragma unroll
    for (int d0 = 0; d0 < 8; ++d0) p = __builtin_amdgcn_mfma_f32_32x32x16_bf16(kf[d0], qr[d0], p, 0, 0, 0);
}
__device__ __forceinline__ float sm_max(const f32x16& p, float& m_reg, bool drop, float& mnL) {
    float pmax = p[0];
#pragma unroll
    for (int r = 1; r < 16; ++r) pmax = fmaxf(pmax, p[r]);
    { auto rr = __builtin_amdgcn_permlane32_swap(__float_as_uint(pmax), __float_as_uint(pmax), false, false); pmax = fmaxf(__uint_as_float(rr[0]), __uint_as_float(rr[1])); }
    if (drop) pmax = -__builtin_inff();
    const bool keep = __all((pmax - m_reg) * SCALE <= THR);
    const float mn = keep ? m_reg : fmaxf(m_reg, pmax);
    const float alpha = __builtin_amdgcn_exp2f((m_reg - mn) * C2);
    m_reg = mn; mnL = drop ? -__builtin_inff() : -mn * C2;
    return alpha;
}
__device__ __forceinline__ void sm_exp(f32x16& p, float mnL, float alpha, float& l_reg, bf16x8& paA, bf16x8& paB) {
    float ps = 0.f;
#pragma unroll
    for (int r = 0; r < 16; ++r) { p[r] = __builtin_amdgcn_exp2f(fmaf(p[r], C2, mnL)); ps += p[r]; }
    { auto rr = __builtin_amdgcn_permlane32_swap(__float_as_uint(ps), __float_as_uint(ps), false, false); ps = __uint_as_float(rr[0]) + __uint_as_float(rr[1]); }
    l_reg = l_reg * alpha + ps;
#define FA_PK4(P, B_, OUT) do { unsigned a0 = cvtpk(P[B_+0], P[B_+1]), a1 = cvtpk(P[B_+2], P[B_+3]);                          \
        unsigned b0 = cvtpk(P[B_+4], P[B_+5]), b1 = cvtpk(P[B_+6], P[B_+7]);                                             \
        auto r0 = __builtin_amdgcn_permlane32_swap(a0, b0, false, false); auto r1 = __builtin_amdgcn_permlane32_swap(a1, b1, false, false); \
        u32x4 w = {r0[0], r1[0], r0[1], r1[1]}; OUT = __builtin_bit_cast(bf16x8, w); } while (0)
    FA_PK4(p, 0, paA); FA_PK4(p, 8, paB);
#undef FA_PK4
}
template <int VB, int H, int D0A = 0, int D0B = 4>
__device__ __forceinline__ void pv_reads(int vb0, s16x4 (&vl)[8], s16x4 (&vh)[8]) {
    const int vbb = vb0 + VB * BUFS;
#define FA_TRRD(dst, off) asm volatile("ds_read_b64_tr_b16 %0, %1 offset:%2" : "=&v"(dst) : "v"(vbb), "i"(off) : "memory")
#define FA_RD_D0(d0) do { constexpr int b_ = A_V + v_rd_off(d0, 2 * H, 0); \
        FA_TRRD(vl[2 * d0], b_); FA_TRRD(vh[2 * d0], b_ + 2048); FA_TRRD(vl[2 * d0 + 1], b_ + 4096); FA_TRRD(vh[2 * d0 + 1], b_ + 6144); } while (0)
    if constexpr (D0A <= 0 && 0 < D0B) FA_RD_D0(0); if constexpr (D0A <= 1 && 1 < D0B) FA_RD_D0(1); if constexpr (D0A <= 2 && 2 < D0B) FA_RD_D0(2); if constexpr (D0A <= 3 && 3 < D0B) FA_RD_D0(3);
#undef FA_RD_D0
#undef FA_TRRD
}
__device__ __forceinline__ void pv_mma(f32x16 (&o)[4], const s16x4 (&vl)[8], const s16x4 (&vh)[8], bf16x8 paA, bf16x8 paB) {
#pragma unroll
    for (int d0 = 0; d0 < 4; ++d0) {
        o[d0] = __builtin_amdgcn_mfma_f32_32x32x16_bf16(paA, (bf16x8){vl[2 * d0][0], vl[2 * d0][1], vl[2 * d0][2], vl[2 * d0][3], vh[2 * d0][0], vh[2 * d0][1], vh[2 * d0][2], vh[2 * d0][3]}, o[d0], 0, 0, 0);
        o[d0] = __builtin_amdgcn_mfma_f32_32x32x16_bf16(paB, (bf16x8){vl[2 * d0 + 1][0], vl[2 * d0 + 1][1], vl[2 * d0 + 1][2], vl[2 * d0 + 1][3], vh[2 * d0 + 1][0], vh[2 * d0 + 1][1], vh[2 * d0 + 1][2], vh[2 * d0 + 1][3]}, o[d0], 0, 0, 0); }
}

struct St { float m, l; f32x16 o[4]; };
__device__ __forceinline__ void st_init(St& S) { S.m = -1e30f; S.l = 0.f;
#pragma unroll
    for (int d = 0; d < 4; ++d)
#pragma unroll
        for (int r = 0; r < 16; ++r) S.o[d][r] = 0.f; }

struct MaskWin { int qlo, qm;
    __device__ __forceinline__ bool act(int t) const { const int kb = t * 64; return kb <= qlo + 31 && kb + 63 >= qlo - 511; }
    __device__ __forceinline__ void apply(f32x16& p0, f32x16& p1, int t) const { const int kb = t * 64; if (kb + 63 > qlo || kb <= qlo + 31 - 512) mask_tile(p0, p1, qm - kb, 512u); }
    __device__ __forceinline__ bool needs_mask(int t) const { const int kb = t * 64; return kb + 63 > qlo || kb <= qlo + 31 - 512; }
    __device__ __forceinline__ void apply_half(f32x16& p, int t, int H) const { mask_half(p, qm - t * 64 - 32 * H, 512u); }
    __device__ __forceinline__ bool drop(int) const { return false; } };
struct MaskSel { int qlo, qm; unsigned selw;
    __device__ __forceinline__ bool act(int t) const { return t * 64 <= qlo + 31; }
    __device__ __forceinline__ void apply(f32x16& p0, f32x16& p1, int t) const { const int kb = t * 64; if (kb + 63 > qlo) mask_tile(p0, p1, qm - kb, 0x40000000u); }
    __device__ __forceinline__ bool needs_mask(int t) const { return t * 64 + 63 > qlo; }
    __device__ __forceinline__ void apply_half(f32x16& p, int t, int H) const { mask_half(p, qm - t * 64 - 32 * H, 0x40000000u); }
    __device__ __forceinline__ bool drop(int t) const { return ((selw >> t) & 1u) == 0u; } };
struct MaskDilA { int plo, pm;
    __device__ __forceinline__ bool act(int t) const { return t * 64 <= plo + 31; }
    __device__ __forceinline__ void apply(f32x16& p0, f32x16& p1, int t) const { mask_dil(p0, p1, pm - t * 64); }
    __device__ __forceinline__ bool needs_mask(int) const { return true; }
    __device__ __forceinline__ void apply_half(f32x16& p, int t, int H) const { mask_dil_half(p, pm - t * 64 - 32 * H); }
    __device__ __forceinline__ bool drop(int) const { return false; } };
struct MaskDilB { int tlo, tm;
    __device__ __forceinline__ bool act(int t) const { const int kb = t * 64; return kb <= tlo + 124 && kb + 63 >= tlo - 128; }
    __device__ __forceinline__ void apply(f32x16& p0, f32x16& p1, int t) const { mask_tile(p0, p1, tm - t * 64, 129u); }
    __device__ __forceinline__ bool needs_mask(int) const { return true; }
    __device__ __forceinline__ void apply_half(f32x16& p, int t, int H) const { mask_half(p, tm - t * 64 - 32 * H, 129u); }
    __device__ __forceinline__ bool drop(int) const { return false; } };

template <class MK>
__device__ __forceinline__ void attn_pass(St& S, const bf16x8 (&qr)[8], const bf16* Kg, const bf16* Vg, int pitch, int t0, int t1, LAS char* lds, const MK& mk, int tid, int wid, int lane) {
    if (t0 >= t1) return;
    const int r32 = lane & 31, hi = lane >> 5;
    LAS char* K_lds = lds + A_K;
    LAS float* al_l = (LAS float*)(lds + A_WS) + wid * 64 + 32;
    const int vb0 = (int)(unsigned)(uintptr_t)lds + v_rd_base(lane);
    unsigned kso[2], vso[2];
#pragma unroll
    for (int j = 0; j < 2; ++j) { const int ch = 2 * wid + j;
        const int row = ch * 4 + (lane >> 4), chunk = (lane & 15) ^ (row & 7); kso[j] = (unsigned)(row * pitch + chunk * 8);
        const int sub = ch * 2 + (lane >> 5), kk = (sub >> 2) * 8 + ((lane & 31) >> 2), key = (kk & ~0xC) | ((kk & 4) << 1) | ((kk & 8) >> 1), col = (sub & 3) * 32 + (lane & 3) * 8;
        vso[j] = (unsigned)(key * pitch + col); }
    const unsigned ldsw = (unsigned)wid * 2048u;
#define FA_DMA(t, bf) do { const bf16* kt_ = Kg + (size_t)((t) * 64) * pitch; const bf16* vt_ = Vg + (size_t)((t) * 64) * pitch; \
        _Pragma("unroll") for (int j_ = 0; j_ < 2; ++j_) { \
            __builtin_amdgcn_global_load_lds((const GAS unsigned*)(kt_ + kso[j_]), (LAS unsigned*)(lds + (bf) * BUFS + A_K + ldsw + j_ * 1024), 16, 0, 0); \
            __builtin_amdgcn_global_load_lds((const GAS unsigned*)(vt_ + vso[j_]), (LAS unsigned*)(lds + (bf) * BUFS + A_V + ldsw + j_ * 1024), 16, 0, 0); } } while (0)
#define FA_BAR() do { asm volatile("s_waitcnt lgkmcnt(0)" ::: "memory"); __builtin_amdgcn_s_barrier(); asm volatile("" ::: "memory"); } while (0)
#define FA_RESC(al_) do { if (__any((al_) < 1.f)) { if (hi == 0) al_l[r32] = (al_); asm volatile("s_waitcnt lgkmcnt(0)" ::: "memory"); \
            _Pragma("unroll") for (int d_ = 0; d_ < 4; ++d_) _Pragma("unroll") for (int r = 0; r < 16; ++r) S.o[d_][r] *= al_l[crow(r, hi)]; \
            asm volatile("s_waitcnt lgkmcnt(0)" ::: "memory"); } } while (0)
#define FA_LWAIT() do { asm volatile("s_waitcnt lgkmcnt(0)" ::: "memory"); FA_SBAR(); } while (0)
#define FA_BODY(t, B) do { f32x16 p0, p1; bf16x8 pa0, pa1, pa2, pa3; float mnL0, mnL1; const bool dr_ = mk.drop(t), nm_ = mk.needs_mask(t); \
            { bf16x8 kfa[8], kfb[8]; k_reads<B, 0>(K_lds, r32, hi, kfa); FA_LWAIT(); \
              k_reads<B, 1>(K_lds, r32, hi, kfb); qk_mma(p0, kfa, qr); FA_LWAIT(); \
              if (nm_) mk.apply_half(p0, (t), 0); \
              s16x4 vl[8], vh[8]; pv_reads<B, 0>(vb0, vl, vh); \
              qk_mma(p1, kfb, qr); const float al0 = sm_max(p0, S.m, dr_, mnL0); sm_exp(p0, mnL0, al0, S.l, pa0, pa1); \
              FA_LWAIT(); FA_RESC(al0); FA_SBAR(); \
              if (nm_) mk.apply_half(p1, (t), 1); \
              pv_mma(S.o, vl, vh, pa0, pa1); const float al1 = sm_max(p1, S.m, dr_, mnL1); sm_exp(p1, mnL1, al1, S.l, pa2, pa3); \
              FA_SBAR(); FA_RESC(al1); \
              pv_reads<B, 1>(vb0, vl, vh); FA_LWAIT(); \
              pv_mma(S.o, vl, vh, pa2, pa3); } } while (0)
#define FA_STEP(t, B) do { const bool more2_ = (t) + 2 < t1; \
        if (more2_) FA_DMA((t) + 2, ((B) + 2) % 3); \
        if (mk.act(t)) { FA_BODY(t, B); } \
        if (more2_) asm volatile("s_waitcnt vmcnt(4)" ::: "memory"); else asm volatile("s_waitcnt vmcnt(0)" ::: "memory"); \
        FA_BAR(); } while (0)
    FA_DMA(t0, 0);
    if (t0 + 1 < t1) { FA_DMA(t0 + 1, 1); asm volatile("s_waitcnt vmcnt(4)" ::: "memory"); } else asm volatile("s_waitcnt vmcnt(0)" ::: "memory");
    FA_BAR();
    for (int t = t0; t < t1; t += 3) {
        FA_STEP(t, 0);
        if (t + 1 < t1) FA_STEP(t + 1, 1);
        if (t + 2 < t1) FA_STEP(t + 2, 2);
    }
#undef FA_STEP
#undef FA_BODY
#undef FA_LWAIT
#undef FA_RESC
#undef FA_BAR
#undef FA_DMA
}
__device__ __forceinline__ void row_factors(float f, float (&rli)[16], LAS char* lds, int wid, int r32, int hi) {
    LAS float* li_l = (LAS float*)(lds + A_WS) + wid * 64;
    if (hi == 0) li_l[r32] = f;
    asm volatile("s_waitcnt lgkmcnt(0)" ::: "memory");
#pragma unroll
    for (int r = 0; r < 16; ++r) rli[r] = li_l[crow(r, hi)];
    asm volatile("s_waitcnt lgkmcnt(0)" ::: "memory");
}
template <int HALF>
__device__ __forceinline__ void stage_half(const f32x16 (&o)[4], const float (&rli)[16], LAS float* st, int r32, int hi, int lane, f32x4 (&lo)[4], f32x4 (&hh)[4]) {
    asm volatile("s_waitcnt lgkmcnt(0)" ::: "memory");
#pragma unroll
    for (int r = 0; r < 16; ++r) { const int row = crow(r, hi); st[row * 64 + r32] = o[2 * HALF][r] * rli[r]; st[row * 64 + 32 + r32] = o[2 * HALF + 1][r] * rli[r]; }
    asm volatile("s_waitcnt lgkmcnt(0)" ::: "memory");
#pragma unroll
    for (int q = 0; q < 4; ++q) { const int idx = q * 64 + lane; const LAS float* p = st + (idx >> 3) * 64 + 8 * (idx & 7); lo[q] = *(const LAS f32x4*)p; hh[q] = *(const LAS f32x4*)(p + 4); }
    asm volatile("s_waitcnt lgkmcnt(0)" ::: "memory");
}
__device__ __forceinline__ float bflo(unsigned w) { return __builtin_bit_cast(float, w << 16); }
__device__ __forceinline__ float bfhi(unsigned w) { return __builtin_bit_cast(float, w & 0xffff0000u); }
__device__ __forceinline__ float silu_mul(float v, float z) { return v * z / (1.0f + __expf(-z)); }
}

__device__ __forceinline__ float sigm(float x) { return 1.0f / (1.0f + __expf(-x)); }

__device__ __forceinline__ void nsa_block(const Args& a, const Ctx& c, int b, int h, int qb) {
    unsigned char* ws = a.ws;
    const bf16* P = (const bf16*)(ws + WS_P); const bf16* QR = (const bf16*)(ws + WS_QR);
    const bf16* OC = (const bf16*)(ws + WS_OC); bf16* OS = (bf16*)(ws + WS_OS); const unsigned* SEL = (const unsigned*)(ws + WS_SEL);
    bf16* MIX = (bf16*)(ws + WS_MIX);
    LAS char* lds = (LAS char*)(c.lds + RING_OFF);
    int lane = c.lane, tid = c.tid; asm volatile("" : "+v"(lane), "+v"(tid));
    const int hk = h >> 2, r32 = lane & 31, hi = lane >> 5;
    const int qlo = qb * 256 + c.wave * 32, t_row = qlo + r32, m0 = b * SEQ + qlo;
    bf16x8 qr[8];
    { const bf16* qb_ = QR + (size_t)m0 * 2048 + h * 128; const unsigned lq = (unsigned)(r32 * 2048 + hi * 8);
#pragma unroll
      for (int d0 = 0; d0 < 8; ++d0) qr[d0] = *(const GAS bf16x8*)(qb_ + lq + d0 * 16); }
    const bf16* Pb = P + (size_t)b * SEQ * LDP;
    const bf16* grow = P + (size_t)m0 * LDP + C_GA + h * 3;

    {
        fa::St S; fa::st_init(S);
        fa::MaskSel mk{qlo, t_row - 4 * hi, (SEL + (b * 4 + hk) * SEQ + qlo)[r32]};
        fa::attn_pass(S, qr, Pb + C_KSL + hk * 128, Pb + C_VSL + hk * 128, LDP, 0, 4 * qb + 4, lds, mk, tid, c.wave, lane);
        const float g1 = sigm(bf2f(grow[(unsigned)(r32 * LDP + 1)]) + a.b_gate[h * 3 + 1]);
        float rli[16]; fa::row_factors(g1 / S.l, rli, lds, c.wave, r32, hi);
        __syncthreads();
        LAS float* st = (LAS float*)lds + c.wave * 2048;
#define SEL_HALF(HF) do { f32x4 lo[4], hh[4]; fa::stage_half<HF>(S.o, rli, st, r32, hi, lane, lo, hh); \
        _Pragma("unroll") for (int q = 0; q < 4; ++q) { const int idx = q * 64 + lane; bf16* ob = OS + (size_t)(m0 + (idx >> 3)) * 2048 + h * 128 + HF * 64 + 8 * (idx & 7); \
            { v4u w_; w_.x = fa::cvtpk(lo[q][0], lo[q][1]); w_.y = fa::cvtpk(lo[q][2], lo[q][3]); w_.z = fa::cvtpk(hh[q][0], hh[q][1]); w_.w = fa::cvtpk(hh[q][2], hh[q][3]); *(GAS v4u*)ob = w_; } } } while (0)
        SEL_HALF(0); SEL_HALF(1);
#undef SEL_HALF
        __syncthreads();
    }
    {
        fa::St S; fa::st_init(S);
        fa::MaskWin mk{qlo, t_row - 4 * hi};
        const int t0 = 4 * qb - 8 > 0 ? 4 * qb - 8 : 0;
        fa::attn_pass(S, qr, Pb + C_KW + hk * 128, Pb + C_VW + hk * 128, LDP, t0, 4 * qb + 4, lds, mk, tid, c.wave, lane);
        const float g2 = sigm(bf2f(grow[(unsigned)(r32 * LDP + 2)]) + a.b_gate[h * 3 + 2]);
        float rli[16]; fa::row_factors(g2 / S.l, rli, lds, c.wave, r32, hi);
        __syncthreads();
        LAS float* st = (LAS float*)lds + c.wave * 2048;
#define WIN_HALF(HF) do { f32x4 lo[4], hh[4]; v4u zz[4], cc_[4], ss_[4]; \
        _Pragma("unroll") for (int q = 0; q < 4; ++q) { const int idx = q * 64 + lane; const size_t mr = (size_t)(m0 + (idx >> 3)); const int gcol = h * 128 + HF * 64 + 8 * (idx & 7); \
            zz[q] = *(const GAS v4u*)(P + mr * LDP + C_ZA + gcol); cc_[q] = *(const GAS v4u*)(OC + mr * 2048 + gcol); ss_[q] = *(const GAS v4u*)(OS + mr * 2048 + gcol); } \
        fa::stage_half<HF>(S.o, rli, st, r32, hi, lane, lo, hh); \
        _Pragma("unroll") for (int q = 0; q < 4; ++q) { const int idx = q * 64 + lane; const size_t mr = (size_t)(m0 + (idx >> 3)); const int gcol = h * 128 + HF * 64 + 8 * (idx & 7); \
            const f32x4 c0 = {fa::bflo(cc_[q].x), fa::bfhi(cc_[q].x), fa::bflo(cc_[q].y), fa::bfhi(cc_[q].y)}, c1 = {fa::bflo(cc_[q].z), fa::bfhi(cc_[q].z), fa::bflo(cc_[q].w), fa::bfhi(cc_[q].w)}; \
            const f32x4 s0 = {fa::bflo(ss_[q].x), fa::bfhi(ss_[q].x), fa::bflo(ss_[q].y), fa::bfhi(ss_[q].y)}, s1 = {fa::bflo(ss_[q].z), fa::bfhi(ss_[q].z), fa::bflo(ss_[q].w), fa::bfhi(ss_[q].w)}; \
            const f32x4 a0 = lo[q] + c0 + s0, a1 = hh[q] + c1 + s1; v4u w; \
            w.x = fa::cvtpk(fa::silu_mul(a0[0], fa::bflo(zz[q].x)), fa::silu_mul(a0[1], fa::bfhi(zz[q].x))); w.y = fa::cvtpk(fa::silu_mul(a0[2], fa::bflo(zz[q].y)), fa::silu_mul(a0[3], fa::bfhi(zz[q].y))); \
            w.z = fa::cvtpk(fa::silu_mul(a1[0], fa::bflo(zz[q].z)), fa::silu_mul(a1[1], fa::bfhi(zz[q].z))); w.w = fa::cvtpk(fa::silu_mul(a1[2], fa::bflo(zz[q].w)), fa::silu_mul(a1[3], fa::bfhi(zz[q].w))); \
            *(GAS v4u*)(MIX + mr * DM + gcol) = w; } } while (0)
        WIN_HALF(0); WIN_HALF(1);
#undef WIN_HALF
        __syncthreads();
    }
}
__device__ __forceinline__ void p4_nsa_mfma(const Args& a, const Ctx& c) {
    for (int it = c.bid; it < 256; it += c.G) {
        const int x = it & 7, y = it >> 3, grp = 2 * x + (y >> 4), idx = y & 15;
        const int b = grp >> 2, hk = grp & 3, g = idx >> 2, pr = idx & 3, h = hk * 4 + g;
        nsa_block(a, c, b, h, pr);
        nsa_block(a, c, b, h, 7 - pr);
    }
}

__device__ __forceinline__ void dil_block(const Args& a, const Ctx& c, int b, int h, int r4, int pb) {
    unsigned char* ws = a.ws;
    const bf16* P = (const bf16*)(ws + WS_P); bf16* MIX = (bf16*)(ws + WS_MIX);
    LAS char* lds = (LAS char*)(c.lds + RING_OFF);
    int lane = c.lane, tid = c.tid; asm volatile("" : "+v"(lane), "+v"(tid));
    const int r32 = lane & 31, hi = lane >> 5;
    const int plo = pb * 256 + c.wave * 32, p_row = plo + r32, tok = 4 * p_row + r4, mrow0 = b * SEQ + 4 * plo + r4;
    bf16x8 qr[8];
    { const bf16* qb_ = P + (size_t)mrow0 * LDP + C_QB + h * 128; const unsigned lq = (unsigned)(r32 * 4 * LDP + hi * 8);
#pragma unroll
      for (int d0 = 0; d0 < 8; ++d0) qr[d0] = *(const GAS bf16x8*)(qb_ + lq + d0 * 16); }
    const bf16* Pb = P + (size_t)b * SEQ * LDP;
    fa::St S; fa::st_init(S);
    {   fa::MaskDilA mk{plo, p_row - 4 * hi};
        fa::attn_pass(S, qr, Pb + (size_t)r4 * LDP + C_KB + h * 128, Pb + (size_t)r4 * LDP + C_VB + h * 128, 4 * LDP, 0, 4 * pb + 4, lds, mk, tid, c.wave, lane); }
    {   const int tmin = 1024 * pb + r4, tmax = 1024 * pb + 1020 + r4;
        const int t0 = tmin - 128 > 0 ? (tmin - 128) >> 6 : 0, t1 = (tmax >> 6) + 1;
        fa::MaskDilB mk{4 * plo + r4, tok - 4 * hi};
        fa::attn_pass(S, qr, Pb + C_KB + h * 128, Pb + C_VB + h * 128, LDP, t0, t1, lds, mk, tid, c.wave, lane); }
    float rli[16]; fa::row_factors(1.0f / S.l, rli, lds, c.wave, r32, hi);
    __syncthreads();
    LAS float* st = (LAS float*)lds + c.wave * 2048;
#define DIL_HALF(HF) do { f32x4 lo[4], hh[4]; v4u zz[4]; \
        _Pragma("unroll") for (int q = 0; q < 4; ++q) { const int idx = q * 64 + lane; const size_t mr = (size_t)(mrow0 + 4 * (idx >> 3)); const int gcol = h * 128 + HF * 64 + 8 * (idx & 7); \
            zz[q] = *(const GAS v4u*)(P + mr * LDP + C_ZB + gcol); } \
        fa::stage_half<HF>(S.o, rli, st, r32, hi, lane, lo, hh); \
        _Pragma("unroll") for (int q = 0; q < 4; ++q) { const int idx = q * 64 + lane; const size_t mr = (size_t)(mrow0 + 4 * (idx >> 3)); const int gcol = h * 128 + HF * 64 + 8 * (idx & 7); \
            const f32x4 a0 = lo[q], a1 = hh[q]; v4u w; \
            w.x = fa::cvtpk(fa::silu_mul(a0[0], fa::bflo(zz[q].x)), fa::silu_mul(a0[1], fa::bfhi(zz[q].x))); w.y = fa::cvtpk(fa::silu_mul(a0[2], fa::bflo(zz[q].y)), fa::silu_mul(a0[3], fa::bfhi(zz[q].y))); \
            w.z = fa::cvtpk(fa::silu_mul(a1[0], fa::bflo(zz[q].z)), fa::silu_mul(a1[1], fa::bfhi(zz[q].z))); w.w = fa::cvtpk(fa::silu_mul(a1[2], fa::bflo(zz[q].w)), fa::silu_mul(a1[3], fa::bfhi(zz[q].w))); \
            *(GAS v4u*)(MIX + mr * DM + 2048 + gcol) = w; } } while (0)
    DIL_HALF(0); DIL_HALF(1);
#undef DIL_HALF
    __syncthreads();
}
__device__ __forceinline__ void p4_dil_mfma(const Args& a, const Ctx& c) {
    for (int it = c.bid; it < 256; it += c.G) {
        const int x = it & 7, y = it >> 3, bh = 8 * x + (y >> 2), r4 = y & 3, b = bh >> 4, h = bh & 15;
        dil_block(a, c, b, h, r4, 0);
        dil_block(a, c, b, h, r4, 1);
    }
}

__device__ __forceinline__ void cmp_item(const Args& a, const Ctx& c, int b, int hk, int tb) {
    unsigned char* ws = a.ws;
    const bf16* P = (const bf16*)(ws + WS_P); const bf16* KCB = (const bf16*)(ws + WS_KCB); const bf16* VCB = (const bf16*)(ws + WS_VCB);
    bf16* OC = (bf16*)(ws + WS_OC); unsigned* SEL = (unsigned*)(ws + WS_SEL);
    LAS char* lds = (LAS char*)(c.lds + RING_OFF);
    LAS float* imps = (LAS float*)(lds + 2 * fa::BUFS);
    int lane = c.lane, tid = c.tid; asm volatile("" : "+v"(lane), "+v"(tid));
    const int r32 = lane & 31, hi = lane >> 5, g = c.wave >> 1, h = hk * 4 + g, bh = b * 4 + hk;
    const int tl0 = 32 * (c.wave & 1), tw0 = 64 * tb + tl0, t = tw0 + r32, m0 = b * SEQ + tw0;
    const int nt = tb >= 16 ? 2 : 1;
    LAS char* V_lds = lds + fa::A_V; LAS char* K_lds = lds + fa::A_K;
    {   const int sr = tid >> 4, sc = (tid & 15) * 8; const int kws = FA_KSWZ(sr, sc * 2), vst0 = fa::v_st(sr, sc), vst1 = fa::v_st(32 + sr, sc);
        const bf16* Kg = KCB + (size_t)bh * 128 * 128; const bf16* Vg = VCB + (size_t)bh * 128 * 128; const unsigned lo = (unsigned)(sr * 128 + sc);
        for (int tt = 0; tt < nt; ++tt) {
            const bf16x8 k0 = *(const GAS bf16x8*)(Kg + tt * 8192 + lo), k1 = *(const GAS bf16x8*)(Kg + tt * 8192 + 4096 + lo);
            const bf16x8 v0 = *(const GAS bf16x8*)(Vg + tt * 8192 + lo), v1 = *(const GAS bf16x8*)(Vg + tt * 8192 + 4096 + lo);
            *(LAS bf16x8*)(K_lds + tt * fa::BUFS + kws) = k0; *(LAS bf16x8*)(K_lds + tt * fa::BUFS + kws + 32 * 256) = k1;
            *(LAS bf16x8*)(V_lds + tt * fa::BUFS + vst0) = v0; *(LAS bf16x8*)(V_lds + tt * fa::BUFS + vst1) = v1; } }
    bf16x8 qr[8];
    { const bf16* qb_ = P + (size_t)m0 * LDP + C_QA + h * 128; const unsigned lq = (unsigned)(r32 * LDP + hi * 8);
#pragma unroll
      for (int d0 = 0; d0 < 8; ++d0) qr[d0] = *(const GAS bf16x8*)(qb_ + lq + d0 * 16); }
    __syncthreads();
    const float NEG = -__builtin_inff();
    fa::f32x16 p0, p1, p2, p3;
    fa::qkt<0>(p0, p1, K_lds, r32, hi, qr);
    const int cmax = (t - 31) >> 4;
    fa::mask_tile(p0, p1, cmax - 4 * hi, 0x40000000u);
    if (nt == 2) { fa::qkt<1>(p2, p3, K_lds, r32, hi, qr); fa::mask_tile(p2, p3, cmax - 4 * hi - 64, 0x40000000u); }
    else {
#pragma unroll
        for (int r = 0; r < 16; ++r) { p2[r] = NEG; p3[r] = NEG; } }
    float mx = p0[0];
#pragma unroll
    for (int r = 0; r < 16; ++r) mx = fmaxf(fmaxf(mx, p0[r]), fmaxf(p1[r], fmaxf(p2[r], p3[r])));
    { auto rr = __builtin_amdgcn_permlane32_swap(__float_as_uint(mx), __float_as_uint(mx), false, false); mx = fmaxf(__uint_as_float(rr[0]), __uint_as_float(rr[1])); }
    const float mL = (mx == NEG) ? 0.f : -mx * fa::C2;
    float l = 0.f;
#pragma unroll
    for (int r = 0; r < 16; ++r) { p0[r] = __builtin_amdgcn_exp2f(fmaf(p0[r], fa::C2, mL)); p1[r] = __builtin_amdgcn_exp2f(fmaf(p1[r], fa::C2, mL));
        p2[r] = __builtin_amdgcn_exp2f(fmaf(p2[r], fa::C2, mL)); p3[r] = __builtin_amdgcn_exp2f(fmaf(p3[r], fa::C2, mL)); l += (p0[r] + p1[r]) + (p2[r] + p3[r]); }
    { auto rr = __builtin_amdgcn_permlane32_swap(__float_as_uint(l), __float_as_uint(l), false, false); l = __uint_as_float(rr[0]) + __uint_as_float(rr[1]); }
    const float inv = l > 0.f ? 1.0f / l : 0.f;
    {   fa::f32x16 o[4];
#pragma unroll
        for (int d = 0; d < 4; ++d)
#pragma unroll
            for (int r = 0; r < 16; ++r) o[d][r] = 0.f;
        const int vb0 = (int)(unsigned)(uintptr_t)lds + fa::v_rd_base(lane);
        bf16x8 pa0, pa1, pa2, pa3;
        fa::pack_p(p0, p1, pa0, pa1, pa2, pa3); FA_SBAR(); fa::pv_tile<0>(o, vb0, pa0, pa1, pa2, pa3);
        if (nt == 2) { fa::pack_p(p2, p3, pa0, pa1, pa2, pa3); FA_SBAR(); fa::pv_tile<1>(o, vb0, pa0, pa1, pa2, pa3); }
        float own[16], last[16];
#pragma unroll
        for (int k = 0; k < 16; ++k) { const int q = k & 3; const fa::f32x16& px = (k >> 2) == 0 ? p0 : (k >> 2) == 1 ? p1 : (k >> 2) == 2 ? p2 : p3;
            own[k] = ((px[4 * q] + px[4 * q + 1]) + (px[4 * q + 2] + px[4 * q + 3])) * inv; last[k] = px[4 * q + 3] * inv; }
        LAS float* dst = imps + ((g * 64 + tl0 + r32) * 32 + hi);
#pragma unroll
        for (int k = 0; k < 16; ++k) { const float x = __shfl_xor(last[k], 32); const float xp = (k > 0) ? __shfl_xor(last[k > 0 ? k - 1 : 0], 32) : 0.f;
            dst[2 * k] = own[k] + (hi ? x : xp); }
        const float g0 = sigm(bf2f((P + (size_t)m0 * LDP + C_GA + h * 3)[(unsigned)(r32 * LDP)]) + a.b_gate[h * 3]);
        float rli[16]; fa::row_factors(inv * g0, rli, lds, c.wave, r32, hi);
        __syncthreads();
        LAS float* st = (LAS float*)lds + c.wave * 2048;
#define CMP_HALF(HF) do { f32x4 lo[4], hh[4]; fa::stage_half<HF>(o, rli, st, r32, hi, lane, lo, hh); \
        _Pragma("unroll") for (int q = 0; q < 4; ++q) { const int idx = q * 64 + lane; bf16* ob = OC + (size_t)(m0 + (idx >> 3)) * 2048 + h * 128 + HF * 64 + 8 * (idx & 7); \
            { v4u w_; w_.x = fa::cvtpk(lo[q][0], lo[q][1]); w_.y = fa::cvtpk(lo[q][2], lo[q][3]); w_.z = fa::cvtpk(hh[q][0], hh[q][1]); w_.w = fa::cvtpk(hh[q][2], hh[q][3]); *(GAS v4u*)ob = w_; } } } while (0)
        CMP_HALF(0); CMP_HALF(1);
#undef CMP_HALF
    }
#pragma unroll 1
    for (int tt = 0; tt < 4; ++tt) {
        const int tl = c.wave * 8 + tt * 2 + hi, j = r32, tq = 64 * tb + tl, cur = tq >> 6;
        float imp = (imps[(0 * 64 + tl) * 32 + j] + imps[(1 * 64 + tl) * 32 + j]) + (imps[(2 * 64 + tl) * 32 + j] + imps[(3 * 64 + tl) * 32 + j]);
        const bool forced = (j == 0) || (j == cur) || (j == cur - 1);
        float v = forced ? imp + 1e4f : imp;
        if (j > cur) v = NEG;
        int rank = 0;
        for (int jj = 0; jj < 32; ++jj) { const float vo = __shfl(v, (lane & 32) + jj); rank += (vo > v || (vo == v && jj < j)) ? 1 : 0; }
        const bool sel = (rank < TOPN) && (j <= cur);
        const unsigned long long bal = __ballot(sel);
        if (r32 == 0) SEL[bh * SEQ + tq] = (unsigned)(bal >> (32 * hi));
    }
    __syncthreads();
}
__device__ __forceinline__ void p3_cmp_mfma(const Args& a, const Ctx& c) {
    for (int it = c.bid; it < 512; it += c.G) {
        const int bh = (it >> 5) & 15, tb = (it & 31) ^ ((it >> 8) ? 31 : 0);
        cmp_item(a, c, bh >> 2, bh & 3, tb);
    }
}

__device__ __forceinline__ void p6_final(const Args& a, const Ctx& c) {
    const bf16* Y = (const bf16*)(a.ws + WS_Y);
    for (int m = c.gw; m < M; m += c.NGW) {
        const GAS v4u* yr = (const GAS v4u*)(Y + (size_t)m * DM) + c.lane;
        v4u yv[8]; float s = 0.f;
#pragma unroll
        for (int j = 0; j < 8; ++j) yv[j] = yr[64 * j];
        const GAS f32x4* xr = (const GAS f32x4*)(a.x + (size_t)m * DM) + 2 * c.lane;
        GAS f32x4* orow = (GAS f32x4*)(a.out + (size_t)m * DM) + 2 * c.lane;
#pragma unroll
        for (int j = 0; j < 8; ++j) { const float y0 = fa::bflo(yv[j].x), y1 = fa::bfhi(yv[j].x), y2 = fa::bflo(yv[j].y), y3 = fa::bfhi(yv[j].y),
                                                  y4 = fa::bflo(yv[j].z), y5 = fa::bfhi(yv[j].z), y6 = fa::bflo(yv[j].w), y7 = fa::bfhi(yv[j].w);
            s += ((y0 * y0 + y1 * y1) + (y2 * y2 + y3 * y3)) + ((y4 * y4 + y5 * y5) + (y6 * y6 + y7 * y7)); }
        const float rstd = 1.0f / sqrtf(wave_sum(s) * (1.0f / DM) + EPS);
#pragma unroll
        for (int j = 0; j < 8; ++j) {
            const f32x4 w0 = ((const GAS f32x4*)a.post_w)[2 * c.lane + 128 * j], w1 = ((const GAS f32x4*)a.post_w)[2 * c.lane + 128 * j + 1];
            const f32x4 x0 = xr[128 * j], x1 = xr[128 * j + 1];
            const f32x4 ya = {fa::bflo(yv[j].x), fa::bfhi(yv[j].x), fa::bflo(yv[j].y), fa::bfhi(yv[j].y)}, yb = {fa::bflo(yv[j].z), fa::bfhi(yv[j].z), fa::bflo(yv[j].w), fa::bfhi(yv[j].w)};
            orow[128 * j] = x0 + ya * rstd * w0; orow[128 * j + 1] = x1 + yb * rstd * w1; }
    }
}


#ifndef MK_SPLIT
#define MK_SPLIT 0
#endif
constexpr int NPHASE = 8;

__global__ void __launch_bounds__(NWAVES * 64, 2) fwd_kernel(Args args) {
    extern __shared__ __attribute__((aligned(16))) unsigned char lds_raw[];
    Ctx c;
    c.lds = (LAS unsigned char*)lds_raw;
    c.tid = threadIdx.x; c.lane = c.tid & 63; c.wave = __builtin_amdgcn_readfirstlane(c.tid >> 6);
    c.G = gridDim.x; c.bid = blockIdx.x; c.gw = c.bid * NWAVES + c.wave; c.NGW = c.G * NWAVES;
    unsigned char* ws = args.ws;
    gu32* ctl = (gu32*)(ws + WS_CTL);
    volatile LAS unsigned* MISC = (volatile LAS unsigned*)(c.lds + MISC_OFF);
    for (int u = c.tid; u < (LDS_BYTES - LDSCTL_OFF) / 4; u += NWAVES * 64) ((LAS unsigned*)(c.lds + LDSCTL_OFF))[u] = 0u;
    __syncthreads();
    XcdBarrier bar; bar.bar = (unsigned*)(ctl + CW_BAR); bar.x = 0; bar.st = nullptr;
    if (!MK_SPLIT) bar = xcd_barrier_post((unsigned*)(ctl + CW_BAR), MISC + 8);
    const int lo = args.ph_lo, hi = args.ph_hi;
#define IN(k) (lo <= (k) && (k) < hi)
#define SEAM(k) do { if (IN(k) && IN((k) + 1)) xcd_barrier(bar); } while (0)

    if (IN(0)) { p0_prologue(args, c); } SEAM(0);
    if (IN(1)) {
        pg8::Gemm g{(const pg8::bf16_t*)(ws + WS_HB), (const pg8::bf16_t*)(ws + WS_WIN), M, NP, DM, DM}; pg8::StaticOrder S; S.init(M, NP, c.G, c.bid);
        pg8::EpiP E{(pg8::bf16_t*)(ws + WS_P), NP, (pg8::bf16_t*)(ws + WS_QR), (pg8::bf16_t*)(ws + WS_XKV), (const float*)(ws + WS_COS), (const float*)(ws + WS_SIN)};
        pg8::gemm_phase<pg8::EpiP, pg8::StaticOrder, true, true>(c.lds + RING_OFF, g, S, E);
        {
            const int rem = ((M / 256) * (NP / 256)) % c.G, nt_ = rem ? c.G - rem : c.G, ti = rem ? c.bid - rem : c.bid;
            if (ti >= 0) p0_transposes(args, c, TI_IN, TI_ALL, ti * NWAVES + c.wave, nt_ * NWAVES);
        }
    } SEAM(1);
    if (IN(2)) {
        pg8::Gemm g{(const pg8::bf16_t*)(ws + WS_XKV), (const pg8::bf16_t*)(ws + WS_WLR), 4096, 1024, 256, 2048}; pg8::CmpOrder S{c.bid, c.G};
        pg8::EpiLR E{(float*)(ws + WS_LR), 1024, (size_t)4096 * 1024};
        pg8::gemm_phase<pg8::EpiLR, pg8::CmpOrder, false, true>(c.lds + RING_OFF, g, S, E);
    } SEAM(2);
    if (IN(3)) { p2c_stage2(args, c); } SEAM(3);
    if (IN(4)) { p3_cmp_mfma(args, c); } SEAM(4);
    if (IN(5)) {
        p4_nsa_mfma(args, c);
        p4_dil_mfma(args, c);
    } SEAM(5);
    if (IN(6)) {
        pg8::Gemm g{(const pg8::bf16_t*)(ws + WS_MIX), (const pg8::bf16_t*)(ws + WS_WOUT), M, DM, DM, DM}; pg8::StaticOrder S; S.init(M, DM, c.G, c.bid);
        pg8::EpiBf16<0> E{(pg8::bf16_t*)(ws + WS_Y), DM, nullptr, 0, 0, 1.f};
        pg8::gemm_phase<pg8::EpiBf16<0>, pg8::StaticOrder, true, true>(c.lds + RING_OFF, g, S, E);
    } SEAM(6);
    if (IN(7)) { p6_final(args, c); }
#undef IN
#undef SEAM
}

extern "C" void kernel_launch(void* const* d_in, const int* in_sizes, int n_in, void* d_out, int out_size, void* d_ws, size_t ws_size, hipStream_t stream) {
    static int grid = 0;
    if (grid == 0) {
        if (n_in != 13 || out_size != M * DM || ws_size < WS_END) { fprintf(stderr, "kernel_launch: unexpected shapes (n_in %d out %d ws %zu)\n", n_in, out_size, ws_size); grid = -1; return; }
        int dev = 0, cus = 0, per_cu = 0;
        if (hipGetDevice(&dev) != hipSuccess || hipDeviceGetAttribute(&cus, hipDeviceAttributeMultiprocessorCount, dev) != hipSuccess) { grid = -1; return; }
        if (hipFuncSetAttribute((const void*)fwd_kernel, hipFuncAttributeMaxDynamicSharedMemorySize, LDS_BYTES) != hipSuccess) { fprintf(stderr, "kernel_launch: hipFuncSetAttribute failed\n"); grid = -1; return; }
        if (hipOccupancyMaxActiveBlocksPerMultiprocessor(&per_cu, (const void*)fwd_kernel, NWAVES * 64, LDS_BYTES) != hipSuccess || per_cu < 1)
            fprintf(stderr, "kernel_launch: occupancy query reports %d\n", per_cu);
        (void)hipGetLastError();
        grid = cus;
    }
    if (grid < 0) return;
    if (hipMemsetAsync((char*)d_ws + WS_CTL, 0, CTL_ZERO_BYTES, stream) != hipSuccess) return;
    Args a{};
    a.x = (const float*)d_in[0]; a.pos = (const int*)d_in[1]; a.pre_w = (const float*)d_in[2]; a.post_w = (const float*)d_in[3];
    a.w_in = (const float*)d_in[4]; a.b_gate = (const float*)d_in[5]; a.pe_k = (const float*)d_in[6]; a.pe_v = (const float*)d_in[7];
    a.wk1 = (const float*)d_in[8]; a.wk2 = (const float*)d_in[9]; a.wv1 = (const float*)d_in[10]; a.wv2 = (const float*)d_in[11]; a.w_out = (const float*)d_in[12];
    a.out = (float*)d_out; a.ws = (unsigned char*)d_ws;
#if MK_SPLIT
    for (int p = 0; p < NPHASE; ++p) { a.ph_lo = p; a.ph_hi = p + 1; hipLaunchKernelGGL(fwd_kernel, dim3(grid), dim3(NWAVES * 64), LDS_BYTES, stream, a); }
#else
    a.ph_lo = 0; a.ph_hi = NPHASE;
    hipLaunchKernelGGL(fwd_kernel, dim3(grid), dim3(NWAVES * 64), LDS_BYTES, stream, a);
#endif
}
```

```cpp
#include <hip/hip_runtime.h>
#include <cstdio>
#include <cstdint>
namespace pg8 {
#define PG8_LAS __attribute__((address_space(3)))
typedef unsigned short bf16_t;
typedef short bf16x8 __attribute__((ext_vector_type(8)));
typedef float f32x4 __attribute__((ext_vector_type(4)));
typedef unsigned u32x4 __attribute__((ext_vector_type(4)));
constexpr int BM = 256, BK = 64, HALF = 128, HTB = HALF * BK * 2  , STAGE_BYTES = 8 * HTB, NXCD = 8, WGM = 8;

__host__ __device__ __forceinline__ int lds_byte(int r, int c) { const int st = (r >> 4) * 2 + (c >> 5), rr = r & 15, cc = c & 31, ob = rr * 64 + cc * 2; return st * 1024 + (ob ^ (((ob >> 9) & 1) << 5)); }
__host__ __device__ __forceinline__ void stage_rc(int b, int& R, int& C) { const int st = b / 1024, sb = b % 1024, swz = sb ^ (((sb >> 9) & 1) << 5); R = (st >> 1) * 16 + swz / 64; C = (st & 1) * 32 + (swz % 64) / 2; }
__host__ __device__ __forceinline__ int perm32(int rho) { const int n = rho >> 4, i = rho & 15; return 8 * (i >> 2) + 4 * n + (i & 3); }

struct Unit { int pm, pn, ko; };
struct Gemm { const bf16_t* A; const bf16_t* Bt; int M, N, K, ld; };

struct StaticOrder {
    int nM, nN, nwg, G, c;
    __host__ __device__ void init(int M, int N, int G_, int c_) { nM = M / BM; nN = N / BM; nwg = nM * nN; G = G_; c = c_; }
    __host__ __device__ bool next(int i, Unit& u) const {
        const long L = (long)i * G + c; if (L >= nwg) return false;
        int wgid = (int)L; { const int q = nwg / NXCD, r = nwg % NXCD, xcd = wgid % NXCD, off = wgid / NXCD; wgid = (xcd < r ? xcd * (q + 1) : r * (q + 1) + (xcd - r) * q) + off; }
        const int nig = WGM * nN, gid = wgid / nig, fm = gid * WGM, gsz = (nM - fm) < WGM ? (nM - fm) : WGM;
        u.pm = fm + ((wgid % nig) % gsz); u.pn = (wgid % nig) / gsz; u.ko = 0; return true;
    }
    __device__ __forceinline__ void a_ready(const Unit&) const {}
    __device__ __forceinline__ void done(const Unit&) const {}
};

__device__ __forceinline__ unsigned cvt_pk_bf16(float lo, float hi) { unsigned r; asm volatile("v_cvt_pk_bf16_f32 %0, %1, %2" : "=v"(r) : "v"(lo), "v"(hi)); return r; }
typedef float f32x2 __attribute__((ext_vector_type(2)));
__device__ __forceinline__ f32x2 gelu_pk(f32x2 v) {
    const f32x2 av = __builtin_elementwise_abs(v), d = av * 0.2316418882f + 1.0f;
    f32x2 t; t.x = __builtin_amdgcn_rcpf(d.x); t.y = __builtin_amdgcn_rcpf(d.y);
    f32x2 q = t * 0.5307027145f + (-0.7265760135f); q = q * t + 0.7107068705f; q = q * t + (-0.142248368f); q = q * t + 0.127414796f; q = q * t;
    const f32x2 s = (v * v) * (-0.72134752044f);
    f32x2 e; e.x = __builtin_amdgcn_exp2f(s.x); e.y = __builtin_amdgcn_exp2f(s.y);
    const f32x2 m = v * (q * e), r = v - m;
    f32x2 o; o.x = v.x < 0.f ? m.x : r.x; o.y = v.y < 0.f ? m.y : r.y; return o;
}

template <int ACT  > struct EpiBf16 {
    static constexpr bool PERM = true, AFTER_DRAIN = false; static_assert(ACT == 0 || ACT == 1, "EpiBf16: ACT is 0 (none) or 1 (gelu_pk)");
    bf16_t* O; int ldc; const float* bias; int split_cols; size_t split_stride; float scale0;
    __device__ __forceinline__ void operator()(const f32x4 (&acc)[2][2][4][2], const Unit& u, int wr, int wc, int fr, int fq) const {
        const int row0 = u.pm * BM + wr * 64 + fr; int colt = u.pn * BM; bf16_t* base = O;
        float sc = 1.f; if (split_cols) { const int t = colt / split_cols; base += (size_t)t * split_stride; colt -= t * split_cols; if (t == 0) sc = scale0; }
        const int col0 = colt + wc * 32 + 8 * fq, bcol0 = u.pn * BM + wc * 32 + 8 * fq;
        f32x4 bv[2][2];
#pragma unroll
        for (int bj = 0; bj < 2; ++bj)
#pragma unroll
            for (int n = 0; n < 2; ++n) bv[bj][n] = bias ? *(const f32x4*)(bias + bcol0 + bj * HALF + 4 * n) : (f32x4){0.f, 0.f, 0.f, 0.f};
#pragma unroll
        for (int ai = 0; ai < 2; ++ai)
#pragma unroll
            for (int m = 0; m < 4; ++m) { bf16_t* rowp = base + (size_t)(row0 + ai * HALF + m * 16) * ldc + col0;
#pragma unroll
                for (int bj = 0; bj < 2; ++bj) { f32x4 v0 = acc[ai][bj][m][0] + bv[bj][0], v1 = acc[ai][bj][m][1] + bv[bj][1];
                    if (ACT == 1) { f32x2 a = gelu_pk((f32x2){v0[0], v0[1]}), b = gelu_pk((f32x2){v0[2], v0[3]}), c = gelu_pk((f32x2){v1[0], v1[1]}), d = gelu_pk((f32x2){v1[2], v1[3]});
                        v0 = (f32x4){a.x, a.y, b.x, b.y}; v1 = (f32x4){c.x, c.y, d.x, d.y}; }
                    v0 = v0 * sc; v1 = v1 * sc; u32x4 w; w.x = cvt_pk_bf16(v0[0], v0[1]); w.y = cvt_pk_bf16(v0[2], v0[3]); w.z = cvt_pk_bf16(v1[0], v1[1]); w.w = cvt_pk_bf16(v1[2], v1[3]);
                    *(u32x4*)(rowp + bj * HALF) = w; } }
    }
};
struct EpiF32 {
    static constexpr bool PERM = false, AFTER_DRAIN = false;
    float* O; int ldc;
    __device__ __forceinline__ void operator()(const f32x4 (&acc)[2][2][4][2], const Unit& u, int wr, int wc, int fr, int fq) const {
        const int row0 = u.pm * BM + wr * 64 + fr, col0 = u.pn * BM + wc * 32 + 4 * fq;
#pragma unroll
        for (int ai = 0; ai < 2; ++ai)
#pragma unroll
            for (int m = 0; m < 4; ++m) { float* rowp = O + (size_t)(row0 + ai * HALF + m * 16) * ldc + col0;
#pragma unroll
                for (int bj = 0; bj < 2; ++bj)
#pragma unroll
                    for (int n = 0; n < 2; ++n) *(f32x4*)(rowp + bj * HALF + n * 16) = acc[ai][bj][m][n]; }
    }
};

struct EpiP {
    static constexpr bool PERM = true, AFTER_DRAIN = false;
    bf16_t* Pm; int ldc; bf16_t* QR; bf16_t* XKV; const float* COS; const float* SIN;
    __device__ __forceinline__ void operator()(const f32x4 (&acc)[2][2][4][2], const Unit& u, int wr, int wc, int fr, int fq) const {
        const int pn = u.pn;
        const bool is_qa = pn < 8, is_rope = is_qa || pn == 20 || pn == 21 || pn == 24 || pn == 25 || (pn >= 28 && pn < 44), is_x = pn >= 16 && pn < 20;
        const int row0 = u.pm * BM + wr * 64 + fr, colw = wc * 32 + 8 * fq;
#pragma unroll
        for (int ai = 0; ai < 2; ++ai)
#pragma unroll
            for (int m = 0; m < 4; ++m) {
                const int row = row0 + ai * HALF + m * 16;
                f32x4 cs = {1.f, 1.f, 1.f, 1.f}, sn = {0.f, 0.f, 0.f, 0.f};
                if (is_rope) { cs = *(const f32x4*)(COS + (size_t)row * 64 + 16 * wc + 4 * fq); sn = *(const f32x4*)(SIN + (size_t)row * 64 + 16 * wc + 4 * fq); }
#pragma unroll
                for (int bj = 0; bj < 2; ++bj) {
                    const f32x4 v0 = acc[ai][bj][m][0], v1 = acc[ai][bj][m][1];
                    u32x4 w;
                    if (!is_rope || is_qa) { w.x = cvt_pk_bf16(v0[0], v0[1]); w.y = cvt_pk_bf16(v0[2], v0[3]); w.z = cvt_pk_bf16(v1[0], v1[1]); w.w = cvt_pk_bf16(v1[2], v1[3]); }
                    if (is_x) { const int hq = (pn - 16) * 2 + bj, kv = hq >> 2, hk = hq & 3, b = row >> 11, tok = row & 2047;
                        *(u32x4*)(XKV + ((size_t)((kv * 16 + b * 4 + hk) * 2048 + tok)) * 128 + colw) = w; }
                    else if (!is_rope) { *(u32x4*)(Pm + (size_t)row * ldc + pn * BM + bj * HALF + colw) = w; }
                    else {
                        if (is_qa) *(u32x4*)(Pm + (size_t)row * ldc + pn * BM + bj * HALF + colw) = w;
                        const f32x4 r0 = v0 * cs - v1 * sn, r1 = v1 * cs + v0 * sn;
                        u32x4 wr_; wr_.x = cvt_pk_bf16(r0[0], r0[1]); wr_.y = cvt_pk_bf16(r0[2], r0[3]); wr_.z = cvt_pk_bf16(r1[0], r1[1]); wr_.w = cvt_pk_bf16(r1[2], r1[3]);
                        if (is_qa) *(u32x4*)(QR + (size_t)row * 2048 + pn * BM + bj * HALF + colw) = wr_;
                        else *(u32x4*)(Pm + (size_t)row * ldc + pn * BM + bj * HALF + colw) = wr_;
                    }
                }
            }
    }
};

struct EpiLR {
    static constexpr bool PERM = false, AFTER_DRAIN = false;
    float* O; int ldc; size_t ks_stride;
    __device__ __forceinline__ void operator()(const f32x4 (&acc)[2][2][4][2], const Unit& u, int wr, int wc, int fr, int fq) const {
        const int row0 = u.pm * BM + wr * 64 + fr, col0 = u.pn * BM + wc * 32 + 4 * fq; float* Ob = O + (size_t)(u.ko >> 8) * ks_stride;
#pragma unroll
        for (int ai = 0; ai < 2; ++ai)
#pragma unroll
            for (int m = 0; m < 4; ++m) { float* rowp = Ob + (size_t)(row0 + ai * HALF + m * 16) * ldc + col0;
#pragma unroll
                for (int bj = 0; bj < 2; ++bj)
#pragma unroll
                    for (int n = 0; n < 2; ++n) *(f32x4*)(rowp + bj * HALF + n * 16) = acc[ai][bj][m][n]; }
    }
};
struct CmpOrder { int c, G;
    __device__ __forceinline__ bool next(int i, Unit& u) const { const int L = i * G + c; if (L >= 256) return false;
        const int ks = L & 7, q = L >> 3, kv = q >> 4, pmi = (q >> 1) & 7, pni = q & 1; u.pm = kv * 8 + pmi; u.pn = kv * 2 + pni; u.ko = ks * 256; return true; }
    __device__ __forceinline__ void a_ready(const Unit&) const {}
    __device__ __forceinline__ void done(const Unit&) const {}
};

template <class Epi, class Sched, bool ALIGN_EPI = false, bool SP2 = false>
__device__ __forceinline__ void gemm_phase(PG8_LAS unsigned char* lds, const Gemm g, const Sched& S, const Epi& E) {
    const int tid = threadIdx.x, wid = __builtin_amdgcn_readfirstlane(tid >> 6), lane = tid & 63, wr = wid >> 2, wc = wid & 3, fr = lane & 15, fq = lane >> 4;
    const int K = g.K, nt = K / BK, ld = g.ld;
    unsigned voffA[2], voffB[2];
#pragma unroll
    for (int i = 0; i < 2; ++i) { int R, C; stage_rc(tid * 16 + i * 8192, R, C); const int Rb = Epi::PERM ? ((R & ~31) + perm32(R & 31)) : R;
        voffA[i] = (unsigned)(R * ld + C) * 2u; voffB[i] = (unsigned)(Rb * ld + C) * 2u; }
    const size_t kstep = (size_t)(BK * 2);
    const size_t hstep = (size_t)HALF * ld * 2;
    const size_t tstep = 2 * hstep;
    const unsigned ldsw = (unsigned)wid * 1024u;
    const int aoff = lds_byte(wr * 64 + fr, fq * 8), boff = lds_byte(wc * 32 + fr, fq * 8);
#define PG8_SA(b, h) (((b) * 2 + (h)) * HTB)
#define PG8_SB(b, h) ((4 + (b) * 2 + (h)) * HTB)
#define PG8_STAGE(bufoff, gbase, voff) do { _Pragma("unroll") for (int _i = 0; _i < 2; ++_i) \
        __builtin_amdgcn_global_load_lds((const unsigned*)((const char*)(gbase) + (voff)[_i]), (PG8_LAS unsigned*)(lds + (bufoff) + ldsw + _i * 8192), 16, 0, 0); } while (0)
#define PG8_LDA(dst, b, h) do { _Pragma("unroll") for (int m = 0; m < 4; ++m) _Pragma("unroll") for (int k = 0; k < 2; ++k) dst[m][k] = *(const PG8_LAS bf16x8*)(lds + PG8_SA(b, h) + aoff + m * 2048 + k * 1024); } while (0)
#define PG8_LDB(dst, b, h) do { _Pragma("unroll") for (int n = 0; n < 2; ++n) _Pragma("unroll") for (int k = 0; k < 2; ++k) dst[n][k] = *(const PG8_LAS bf16x8*)(lds + PG8_SB(b, h) + boff + n * 2048 + k * 1024); } while (0)
#define PG8_MMA(ai, bj, At, Bt) do { __builtin_amdgcn_s_setprio(1); _Pragma("unroll") for (int m = 0; m < 4; ++m) _Pragma("unroll") for (int n = 0; n < 2; ++n) _Pragma("unroll") for (int k = 0; k < 2; ++k) \
        acc[ai][bj][m][n] = __builtin_amdgcn_mfma_f32_16x16x32_bf16(Bt[n][k], At[m][k], acc[ai][bj][m][n], 0, 0, 0); __builtin_amdgcn_s_setprio(0); } while (0)
#define PG8_WAIT_V(n) asm volatile("s_waitcnt vmcnt(" #n ")" ::: "memory")
#define PG8_WAIT_L(n) asm volatile("s_waitcnt lgkmcnt(" #n ")" ::: "memory")
#define PG8_BAR __builtin_amdgcn_s_barrier()
#define PG8_SCHED __builtin_amdgcn_sched_barrier(0)
    Unit cur, nxt; int ui = 0;
    if (!S.next(0, cur)) return;
    f32x4 acc[2][2][4][2];
#pragma unroll
    for (int a = 0; a < 2; ++a)
#pragma unroll
        for (int b = 0; b < 2; ++b)
#pragma unroll
            for (int m = 0; m < 4; ++m)
#pragma unroll
                for (int n = 0; n < 2; ++n) acc[a][b][m][n] = (f32x4){0.f, 0.f, 0.f, 0.f};
    bf16x8 At[4][2], B0[2][2], B1[2][2];
    const char* cA = (const char*)g.A + (size_t)cur.pm * tstep + (size_t)cur.ko * 2; const char* cB = (const char*)g.Bt + (size_t)cur.pn * tstep + (size_t)cur.ko * 2;
    S.a_ready(cur);
    if constexpr (SP2) {
        PG8_STAGE(PG8_SB(0, 0), cB, voffB); PG8_STAGE(PG8_SB(0, 1), cB + hstep, voffB); PG8_STAGE(PG8_SA(0, 0), cA, voffA); PG8_STAGE(PG8_SA(0, 1), cA + hstep, voffA);
        if (wr == 1) PG8_BAR;
        PG8_WAIT_V(2); PG8_BAR;
        PG8_STAGE(PG8_SB(1, 0), cB + kstep, voffB); PG8_STAGE(PG8_SA(1, 0), cA + kstep, voffA); PG8_STAGE(PG8_SB(1, 1), cB + hstep + kstep, voffB);
        PG8_WAIT_V(6); PG8_BAR;
    } else {
        PG8_STAGE(PG8_SB(0, 0), cB, voffB); PG8_STAGE(PG8_SA(0, 0), cA, voffA); PG8_STAGE(PG8_SB(0, 1), cB + hstep, voffB); PG8_STAGE(PG8_SA(0, 1), cA + hstep, voffA);
        if (wr == 1) PG8_BAR;
        PG8_WAIT_V(4); PG8_BAR;
        PG8_STAGE(PG8_SB(1, 0), cB + kstep, voffB); PG8_STAGE(PG8_SA(1, 0), cA + kstep, voffA); PG8_STAGE(PG8_SB(1, 1), cB + hstep + kstep, voffB);
        PG8_WAIT_V(6); PG8_BAR;
    }
    for (;;) {
        const bool has_next = S.next(ui + 1, nxt);
        const char* nA = has_next ? (const char*)g.A + (size_t)nxt.pm * tstep + (size_t)nxt.ko * 2 : cA; const char* nB = has_next ? (const char*)g.Bt + (size_t)nxt.pn * tstep + (size_t)nxt.ko * 2 : cB;
        for (int t = 0; t < nt; t += 2) {
            const bool last = (t == nt - 2);
            const char* a1 = cA + (size_t)(t + 1) * kstep;
            const char* a2 = last ? nA : cA + (size_t)(t + 2) * kstep; const char* b2 = last ? nB : cB + (size_t)(t + 2) * kstep;
            const char* a3 = a2 + kstep; const char* b3 = b2 + kstep;
            if (last && has_next) S.a_ready(nxt);
            if constexpr (SP2) {
            PG8_LDB(B0, 0, 0); PG8_LDB(B1, 0, 1); PG8_SCHED; PG8_LDA(At, 0, 0); PG8_STAGE(PG8_SA(1, 1), a1 + hstep, voffA);
            PG8_WAIT_V(8); PG8_WAIT_L(0); PG8_BAR; PG8_MMA(0, 0, At, B0); PG8_MMA(0, 1, At, B1); PG8_BAR; PG8_SCHED;
            PG8_LDA(At, 0, 1); PG8_STAGE(PG8_SB(0, 0), b2, voffB); PG8_STAGE(PG8_SB(0, 1), b2 + hstep, voffB); PG8_STAGE(PG8_SA(0, 0), a2, voffA);
            PG8_WAIT_V(8); PG8_WAIT_L(0); PG8_BAR; PG8_MMA(1, 0, At, B0); PG8_MMA(1, 1, At, B1); PG8_BAR; PG8_SCHED;
            PG8_LDB(B0, 1, 0); PG8_LDB(B1, 1, 1); PG8_SCHED; PG8_LDA(At, 1, 0); PG8_STAGE(PG8_SA(0, 1), a2 + hstep, voffA);
            PG8_WAIT_V(8); PG8_WAIT_L(0); PG8_BAR; PG8_MMA(0, 0, At, B0); PG8_MMA(0, 1, At, B1); PG8_BAR; PG8_SCHED;
            PG8_LDA(At, 1, 1); PG8_STAGE(PG8_SB(1, 0), b3, voffB); PG8_STAGE(PG8_SB(1, 1), b3 + hstep, voffB); PG8_STAGE(PG8_SA(1, 0), a3, voffA);
            PG8_WAIT_V(8); PG8_WAIT_L(0); PG8_BAR; PG8_MMA(1, 0, At, B0); PG8_MMA(1, 1, At, B1); PG8_BAR; PG8_SCHED;
            } else {
            PG8_LDB(B0, 0, 0); PG8_SCHED; PG8_LDA(At, 0, 0); PG8_STAGE(PG8_SA(1, 1), a1 + hstep, voffA);
            PG8_WAIT_L(8); PG8_BAR; PG8_WAIT_L(0); PG8_MMA(0, 0, At, B0); PG8_BAR; PG8_SCHED;
            PG8_LDB(B1, 0, 1); PG8_STAGE(PG8_SB(0, 0), b2, voffB);
            PG8_BAR; PG8_WAIT_L(0); PG8_MMA(0, 1, At, B1); PG8_BAR;
            PG8_LDA(At, 0, 1); PG8_STAGE(PG8_SA(0, 0), a2, voffA);
            PG8_BAR; PG8_WAIT_L(0); PG8_MMA(1, 0, At, B0); PG8_BAR; PG8_SCHED;
            PG8_STAGE(PG8_SB(0, 1), b2 + hstep, voffB);
            PG8_WAIT_V(6); PG8_BAR; PG8_MMA(1, 1, At, B1); PG8_BAR;
            PG8_LDB(B0, 1, 0); PG8_SCHED; PG8_LDA(At, 1, 0); PG8_STAGE(PG8_SA(0, 1), a2 + hstep, voffA);
            PG8_WAIT_L(8); PG8_BAR; PG8_WAIT_L(0); PG8_MMA(0, 0, At, B0); PG8_BAR; PG8_SCHED;
            PG8_LDB(B1, 1, 1); PG8_STAGE(PG8_SB(1, 0), b3, voffB);
            PG8_BAR; PG8_WAIT_L(0); PG8_MMA(0, 1, At, B1); PG8_BAR;
            PG8_LDA(At, 1, 1); PG8_STAGE(PG8_SA(1, 0), a3, voffA);
            PG8_BAR; PG8_WAIT_L(0); PG8_MMA(1, 0, At, B0); PG8_BAR; PG8_SCHED;
            PG8_STAGE(PG8_SB(1, 1), b3 + hstep, voffB);
            PG8_WAIT_V(6); PG8_BAR; PG8_MMA(1, 1, At, B1); PG8_BAR;
            }
        }
        if constexpr (ALIGN_EPI) { if (wr == 0) PG8_BAR; }
        if constexpr (!Epi::AFTER_DRAIN) { E(acc, cur, wr, wc, fr, fq); S.done(cur); }
        if (!has_next) break;
#pragma unroll
        for (int a = 0; a < 2; ++a)
#pragma unroll
            for (int b = 0; b < 2; ++b)
#pragma unroll
                for (int m = 0; m < 4; ++m)
#pragma unroll
                    for (int n = 0; n < 2; ++n) acc[a][b][m][n] = (f32x4){0.f, 0.f, 0.f, 0.f};
        cur = nxt; cA = nA; cB = nB; ++ui;
        if constexpr (ALIGN_EPI) { if (wr == 1) PG8_BAR; }
    }
    PG8_WAIT_V(0);
    if constexpr (!ALIGN_EPI) { if (wr == 0) PG8_BAR; }
    PG8_BAR;
    if constexpr (Epi::AFTER_DRAIN) { E.fused(acc, cur, wr, wc, fr, fq, lds, wid, lane); S.done(cur); }
#undef PG8_SA
#undef PG8_SB
#undef PG8_STAGE
#undef PG8_LDA
#undef PG8_LDB
#undef PG8_MMA
#undef PG8_WAIT_V
#undef PG8_WAIT_L
#undef PG8_BAR
#undef PG8_SCHED
}
}
#define GAS __attribute__((address_space(1)))
#define LAS __attribute__((address_space(3)))
typedef unsigned short bf16;
typedef unsigned v4u __attribute__((ext_vector_type(4)));
typedef float f32x4 __attribute__((ext_vector_type(4)));
typedef short bf16x8 __attribute__((ext_vector_type(8)));
typedef GAS unsigned gu32;
typedef GAS unsigned long long gu64;
#define RLX_AGENT __ATOMIC_RELAXED, __HIP_MEMORY_SCOPE_AGENT
#define LDS_WAIT() asm volatile("s_waitcnt lgkmcnt(0)" ::: "memory")
#define VM_WAIT() asm volatile("s_waitcnt vmcnt(0)" ::: "memory")
__device__ __forceinline__ unsigned long long rt() { return __builtin_amdgcn_s_memrealtime(); }
__device__ __forceinline__ unsigned f2bf(float f) { unsigned u = __builtin_bit_cast(unsigned, f); return (u + 0x7fffu + ((u >> 16) & 1u)) >> 16; }
__device__ __forceinline__ unsigned pk2(float lo, float hi) { return f2bf(lo) | (f2bf(hi) << 16); }

#define XB_TMO      128
#define XB_XCNT(j)  (256  + 64 * (j))
#define XB_XSUB(j)  (1280 + 64 * (j))
#define XB_XGEN(j)  (2304 + 64 * (j))
#define XB_TOP      3328
#define XB_TOPGEN   3392
#define XCD_BAR_WORDS 3456
#define XB_SPIN_CAP (1u << 24)

__device__ __forceinline__ unsigned xb_ld(unsigned* p)              { return __hip_atomic_load(p, __ATOMIC_RELAXED, __HIP_MEMORY_SCOPE_AGENT); }
__device__ __forceinline__ unsigned xb_add(unsigned* p, unsigned v) { return __hip_atomic_fetch_add(p, v, __ATOMIC_RELAXED, __HIP_MEMORY_SCOPE_AGENT); }
__device__ __forceinline__ unsigned xb_xcc_id() { return (unsigned)__builtin_amdgcn_s_getreg((3 << 11) | 20) & 0xFu; }
#define XB_SPIN(cond, bar) do { unsigned _sp = 0; while (cond) { __builtin_amdgcn_s_sleep(1); \
    if ((++_sp & 255u) == 0u) { if (xb_ld(&(bar)[XB_TMO])) break; if (_sp > XB_SPIN_CAP) { atomicAdd(&(bar)[XB_TMO], 1u); break; } } } } while (0)

struct XcdBarrier {
    unsigned* bar; unsigned x;
    volatile LAS unsigned* st;
};

__device__ __forceinline__ XcdBarrier xcd_barrier_post(unsigned* bar, volatile LAS unsigned* st) {
    XcdBarrier b; b.bar = bar; b.x = xb_xcc_id(); b.st = st;
    if (threadIdx.x == 0) (void)xb_add(&bar[XB_XCNT(b.x)], 1u);
    return b;
}
__device__ __forceinline__ void xcd_barrier_complete(unsigned* bar, unsigned x, unsigned& nloc, unsigned& nx) {
    const unsigned G = gridDim.x * gridDim.y * gridDim.z;
    unsigned sum, cnt, mine, sp = 0u;
    for (;;) {
        sum = 0u; cnt = 0u; mine = 0u;
#pragma unroll
        for (unsigned j = 0; j < 16; ++j) { const unsigned c = xb_ld(&bar[XB_XCNT(j)]); sum += c; cnt += (c > 0u) ? 1u : 0u; mine = (j == x) ? c : mine; }
        if (sum == G) break;
        __builtin_amdgcn_s_sleep(1);
        if ((++sp & 255u) == 0u) { if (xb_ld(&bar[XB_TMO])) break; if (sp > XB_SPIN_CAP) { atomicAdd(&bar[XB_TMO], 1u); break; } }
    }
    nloc = mine > 0u ? mine : 1u; nx = cnt > 0u ? cnt : 1u;
}

__device__ __forceinline__ void xcd_barrier(const XcdBarrier& b) {
    asm volatile("s_waitcnt vmcnt(0)" ::: "memory");
    __syncthreads();
    if (threadIdx.x == 0) {
        unsigned* bar = b.bar;
        __builtin_amdgcn_s_waitcnt(0);
        unsigned nloc = b.st[0], nx = b.st[1];
        if (nloc == 0u) { xcd_barrier_complete(bar, b.x, nloc, nx); b.st[0] = nloc; b.st[1] = nx; }
        const unsigned old = xb_add(&bar[XB_XSUB(b.x)], 1u);
        const unsigned gen = old / nloc;
        if (old + 1u == (gen + 1u) * nloc) {
            __builtin_amdgcn_fence(__ATOMIC_RELEASE, "agent");
            asm volatile("s_waitcnt vmcnt(0)" ::: "memory");
            const unsigned og = xb_add(&bar[XB_TOP], 1u);
            const unsigned tg = og / nx;
            if (og + 1u == (tg + 1u) * nx) xb_add(&bar[XB_TOPGEN], 1u);
            else XB_SPIN(xb_ld(&bar[XB_TOPGEN]) == tg, bar);
            __builtin_amdgcn_fence(__ATOMIC_ACQUIRE, "agent");
            xb_add(&bar[XB_XGEN(b.x)], 1u);
            asm volatile("s_waitcnt vmcnt(0)" ::: "memory");
        } else {
            XB_SPIN(xb_ld(&bar[XB_XGEN(b.x)]) == gen, bar);
            __builtin_amdgcn_fence(__ATOMIC_ACQUIRE, "agent");
            asm volatile("s_waitcnt vmcnt(0)" ::: "memory");
        }
    }
    __syncthreads();
}

constexpr int NWAVES = 8;
constexpr int BATCH = 4, SEQ = 2048, DM = 4096, M = BATCH * SEQ;
constexpr int HD = 128, NHA = 16, NKV = 4, GRP = 4, NHB = 16;
constexpr int CIN = 15408, NP = 15616;
constexpr int LDP = NP;
constexpr int C_QA = 0, C_ZA = 2048, C_KC = 4096, C_VC = 4608, C_KSL = 5120, C_VSL = 5632, C_KW = 6144, C_VW = 6656,
              C_QB = 7168, C_KB = 9216, C_VB = 11264, C_ZB = 13312, C_GA = 15360;
constexpr int NCMP = 127, NSEL = 32, TOPN = 16;
constexpr float EPS = 1e-6f;
constexpr float QSCALE = 0.08838834764831845f;

constexpr size_t MiB = 1u << 20;
constexpr size_t WS_CTL = 0, CTL_ZERO_BYTES = 1 * MiB;
constexpr size_t WS_WIN = 2 * MiB;
constexpr size_t WS_WOUT = 124 * MiB;
constexpr size_t WS_HB = 160 * MiB;
constexpr size_t WS_P = 224 * MiB;
constexpr size_t WS_QR = 468 * MiB;
constexpr size_t WS_COS = 500 * MiB;
constexpr size_t WS_SIN = 502 * MiB;
constexpr size_t WS_MIX = 504 * MiB;
constexpr size_t WS_Y = 568 * MiB;
constexpr size_t WS_KCMP = 696 * MiB;
constexpr size_t WS_VCMP = 697 * MiB;
constexpr size_t WS_BIAS1 = 698 * MiB;
constexpr size_t WS_SEL = 699 * MiB;
constexpr size_t WS_OC = 704 * MiB;
constexpr size_t WS_OS = 768 * MiB;
constexpr size_t WS_XKV = 832 * MiB;
constexpr size_t WS_WLR = 848 * MiB;
constexpr size_t WS_KCB = 852 * MiB;
constexpr size_t WS_VCB = 853 * MiB;
constexpr size_t WS_LR = WS_Y;
constexpr size_t WS_END = 854 * MiB;
constexpr int CW_BAR = 4096;

constexpr int RING_OFF = 0, RING_BYTES = 131072;
constexpr int LDSCTL_OFF = RING_BYTES, MISC_OFF = LDSCTL_OFF + 320;
constexpr int LDS_BYTES = 147456;

__device__ __forceinline__ float bf2f(unsigned short u) { return __builtin_bit_cast(float, (unsigned)u << 16); }
__device__ __forceinline__ float wave_sum(float v) {
#pragma unroll
    for (int o = 1; o < 64; o <<= 1) v += __shfl_xor(v, o);
    return v;
}
__device__ __forceinline__ float wave_max(float v) {
#pragma unroll
    for (int o = 1; o < 64; o <<= 1) v = fmaxf(v, __shfl_xor(v, o));
    return v;
}

struct Args {
    const float* x; const int* pos; const float* pre_w; const float* post_w; const float* w_in; const float* b_gate;
    const float* pe_k; const float* pe_v; const float* wk1; const float* wk2; const float* wv1; const float* wv2; const float* w_out;
    float* out; unsigned char* ws; int ph_lo, ph_hi;
};

struct Ctx {
    LAS unsigned char* lds; int tid, lane, wave, G, bid, gw, NGW;
};

__host__ __device__ __forceinline__ int rope_phi(int d) { const int dd = d & 63; return 32 * (dd >> 4) + 8 * ((dd >> 2) & 3) + 4 * (d >> 6) + (dd & 3); }
__device__ __forceinline__ void transpose_item(const float* W, int ldw, int K, int k0, int c0, int ncols, bf16* WT, int r0, LAS float* scr, int lane, bool perm = false) {
#pragma unroll 8
    for (int i = 0; i < 32; ++i) { const int kk = 2 * i + (lane >> 5), n = lane & 31; scr[kk * 33 + n] = (n < ncols) ? W[(size_t)(k0 + kk) * ldw + c0 + n] : 0.f; }
    LDS_WAIT(); asm volatile("" ::: "memory");
    const int c = lane & 7;
#pragma unroll
    for (int j = 0; j < 4; ++j) { const int n = (lane >> 3) + 8 * j; const LAS float* s = scr + (8 * c) * 33 + n;
        v4u o; o.x = pk2(s[0 * 33], s[1 * 33]); o.y = pk2(s[2 * 33], s[3 * 33]); o.z = pk2(s[4 * 33], s[5 * 33]); o.w = pk2(s[6 * 33], s[7 * 33]);
        const int drow = perm ? (r0 & ~127) + rope_phi((r0 & 127) + n) : r0 + n;
        if (n < ncols) *(GAS v4u*)(WT + (size_t)drow * K + k0 + 8 * c) = o; }
    LDS_WAIT(); asm volatile("" ::: "memory");
}

__device__ __forceinline__ void p0_transposes(const Args& a, const Ctx& c, int it0, int it1, int widx, int nw) {
    unsigned char* ws = a.ws;
    bf16* WinT = (bf16*)(ws + WS_WIN); bf16* WoutT = (bf16*)(ws + WS_WOUT);
    LAS float* scr = (LAS float*)(c.lds + RING_OFF + c.wave * 16384);
    constexpr int NB_IN = 482, I_IN = 64 * NB_IN, I_OUT = 64 * 128, I_LR = 4 * 32 * 8, I_ALL = I_IN + I_OUT + I_LR;
    bf16* WLR = (bf16*)(ws + WS_WLR);
    struct TItem { const float* src; bf16* dst; int ldw, K, ncols; bool perm; int r0; };
    auto decode = [&](int it) -> TItem {
        TItem t;
        if (it < I_IN) {
            const int kb = it / NB_IN, nb = it % NB_IN; int c0, r0, nc = 32;
            if (nb < 128) { c0 = nb * 32; r0 = nb * 32; }
            else if (nb < 224) { c0 = 4144 + (nb - 128) * 32; r0 = 4096 + (nb - 128) * 32; }
            else if (nb < 480) { c0 = 7216 + (nb - 224) * 32; r0 = 7168 + (nb - 224) * 32; }
            else { c0 = 4096 + (nb - 480) * 32; r0 = C_GA + (nb - 480) * 32; nc = (nb == 480) ? 32 : 16; }
            t.perm = (r0 < 2048) || (r0 >= C_KSL && r0 < C_VSL) || (r0 >= C_KW && r0 < C_VW) || (r0 >= C_QB && r0 < C_VB);
            t.src = a.w_in + (size_t)(kb * 64) * CIN + c0; t.ldw = CIN; t.K = DM; t.ncols = nc; t.dst = WinT + kb * 64; t.r0 = r0;
        } else if (it < I_IN + I_OUT) {
            const int r = it - I_IN, kb = r / 128, nb = r % 128;
            t.perm = false; t.src = a.w_out + (size_t)(kb * 64) * DM + nb * 32; t.ldw = DM; t.K = DM; t.ncols = 32; t.dst = WoutT + kb * 64; t.r0 = nb * 32;
        } else {
            const int r = it - I_IN - I_OUT, part = r >> 8, kb = (r >> 3) & 31, nb = r & 7;
            t.perm = false; t.src = ((part >> 1) ? a.wv1 : a.wk1) + (size_t)((part & 1) * 2048 + kb * 64) * 256 + nb * 32; t.ldw = 256; t.K = 2048; t.ncols = 32;
            t.dst = WLR + kb * 64; t.r0 = part * 256 + nb * 32;
        }
        return t;
    };
    {
        const int kr = c.lane >> 3, nq = (c.lane & 7) * 4;
        f32x4 v[8];
        int it = it0 + widx; bool have = it < it1; TItem cur{};
        if (have) { cur = decode(it);
#pragma unroll
            for (int i = 0; i < 8; ++i) v[i] = (nq < cur.ncols) ? __builtin_nontemporal_load((const GAS f32x4*)(cur.src + (size_t)(8 * i + kr) * cur.ldw + nq)) : (f32x4){0.f, 0.f, 0.f, 0.f}; }
        while (have) {
#pragma unroll
            for (int i = 0; i < 8; ++i) { LAS float* d = scr + (8 * i + kr) * 33 + nq; d[0] = v[i].x; d[1] = v[i].y; d[2] = v[i].z; d[3] = v[i].w; }
            const int nit = it + nw; const bool hn = nit < it1; TItem nx{};
            if (hn) { nx = decode(nit);
#pragma unroll
                for (int i = 0; i < 8; ++i) v[i] = (nq < nx.ncols) ? __builtin_nontemporal_load((const GAS f32x4*)(nx.src + (size_t)(8 * i + kr) * nx.ldw + nq)) : (f32x4){0.f, 0.f, 0.f, 0.f}; }
            LDS_WAIT(); asm volatile("" ::: "memory");
            const int cc = c.lane & 7;
#pragma unroll
            for (int j = 0; j < 4; ++j) { const int n = (c.lane >> 3) + 8 * j; const LAS float* sp = scr + (8 * cc) * 33 + n;
                v4u o; o.x = pk2(sp[0 * 33], sp[1 * 33]); o.y = pk2(sp[2 * 33], sp[3 * 33]); o.z = pk2(sp[4 * 33], sp[5 * 33]); o.w = pk2(sp[6 * 33], sp[7 * 33]);
                const int drow = cur.perm ? (cur.r0 & ~127) + rope_phi((cur.r0 & 127) + n) : cur.r0 + n;
                if (n < cur.ncols) *(GAS v4u*)(cur.dst + (size_t)drow * cur.K + 8 * cc) = o; }
            LDS_WAIT(); asm volatile("" ::: "memory");
            it = nit; have = hn; cur = nx;
        }
    }
}
constexpr int TI_IN = 64 * 482, TI_ALL = TI_IN + 64 * 128 + 4 * 32 * 8;

__device__ __forceinline__ void p0_prologue(const Args& a, const Ctx& c) {
    unsigned char* ws = a.ws;
    bf16* WinT = (bf16*)(ws + WS_WIN); bf16* HB = (bf16*)(ws + WS_HB);
    p0_transposes(a, c, 0, TI_IN, c.gw, c.NGW);
    for (int e = c.gw * 64 + c.lane; e < (NP - CIN) * (DM / 8); e += c.NGW * 64)
        *(GAS v4u*)(WinT + (size_t)CIN * DM + (size_t)e * 8) = (v4u){0u, 0u, 0u, 0u};
    for (int m = c.gw; m < M; m += c.NGW) {
        const GAS f32x4* xr = (const GAS f32x4*)(a.x + (size_t)m * DM) + c.lane;
        f32x4 v[16]; float s = 0.f;
#pragma unroll
        for (int j = 0; j < 16; ++j) { v[j] = __builtin_nontemporal_load(xr + 64 * j); s += (v[j].x * v[j].x + v[j].y * v[j].y) + (v[j].z * v[j].z + v[j].w * v[j].w); }
        const float rstd = 1.0f / sqrtf(wave_sum(s) * (1.0f / DM) + EPS);
        GAS unsigned long long* o8 = (GAS unsigned long long*)(HB + (size_t)m * DM) + c.lane;
#pragma unroll
        for (int j = 0; j < 16; ++j) { const f32x4 w = ((const GAS f32x4*)a.pre_w)[c.lane + 64 * j];
            o8[64 * j] = (unsigned long long)pk2(v[j].x * rstd * w.x, v[j].y * rstd * w.y) | ((unsigned long long)pk2(v[j].z * rstd * w.z, v[j].w * rstd * w.w) << 32); }
    }
    {
        float* COS = (float*)(ws + WS_COS); float* SIN = (float*)(ws + WS_SIN);
        for (int e = c.gw * 64 + c.lane; e < M * 64; e += c.NGW * 64) {
            const int m = e >> 6, i = e & 63;
            double inv = 1.0; for (int k = 0; k < i; ++k) inv *= 0.8659643233600653;
            const double ang = (double)a.pos[m] * inv;
            const double TWO_PI = 6.283185307179586476925286766559;
            const double n = __builtin_rint(ang / TWO_PI);
            const double r = ang - n * TWO_PI;
            const double r2 = r * r;
            double sn = 0.0, cs = 0.0;
            double ts = r, tc = 1.0;
#pragma unroll
            for (int k = 0; k < 14; ++k) { sn += ts; cs += tc; ts *= -r2 / (double)((2 * k + 2) * (2 * k + 3)); tc *= -r2 / (double)((2 * k + 1) * (2 * k + 2)); }
            COS[e] = (float)cs; SIN[e] = (float)sn;
        }
    }
    {
        float* BP = (float*)(ws + WS_BIAS1);
        for (int o = c.NGW - 1 - c.gw; o < 128; o += c.NGW) {
            const int kv = o >> 6, ch = o & 63; const float* pe = (kv ? a.pe_v : a.pe_k) + ch * 64; const float* w1 = (kv ? a.wv1 : a.wk1) + (size_t)ch * 64 * 256;
            float s0 = 0.f, s1 = 0.f, s2 = 0.f, s3 = 0.f;
#pragma unroll 16
            for (int i = 0; i < 64; ++i) { const float p = pe[i]; const float* wr = w1 + i * 256 + c.lane; s0 += p * wr[0]; s1 += p * wr[64]; s2 += p * wr[128]; s3 += p * wr[192]; }
            float* d = BP + (size_t)o * 256 + c.lane; d[0] = s0; d[64] = s1; d[128] = s2; d[192] = s3;
        }
    }
}

__device__ __forceinline__ float gelu_tanh(float x) {
    const float u = 0.7978845608028654f * (x + 0.044715f * x * x * x);
    const float e = __expf(2.0f * u);
    const float th = 1.0f - 2.0f / (e + 1.0f);
    return 0.5f * x * (1.0f + th);
}

__device__ __forceinline__ void p2c_stage2(const Args& a, const Ctx& c) {
    unsigned char* ws = a.ws;
    const float* LR = (const float*)(ws + WS_LR); const float* B1 = (const float*)(ws + WS_BIAS1);
    LAS float* Gs = (LAS float*)(c.lds + RING_OFF);
    bf16* KCB = (bf16*)(ws + WS_KCB); bf16* VCB = (bf16*)(ws + WS_VCB);
    for (int e = c.gw * 64 + c.lane; e < 2 * 16 * 128; e += c.NGW * 64) { bf16* dst = (e >> 11) ? VCB : KCB; dst[(size_t)((e >> 7) & 15) * 128 * 128 + 127 * 128 + (e & 127)] = 0; }
    for (int it = c.bid; it < 2 * 127; it += c.G) {
        const int kv = it / 127, rb = it % 127;
        const float* w2 = kv ? a.wv2 : a.wk2;
        float* OUT = (float*)(ws + (kv ? WS_VCMP : WS_KCMP)); bf16* OUTB = kv ? VCB : KCB;
        const int n = c.tid & 255, half = c.tid >> 8;
        float b1 = 0.f;
#pragma unroll 16
        for (int ch = 0; ch < 64; ++ch) b1 += B1[(size_t)(kv * 64 + ch) * 256 + n];
        __syncthreads();
#pragma unroll
        for (int r = 0; r < 8; ++r) { const int R = rb * 16 + half * 8 + r, bh = R / 127, cc = R % 127; const size_t rowL = (size_t)kv * 2048 + bh * 128 + cc;
            float h = b1;
#pragma unroll
            for (int ks = 0; ks < 8; ++ks) { const float* p = LR + (size_t)ks * 4096 * 1024 + rowL * 1024 + kv * 512 + n; h += p[0] + p[1024 + 256]; }
            Gs[(half * 8 + r) * 256 + n] = gelu_tanh(h); }
        __syncthreads();
        const int d = c.tid & 127, rq = c.tid >> 7;
        float o[4] = {0.f, 0.f, 0.f, 0.f};
#pragma unroll 16
        for (int nn = 0; nn < 256; ++nn) { const float w = w2[nn * 128 + d];
#pragma unroll
            for (int r = 0; r < 4; ++r) o[r] += Gs[(rq * 4 + r) * 256 + nn] * w; }
#pragma unroll
        for (int r = 0; r < 4; ++r) { const int R = rb * 16 + rq * 4 + r, bh = R / 127, cc = R % 127; const int dd = kv ? d : rope_phi(d);
            OUT[(size_t)(bh * 128 + cc) * 128 + dd] = o[r]; OUTB[(size_t)(bh * 128 + cc) * 128 + dd] = (bf16)f2bf(o[r]); }
    }
}

namespace fa {
typedef short s16x4 __attribute__((ext_vector_type(4)));
typedef float f32x16 __attribute__((ext_vector_type(16)));
typedef unsigned u32x4 __attribute__((ext_vector_type(4)));
constexpr int KVBLK = 64, SHM_K = KVBLK * 128 * 2, SHM_V = SHM_K;
constexpr int BUFS = SHM_V + SHM_K, A_V = 0, A_K = SHM_V, A_WS = 3 * BUFS;
constexpr float SCALE = 0.08838834764831845f, THR = 8.f;
constexpr float C2 = 1.4426950408889634f * SCALE;
constexpr float DBL = 1.0f / C2;
#define FA_KSWZ(row, colB) ((row) * 256 + ((colB) ^ (((row) & 7) << 4)))
#define FA_SBAR() __builtin_amdgcn_sched_barrier(0)
__device__ __forceinline__ int v_st(int k, int c) { const int kk = (k & ~0xC) | ((k & 4) << 1) | ((k & 8) >> 1); return ((kk >> 3) * 4 + (c >> 5)) * 512 + ((kk & 7) * 32 + (c & 31)) * 2; }
__device__ __forceinline__ int v_rd_base(int lane) { return ((lane & 3) << 3) | (((lane >> 2) & 3) << 6) | (((lane >> 4) & 1) << 5) | (((lane >> 5) & 1) << 8); }
constexpr int v_rd_off(int d0, int ks, int half) { return d0 * 512 + ks * 4096 + half * 2048; }
__device__ __forceinline__ int crow(int r, int hi) { return (r & 3) + 8 * (r >> 2) + 4 * hi; }
__device__ __forceinline__ unsigned cvtpk(float lo, float hi) { unsigned r; asm volatile("v_cvt_pk_bf16_f32 %0, %1, %2" : "=v"(r) : "v"(lo), "v"(hi)); return r; }

__device__ __forceinline__ void mask_tile(f32x16& p0, f32x16& p1, int dq, unsigned W) {
    const float NEG = -__builtin_inff();
#pragma unroll
    for (int r = 0; r < 16; ++r) {
        const int c = (r & 3) + 8 * (r >> 2);
        if ((unsigned)(dq - c) >= W) p0[r] = NEG;
        if ((unsigned)(dq - c - 32) >= W) p1[r] = NEG;
    }
}
__device__ __forceinline__ void mask_dil(f32x16& p0, f32x16& p1, int dq) {
    const float NEG = -__builtin_inff();
#pragma unroll
    for (int r = 0; r < 16; ++r) {
        const int c = (r & 3) + 8 * (r >> 2);
        { const int dl = dq - c; const bool nr = (unsigned)dl <= 128u, m4 = dl >= 0 && (dl & 3) == 0; const float v = p0[r];
          p0[r] = nr ? (m4 ? v + DBL : v) : (m4 ? v : NEG); }
        { const int dl = dq - c - 32; const bool nr = (unsigned)dl <= 128u, m4 = dl >= 0 && (dl & 3) == 0; const float v = p1[r];
          p1[r] = nr ? (m4 ? v + DBL : v) : (m4 ? v : NEG); }
    }
}
__device__ __forceinline__ void partialSM(f32x16& p0, f32x16& p1, float& m_reg, float& mn, float& alpha, bool drop) {
    float pmax = p0[0];
#pragma unroll
    for (int r = 1; r < 16; ++r) pmax = fmaxf(pmax, p0[r]);
#pragma unroll
    for (int r = 0; r < 16; ++r) pmax = fmaxf(pmax, p1[r]);
    { auto rr = __builtin_amdgcn_permlane32_swap(__float_as_uint(pmax), __float_as_uint(pmax), false, false);
      pmax = fmaxf(__uint_as_float(rr[0]), __uint_as_float(rr[1])); }
    if (drop) pmax = -__builtin_inff();
    if (__builtin_expect(__all((pmax - m_reg) * SCALE <= THR), 1)) { mn = m_reg; alpha = 1.f; }
    else { mn = fmaxf(m_reg, pmax); alpha = __builtin_amdgcn_exp2f((m_reg - mn) * C2); m_reg = mn; }
    const float mnL = drop ? -__builtin_inff() : -mn * C2;
#pragma unroll
    for (int r = 0; r < 16; ++r) p0[r] = fmaf(p0[r], C2, mnL);
#pragma unroll
    for (int r = 0; r < 16; ++r) p1[r] = fmaf(p1[r], C2, mnL);
#pragma unroll
    for (int r = 0; r < 16; ++r) p0[r] = __builtin_amdgcn_exp2f(p0[r]);
}
__device__ __forceinline__ void finishSM(f32x16& p0, f32x16& p1, float alpha, float& l_reg, bf16x8& pa0, bf16x8& pa1, bf16x8& pa2, bf16x8& pa3) {
#pragma unroll
    for (int r = 0; r < 16; ++r) p1[r] = __builtin_amdgcn_exp2f(p1[r]);
    float ps = 0;
#pragma unroll
    for (int r = 0; r < 16; ++r) ps += p0[r];
#pragma unroll
    for (int r = 0; r < 16; ++r) ps += p1[r];
    { auto rr = __builtin_amdgcn_permlane32_swap(__float_as_uint(ps), __float_as_uint(ps), false, false);
      ps = __uint_as_float(rr[0]) + __uint_as_float(rr[1]); }
    l_reg = l_reg * alpha + ps;
#define FA_PK4(P, B_, OUT) do { unsigned a0 = cvtpk(P[B_+0], P[B_+1]), a1 = cvtpk(P[B_+2], P[B_+3]);                          \
        unsigned b0 = cvtpk(P[B_+4], P[B_+5]), b1 = cvtpk(P[B_+6], P[B_+7]);                                             \
        auto r0 = __builtin_amdgcn_permlane32_swap(a0, b0, false, false); auto r1 = __builtin_amdgcn_permlane32_swap(a1, b1, false, false); \
        u32x4 w = {r0[0], r1[0], r0[1], r1[1]}; OUT = __builtin_bit_cast(bf16x8, w); } while (0)
    FA_PK4(p0, 0, pa0); FA_PK4(p0, 8, pa1); FA_PK4(p1, 0, pa2); FA_PK4(p1, 8, pa3);
#undef FA_PK4
}
__device__ __forceinline__ void pack_p(const f32x16& p0, const f32x16& p1, bf16x8& pa0, bf16x8& pa1, bf16x8& pa2, bf16x8& pa3) {
#define FA_PK4(P, B_, OUT) do { unsigned a0 = cvtpk(P[B_+0], P[B_+1]), a1 = cvtpk(P[B_+2], P[B_+3]);                          \
        unsigned b0 = cvtpk(P[B_+4], P[B_+5]), b1 = cvtpk(P[B_+6], P[B_+7]);                                             \
        auto r0 = __builtin_amdgcn_permlane32_swap(a0, b0, false, false); auto r1 = __builtin_amdgcn_permlane32_swap(a1, b1, false, false); \
        u32x4 w = {r0[0], r1[0], r0[1], r1[1]}; OUT = __builtin_bit_cast(bf16x8, w); } while (0)
    FA_PK4(p0, 0, pa0); FA_PK4(p0, 8, pa1); FA_PK4(p1, 0, pa2); FA_PK4(p1, 8, pa3);
#undef FA_PK4
}
template <int KB>
__device__ __forceinline__ void qkt(f32x16& p0, f32x16& p1, const LAS char* K_lds, int r32, int hi, const bf16x8 (&qr)[8]) {
#pragma unroll
    for (int r = 0; r < 16; ++r) { p0[r] = 0.f; p1[r] = 0.f; }
    const LAS char* kb[4];
#pragma unroll
    for (int dd = 0; dd < 4; ++dd) kb[dd] = K_lds + KB * BUFS + FA_KSWZ(r32, (dd * 16 + hi * 8) * 2);
#pragma unroll
    for (int d0 = 0; d0 < 8; ++d0) { const LAS char* a = kb[d0 & 3] + (d0 >> 2) * 128;
        const bf16x8 b0 = *(const LAS bf16x8*)a;
        const bf16x8 b1 = *(const LAS bf16x8*)(a + 32 * 256);
        p0 = __builtin_amdgcn_mfma_f32_32x32x16_bf16(b0, qr[d0], p0, 0, 0, 0);
        p1 = __builtin_amdgcn_mfma_f32_32x32x16_bf16(b1, qr[d0], p1, 0, 0, 0); }
}
template <int VB>
__device__ __forceinline__ void pv_tile(f32x16 (&o)[4], int vb0, bf16x8 pa0, bf16x8 pa1, bf16x8 pa2, bf16x8 pa3) {
#define FA_TRRD(dst, off) asm volatile("ds_read_b64_tr_b16 %0, %1 offset:%2" : "=&v"(dst) : "v"(vb0), "i"(off) : "memory")
#define FA_PV_D0(d0) do { s16x4 l0, l1, l2, l3, h0, h1, h2, h3; constexpr int b_ = A_V + VB * BUFS + v_rd_off(d0, 0, 0); \
        FA_TRRD(l0, b_); FA_TRRD(h0, b_ + 2048); FA_TRRD(l1, b_ + 4096); FA_TRRD(h1, b_ + 6144); FA_TRRD(l2, b_ + 8192); FA_TRRD(h2, b_ + 10240); FA_TRRD(l3, b_ + 12288); FA_TRRD(h3, b_ + 14336); \
        asm volatile("s_waitcnt lgkmcnt(0)" ::: "memory"); FA_SBAR(); \
        o[d0] = __builtin_amdgcn_mfma_f32_32x32x16_bf16(pa0, (bf16x8){l0[0], l0[1], l0[2], l0[3], h0[0], h0[1], h0[2], h0[3]}, o[d0], 0, 0, 0);   \
        o[d0] = __builtin_amdgcn_mfma_f32_32x32x16_bf16(pa1, (bf16x8){l1[0], l1[1], l1[2], l1[3], h1[0], h1[1], h1[2], h1[3]}, o[d0], 0, 0, 0);   \
        o[d0] = __builtin_amdgcn_mfma_f32_32x32x16_bf16(pa2, (bf16x8){l2[0], l2[1], l2[2], l2[3], h2[0], h2[1], h2[2], h2[3]}, o[d0], 0, 0, 0);   \
        o[d0] = __builtin_amdgcn_mfma_f32_32x32x16_bf16(pa3, (bf16x8){l3[0], l3[1], l3[2], l3[3], h3[0], h3[1], h3[2], h3[3]}, o[d0], 0, 0, 0); } while (0)
    FA_PV_D0(0); FA_PV_D0(1); FA_PV_D0(2); FA_PV_D0(3);
#undef FA_PV_D0
#undef FA_TRRD
}

__device__ __forceinline__ void mask_half(f32x16& p, int dq, unsigned W) {
    const float NEG = -__builtin_inff();
#pragma unroll
    for (int r = 0; r < 16; ++r) { const int c = (r & 3) + 8 * (r >> 2); if ((unsigned)(dq - c) >= W) p[r] = NEG; }
}
__device__ __forceinline__ void mask_dil_half(f32x16& p, int dq) {
    const float NEG = -__builtin_inff();
#pragma unroll
    for (int r = 0; r < 16; ++r) { const int c = (r & 3) + 8 * (r >> 2); const int dl = dq - c; const bool nr = (unsigned)dl <= 128u, m4 = dl >= 0 && (dl & 3) == 0; const float v = p[r];
        p[r] = nr ? (m4 ? v + DBL : v) : (m4 ? v : NEG); }
}
template <int KB, int H>
__device__ __forceinline__ void qk_half(f32x16& p, const LAS char* K_lds, int r32, int hi, const bf16x8 (&qr)[8]) {
#pragma unroll
    for (int r = 0; r < 16; ++r) p[r] = 0.f;
    const LAS char* kb[4];
#pragma unroll
    for (int dd = 0; dd < 4; ++dd) kb[dd] = K_lds + KB * BUFS + H * 32 * 256 + FA_KSWZ(r32, (dd * 16 + hi * 8) * 2);
#pragma unroll
    for (int d0 = 0; d0 < 8; ++d0) { const bf16x8 b0 = *(const LAS bf16x8*)(kb[d0 & 3] + (d0 >> 2) * 128); p = __builtin_amdgcn_mfma_f32_32x32x16_bf16(b0, qr[d0], p, 0, 0, 0); }
}
template <int KB, int H>
__device__ __forceinline__ void k_reads(const LAS char* K_lds, int r32, int hi, bf16x8 (&kf)[8]) {
    const unsigned a0 = (unsigned)(uintptr_t)(K_lds + KB * BUFS + FA_KSWZ(r32, (0 * 16 + hi * 8) * 2)), a1 = (unsigned)(uintptr_t)(K_lds + KB * BUFS + FA_KSWZ(r32, (1 * 16 + hi * 8) * 2)),
                   a2 = (unsigned)(uintptr_t)(K_lds + KB * BUFS + FA_KSWZ(r32, (2 * 16 + hi * 8) * 2)), a3 = (unsigned)(uintptr_t)(K_lds + KB * BUFS + FA_KSWZ(r32, (3 * 16 + hi * 8) * 2));
#define FA_KRD(dst, ad, off) asm volatile("ds_read_b128 %0, %1 offset:%2" : "=&v"(dst) : "v"(ad), "i"(off) : "memory")
    FA_KRD(kf[0], a0, H * 8192); FA_KRD(kf[1], a1, H * 8192); FA_KRD(kf[2], a2, H * 8192); FA_KRD(kf[3], a3, H * 8192);
    FA_KRD(kf[4], a0, H * 8192 + 128); FA_KRD(kf[5], a1, H * 8192 + 128); FA_KRD(kf[6], a2, H * 8192 + 128); FA_KRD(kf[7], a3, H * 8192 + 128);
#undef FA_KRD
}
__device__ __forceinline__ void qk_mma(f32x16& p, const bf16x8 (&kf)[8], const bf16x8 (&qr)[8]) {
#pragma unroll
    for (int r = 0; r < 16; ++r) p[r] = 0.f;
#pragma unroll
    for (int d0 = 0; d0 < 8; ++d0) p = __builtin_amdgcn_mfma_f32_32x32x16_bf16(kf[d0], qr[d0], p, 0, 0, 0);
}
__device__ __forceinline__ float sm_max(const f32x16& p, float& m_reg, bool drop, float& mnL) {
    float pmax = p[0];
#pragma unroll
    for (int r = 1; r < 16; ++r) pmax = fmaxf(pmax, p[r]);
    { auto rr = __builtin_amdgcn_permlane32_swap(__float_as_uint(pmax), __float_as_uint(pmax), false, false); pmax = fmaxf(__uint_as_float(rr[0]), __uint_as_float(rr[1])); }
    if (drop) pmax = -__builtin_inff();
    const bool keep = __all((pmax - m_reg) * SCALE <= THR);
    const float mn = keep ? m_reg : fmaxf(m_reg, pmax);
    const float alpha = __builtin_amdgcn_exp2f((m_reg - mn) * C2);
    m_reg = mn; mnL = drop ? -__builtin_inff() : -mn * C2;
    return alpha;
}
__device__ __forceinline__ void sm_exp(f32x16& p, float mnL, float alpha, float& l_reg, bf16x8& paA, bf16x8& paB) {
    float ps = 0.f;
#pragma unroll
    for (int r = 0; r < 16; ++r) { p[r] = __builtin_amdgcn_exp2f(fmaf(p[r], C2, mnL)); ps += p[r]; }
    { auto rr = __builtin_amdgcn_permlane32_swap(__float_as_uint(ps), __float_as_uint(ps), false, false); ps = __uint_as_float(rr[0]) + __uint_as_float(rr[1]); }
    l_reg = l_reg * alpha + ps;
#define FA_PK4(P, B_, OUT) do { unsigned a0 = cvtpk(P[B_+0], P[B_+1]), a1 = cvtpk(P[B_+2], P[B_+3]);                          \
        unsigned b0 = cvtpk(P[B_+4], P[B_+5]), b1 = cvtpk(P[B_+6], P[B_+7]);                                             \
        auto r0 = __builtin_amdgcn_permlane32_swap(a0, b0, false, false); auto r1 = __builtin_amdgcn_permlane32_swap(a1, b1, false, false); \
        u32x4 w = {r0[0], r1[0], r0[1], r1[1]}; OUT = __builtin_bit_cast(bf16x8, w); } while (0)
    FA_PK4(p, 0, paA); FA_PK4(p, 8, paB);
#undef FA_PK4
}
template <int VB, int H, int D0A = 0, int D0B = 4>
__device__ __forceinline__ void pv_reads(int vb0, s16x4 (&vl)[8], s16x4 (&vh)[8]) {
    const int vbb = vb0 + VB * BUFS;
#define FA_TRRD(dst, off) asm volatile("ds_read_b64_tr_b16 %0, %1 offset:%2" : "=&v"(dst) : "v"(vbb), "i"(off) : "memory")
#define FA_RD_D0(d0) do { constexpr int b_ = A_V + v_rd_off(d0, 2 * H, 0); \
        FA_TRRD(vl[2 * d0], b_); FA_TRRD(vh[2 * d0], b_ + 2048); FA_TRRD(vl[2 * d0 + 1], b_ + 4096); FA_TRRD(vh[2 * d0 + 1], b_ + 6144); } while (0)
    if constexpr (D0A <= 0 && 0 < D0B) FA_RD_D0(0); if constexpr (D0A <= 1 && 1 < D0B) FA_RD_D0(1); if constexpr (D0A <= 2 && 2 < D0B) FA_RD_D0(2); if constexpr (D0A <= 3 && 3 < D0B) FA_RD_D0(3);
#undef FA_RD_D0
#undef FA_TRRD
}
__device__ __forceinline__ void pv_mma(f32x16 (&o)[4], const s16x4 (&vl)[8], const s16x4 (&vh)[8], bf16x8 paA, bf16x8 paB) {
#pragma unroll
    for (int d0 = 0; d0 < 4; ++d0) {
        o[d0] = __builtin_amdgcn_mfma_f32_32x32x16_bf16(paA, (bf16x8){vl[2 * d0][0], vl[2 * d0][1], vl[2 * d0][2], vl[2 * d0][3], vh[2 * d0][0], vh[2 * d0][1], vh[2 * d0][2], vh[2 * d0][3]}, o[d0], 0, 0, 0);
        o[d0] = __builtin_amdgcn_mfma_f32_32x32x16_bf16(paB, (bf16x8){vl[2 * d0 + 1][0], vl[2 * d0 + 1][1], vl[2 * d0 + 1][2], vl[2 * d0 + 1][3], vh[2 * d0 + 1][0], vh[2 * d0 + 1][1], vh[2 * d0 + 1][2], vh[2 * d0 + 1][3]}, o[d0], 0, 0, 0); }
}

struct St { float m, l; f32x16 o[4]; };
__device__ __forceinline__ void st_init(St& S) { S.m = -1e30f; S.l = 0.f;
#pragma unroll
    for (int d = 0; d < 4; ++d)
#pragma unroll
        for (int r = 0; r < 16; ++r) S.o[d][r] = 0.f; }

struct MaskWin { int qlo, qm;
    __device__ __forceinline__ bool act(int t) const { const int kb = t * 64; return kb <= qlo + 31 && kb + 63 >= qlo - 511; }
    __device__ __forceinline__ void apply(f32x16& p0, f32x16& p1, int t) const { const int kb = t * 64; if (kb + 63 > qlo || kb <= qlo + 31 - 512) mask_tile(p0, p1, qm - kb, 512u); }
    __device__ __forceinline__ bool needs_mask(int t) const { const int kb = t * 64; return kb + 63 > qlo || kb <= qlo + 31 - 512; }
    __device__ __forceinline__ void apply_half(f32x16& p, int t, int H) const { mask_half(p, qm - t * 64 - 32 * H, 512u); }
    __device__ __forceinline__ bool drop(int) const { return false; } };
struct MaskSel { int qlo, qm; unsigned selw;
    __device__ __forceinline__ bool act(int t) const { return t * 64 <= qlo + 31; }
    __device__ __forceinline__ void apply(f32x16& p0, f32x16& p1, int t) const { const int kb = t * 64; if (kb + 63 > qlo) mask_tile(p0, p1, qm - kb, 0x40000000u); }
    __device__ __forceinline__ bool needs_mask(int t) const { return t * 64 + 63 > qlo; }
    __device__ __forceinline__ void apply_half(f32x16& p, int t, int H) const { mask_half(p, qm - t * 64 - 32 * H, 0x40000000u); }
    __device__ __forceinline__ bool drop(int t) const { return ((selw >> t) & 1u) == 0u; } };
struct MaskDilA { int plo, pm;
    __device__ __forceinline__ bool act(int t) const { return t * 64 <= plo + 31; }
    __device__ __forceinline__ void apply(f32x16& p0, f32x16& p1, int t) const { mask_dil(p0, p1, pm - t * 64); }
    __device__ __forceinline__ bool needs_mask(int) const { return true; }
    __device__ __forceinline__ void apply_half(f32x16& p, int t, int H) const { mask_dil_half(p, pm - t * 64 - 32 * H); }
    __device__ __forceinline__ bool drop(int) const { return false; } };
struct MaskDilB { int tlo, tm;
    __device__ __forceinline__ bool act(int t) const { const int kb = t * 64; return kb <= tlo + 124 && kb + 63 >= tlo - 128; }
    __device__ __forceinline__ void apply(f32x16& p0, f32x16& p1, int t) const { mask_tile(p0, p1, tm - t * 64, 129u); }
    __device__ __forceinline__ bool needs_mask(int) const { return true; }
    __device__ __forceinline__ void apply_half(f32x16& p, int t, int H) const { mask_half(p, tm - t * 64 - 32 * H, 129u); }
    __device__ __forceinline__ bool drop(int) const { return false; } };

template <class MK>
__device__ __forceinline__ void attn_pass(St& S, const bf16x8 (&qr)[8], const bf16* Kg, const bf16* Vg, int pitch, int t0, int t1, LAS char* lds, const MK& mk, int tid, int wid, int lane) {
    if (t0 >= t1) return;
    const int r32 = lane & 31, hi = lane >> 5;
    LAS char* K_lds = lds + A_K;
    LAS float* al_l = (LAS float*)(lds + A_WS) + wid * 64 + 32;
    const int vb0 = (int)(unsigned)(uintptr_t)lds + v_rd_base(lane);
    unsigned kso[2], vso[2];
#pragma unroll
    for (int j = 0; j < 2; ++j) { const int ch = 2 * wid + j;
        const int row = ch * 4 + (lane >> 4), chunk = (lane & 15) ^ (row & 7); kso[j] = (unsigned)(row * pitch + chunk * 8);
        const int sub = ch * 2 + (lane >> 5), kk = (sub >> 2) * 8 + ((lane & 31) >> 2), key = (kk & ~0xC) | ((kk & 4) << 1) | ((kk & 8) >> 1), col = (sub & 3) * 32 + (lane & 3) * 8;
        vso[j] = (unsigned)(key * pitch + col); }
    const unsigned ldsw = (unsigned)wid * 2048u;
#define FA_DMA(t, bf) do { const bf16* kt_ = Kg + (size_t)((t) * 64) * pitch; const bf16* vt_ = Vg + (size_t)((t) * 64) * pitch; \
        _Pragma("unroll") for (int j_ = 0; j_ < 2; ++j_) { \
            __builtin_amdgcn_global_load_lds((const GAS unsigned*)(kt_ + kso[j_]), (LAS unsigned*)(lds + (bf) * BUFS + A_K + ldsw + j_ * 1024), 16, 0, 0); \
            __builtin_amdgcn_global_load_lds((const GAS unsigned*)(vt_ + vso[j_]), (LAS unsigned*)(lds + (bf) * BUFS + A_V + ldsw + j_ * 1024), 16, 0, 0); } } while (0)
#define FA_BAR() do { asm volatile("s_waitcnt lgkmcnt(0)" ::: "memory"); __builtin_amdgcn_s_barrier(); asm volatile("" ::: "memory"); } while (0)
#define FA_RESC(al_) do { if (__any((al_) < 1.f)) { if (hi == 0) al_l[r32] = (al_); asm volatile("s_waitcnt lgkmcnt(0)" ::: "memory"); \
            _Pragma("unroll") for (int d_ = 0; d_ < 4; ++d_) _Pragma("unroll") for (int r = 0; r < 16; ++r) S.o[d_][r] *= al_l[crow(r, hi)]; \
            asm volatile("s_waitcnt lgkmcnt(0)" ::: "memory"); } } while (0)
#define FA_LWAIT() do { asm volatile("s_waitcnt lgkmcnt(0)" ::: "memory"); FA_SBAR(); } while (0)
#define FA_BODY(t, B) do { f32x16 p0, p1; bf16x8 pa0, pa1, pa2, pa3; float mnL0, mnL1; const bool dr_ = mk.drop(t), nm_ = mk.needs_mask(t); \
            { bf16x8 kfa[8], kfb[8]; k_reads<B, 0>(K_lds, r32, hi, kfa); FA_LWAIT(); \
              k_reads<B, 1>(K_lds, r32, hi, kfb); qk_mma(p0, kfa, qr); FA_LWAIT(); \
              if (nm_) mk.apply_half(p0, (t), 0); \
              s16x4 vl[8], vh[8]; pv_reads<B, 0, 0, 2>(vb0, vl, vh); \
              qk_mma(p1, kfb, qr); const float al0 = sm_max(p0, S.m, dr_, mnL0); sm_exp(p0, mnL0, al0, S.l, pa0, pa1); \
              FA_SBAR(); pv_reads<B, 0, 2, 4>(vb0, vl, vh); FA_LWAIT(); FA_RESC(al0); FA_SBAR(); \
              if (nm_) mk.apply_half(p1, (t), 1); \
              pv_mma(S.o, vl, vh, pa0, pa1); const float al1 = sm_max(p1, S.m, dr_, mnL1); sm_exp(p1, mnL1, al1, S.l, pa2, pa3); \
              FA_SBAR(); FA_RESC(al1); \
              pv_reads<B, 1>(vb0, vl, vh); FA_LWAIT(); \
              pv_mma(S.o, vl, vh, pa2, pa3); } } while (0)
#define FA_STEP(t, B) do { const bool more2_ = (t) + 2 < t1; \
        if (more2_) FA_DMA((t) + 2, ((B) + 2) % 3); \
        if (mk.act(t)) { FA_BODY(t, B); } \
        if (more2_) asm volatile("s_waitcnt vmcnt(4)" ::: "memory"); else asm volatile("s_waitcnt vmcnt(0)" ::: "memory"); \
        FA_BAR(); } while (0)
    FA_DMA(t0, 0);
    if (t0 + 1 < t1) { FA_DMA(t0 + 1, 1); asm volatile("s_waitcnt vmcnt(4)" ::: "memory"); } else asm volatile("s_waitcnt vmcnt(0)" ::: "memory");
    FA_BAR();
    for (int t = t0; t < t1; t += 3) {
        FA_STEP(t, 0);
        if (t + 1 < t1) FA_STEP(t + 1, 1);
        if (t + 2 < t1) FA_STEP(t + 2, 2);
    }
#undef FA_STEP
#undef FA_BODY
#undef FA_LWAIT
#undef FA_RESC
#undef FA_BAR
#undef FA_DMA
}
__device__ __forceinline__ void row_factors(float f, float (&rli)[16], LAS char* lds, int wid, int r32, int hi) {
    LAS float* li_l = (LAS float*)(lds + A_WS) + wid * 64;
    if (hi == 0) li_l[r32] = f;
    asm volatile("s_waitcnt lgkmcnt(0)" ::: "memory");
#pragma unroll
    for (int r = 0; r < 16; ++r) rli[r] = li_l[crow(r, hi)];
    asm volatile("s_waitcnt lgkmcnt(0)" ::: "memory");
}
template <int HALF>
__device__ __forceinline__ void stage_half(const f32x16 (&o)[4], const float (&rli)[16], LAS float* st, int r32, int hi, int lane, f32x4 (&lo)[4], f32x4 (&hh)[4]) {
    asm volatile("s_waitcnt lgkmcnt(0)" ::: "memory");
#pragma unroll
    for (int r = 0; r < 16; ++r) { const int row = crow(r, hi); st[row * 64 + r32] = o[2 * HALF][r] * rli[r]; st[row * 64 + 32 + r32] = o[2 * HALF + 1][r] * rli[r]; }
    asm volatile("s_waitcnt lgkmcnt(0)" ::: "memory");
#pragma unroll
    for (int q = 0; q < 4; ++q) { const int idx = q * 64 + lane; const LAS float* p = st + (idx >> 3) * 64 + 8 * (idx & 7); lo[q] = *(const LAS f32x4*)p; hh[q] = *(const LAS f32x4*)(p + 4); }
    asm volatile("s_waitcnt lgkmcnt(0)" ::: "memory");
}
__device__ __forceinline__ float bflo(unsigned w) { return __builtin_bit_cast(float, w << 16); }
__device__ __forceinline__ float bfhi(unsigned w) { return __builtin_bit_cast(float, w & 0xffff0000u); }
__device__ __forceinline__ float silu_mul(float v, float z) { return v * z / (1.0f + __expf(-z)); }
}

__device__ __forceinline__ float sigm(float x) { return 1.0f / (1.0f + __expf(-x)); }

__device__ __forceinline__ void nsa_passes(const Args& a, const Ctx& c, int b, int h, int qlo, int sel_t1, int win_t0, int win_t1, const LAS unsigned* selt) {
    unsigned char* ws = a.ws;
    const bf16* P = (const bf16*)(ws + WS_P); const bf16* QR = (const bf16*)(ws + WS_QR);
    const bf16* OC = (const bf16*)(ws + WS_OC); bf16* OS = (bf16*)(ws + WS_OS);
    bf16* MIX = (bf16*)(ws + WS_MIX);
    LAS char* lds = (LAS char*)(c.lds + RING_OFF);
    int lane = c.lane, tid = c.tid; asm volatile("" : "+v"(lane), "+v"(tid));
    const int hk = h >> 2, r32 = lane & 31, hi = lane >> 5;
    const int t_row = qlo + r32, m0 = b * SEQ + qlo;
    bf16x8 qr[8];
    { const bf16* qb_ = QR + (size_t)m0 * 2048 + h * 128; const unsigned lq = (unsigned)(r32 * 2048 + hi * 8);
#pragma unroll
      for (int d0 = 0; d0 < 8; ++d0) qr[d0] = *(const GAS bf16x8*)(qb_ + lq + d0 * 16); }
    const bf16* Pb = P + (size_t)b * SEQ * LDP;
    const bf16* grow = P + (size_t)m0 * LDP + C_GA + h * 3;

    {
        fa::St S; fa::st_init(S);
        fa::MaskSel mk{qlo, t_row - 4 * hi, selt[(qlo & 63) + r32]};
        fa::attn_pass(S, qr, Pb + C_KSL + hk * 128, Pb + C_VSL + hk * 128, LDP, 0, sel_t1, lds, mk, tid, c.wave, lane);
        const float g1 = sigm(bf2f(grow[(unsigned)(r32 * LDP + 1)]) + a.b_gate[h * 3 + 1]);
        float rli[16]; fa::row_factors(g1 / S.l, rli, lds, c.wave, r32, hi);
        __syncthreads();
        LAS float* st = (LAS float*)lds + c.wave * 2048;
#define SEL_HALF(HF) do { f32x4 lo[4], hh[4]; fa::stage_half<HF>(S.o, rli, st, r32, hi, lane, lo, hh); \
        _Pragma("unroll") for (int q = 0; q < 4; ++q) { const int idx = q * 64 + lane; bf16* ob = OS + (size_t)(m0 + (idx >> 3)) * 2048 + h * 128 + HF * 64 + 8 * (idx & 7); \
            { v4u w_; w_.x = fa::cvtpk(lo[q][0], lo[q][1]); w_.y = fa::cvtpk(lo[q][2], lo[q][3]); w_.z = fa::cvtpk(hh[q][0], hh[q][1]); w_.w = fa::cvtpk(hh[q][2], hh[q][3]); *(GAS v4u*)ob = w_; } } } while (0)
        SEL_HALF(0); SEL_HALF(1);
#undef SEL_HALF
        __syncthreads();
    }
    {
        fa::St S; fa::st_init(S);
        fa::MaskWin mk{qlo, t_row - 4 * hi};
        fa::attn_pass(S, qr, Pb + C_KW + hk * 128, Pb + C_VW + hk * 128, LDP, win_t0, win_t1, lds, mk, tid, c.wave, lane);
        const float g2 = sigm(bf2f(grow[(unsigned)(r32 * LDP + 2)]) + a.b_gate[h * 3 + 2]);
        float rli[16]; fa::row_factors(g2 / S.l, rli, lds, c.wave, r32, hi);
        __syncthreads();
        LAS float* st = (LAS float*)lds + c.wave * 2048;
#define WIN_HALF(HF) do { f32x4 lo[4], hh[4]; v4u zz[4], cc_[4], ss_[4]; \
        _Pragma("unroll") for (int q = 0; q < 4; ++q) { const int idx = q * 64 + lane; const size_t mr = (size_t)(m0 + (idx >> 3)); const int gcol = h * 128 + HF * 64 + 8 * (idx & 7); \
            zz[q] = *(const GAS v4u*)(P + mr * LDP + C_ZA + gcol); cc_[q] = *(const GAS v4u*)(OC + mr * 2048 + gcol); ss_[q] = *(const GAS v4u*)(OS + mr * 2048 + gcol); } \
        fa::stage_half<HF>(S.o, rli, st, r32, hi, lane, lo, hh); \
        _Pragma("unroll") for (int q = 0; q < 4; ++q) { const int idx = q * 64 + lane; const size_t mr = (size_t)(m0 + (idx >> 3)); const int gcol = h * 128 + HF * 64 + 8 * (idx & 7); \
            const f32x4 c0 = {fa::bflo(cc_[q].x), fa::bfhi(cc_[q].x), fa::bflo(cc_[q].y), fa::bfhi(cc_[q].y)}, c1 = {fa::bflo(cc_[q].z), fa::bfhi(cc_[q].z), fa::bflo(cc_[q].w), fa::bfhi(cc_[q].w)}; \
            const f32x4 s0 = {fa::bflo(ss_[q].x), fa::bfhi(ss_[q].x), fa::bflo(ss_[q].y), fa::bfhi(ss_[q].y)}, s1 = {fa::bflo(ss_[q].z), fa::bfhi(ss_[q].z), fa::bflo(ss_[q].w), fa::bfhi(ss_[q].w)}; \
            const f32x4 a0 = lo[q] + c0 + s0, a1 = hh[q] + c1 + s1; v4u w; \
            w.x = fa::cvtpk(fa::silu_mul(a0[0], fa::bflo(zz[q].x)), fa::silu_mul(a0[1], fa::bfhi(zz[q].x))); w.y = fa::cvtpk(fa::silu_mul(a0[2], fa::bflo(zz[q].y)), fa::silu_mul(a0[3], fa::bfhi(zz[q].y))); \
            w.z = fa::cvtpk(fa::silu_mul(a1[0], fa::bflo(zz[q].z)), fa::silu_mul(a1[1], fa::bfhi(zz[q].z))); w.w = fa::cvtpk(fa::silu_mul(a1[2], fa::bflo(zz[q].w)), fa::silu_mul(a1[3], fa::bfhi(zz[q].w))); \
            *(GAS v4u*)(MIX + mr * DM + gcol) = w; } } while (0)
        WIN_HALF(0); WIN_HALF(1);
#undef WIN_HALF
        __syncthreads();
    }
}
__device__ __forceinline__ void dil_block(const Args& a, const Ctx& c, int b, int h, int r4, int pb) {
    unsigned char* ws = a.ws;
    const bf16* P = (const bf16*)(ws + WS_P); bf16* MIX = (bf16*)(ws + WS_MIX);
    LAS char* lds = (LAS char*)(c.lds + RING_OFF);
    int lane = c.lane, tid = c.tid; asm volatile("" : "+v"(lane), "+v"(tid));
    const int r32 = lane & 31, hi = lane >> 5;
    const int plo = pb * 256 + c.wave * 32, p_row = plo + r32, tok = 4 * p_row + r4, mrow0 = b * SEQ + 4 * plo + r4;
    bf16x8 qr[8];
    { const bf16* qb_ = P + (size_t)mrow0 * LDP + C_QB + h * 128; const unsigned lq = (unsigned)(r32 * 4 * LDP + hi * 8);
#pragma unroll
      for (int d0 = 0; d0 < 8; ++d0) qr[d0] = *(const GAS bf16x8*)(qb_ + lq + d0 * 16); }
    const bf16* Pb = P + (size_t)b * SEQ * LDP;
    fa::St S; fa::st_init(S);
    {   fa::MaskDilA mk{plo, p_row - 4 * hi};
        fa::attn_pass(S, qr, Pb + (size_t)r4 * LDP + C_KB + h * 128, Pb + (size_t)r4 * LDP + C_VB + h * 128, 4 * LDP, 0, 4 * pb + 4, lds, mk, tid, c.wave, lane); }
    {   const int tmin = 1024 * pb + r4, tmax = 1024 * pb + 1020 + r4;
        const int t0 = tmin - 128 > 0 ? (tmin - 128) >> 6 : 0, t1 = (tmax >> 6) + 1;
        fa::MaskDilB mk{4 * plo + r4, tok - 4 * hi};
        fa::attn_pass(S, qr, Pb + C_KB + h * 128, Pb + C_VB + h * 128, LDP, t0, t1, lds, mk, tid, c.wave, lane); }
    float rli[16]; fa::row_factors(1.0f / S.l, rli, lds, c.wave, r32, hi);
    __syncthreads();
    LAS float* st = (LAS float*)lds + c.wave * 2048;
#define DIL_HALF(HF) do { f32x4 lo[4], hh[4]; v4u zz[4]; \
        _Pragma("unroll") for (int q = 0; q < 4; ++q) { const int idx = q * 64 + lane; const size_t mr = (size_t)(mrow0 + 4 * (idx >> 3)); const int gcol = h * 128 + HF * 64 + 8 * (idx & 7); \
            zz[q] = *(const GAS v4u*)(P + mr * LDP + C_ZB + gcol); } \
        fa::stage_half<HF>(S.o, rli, st, r32, hi, lane, lo, hh); \
        _Pragma("unroll") for (int q = 0; q < 4; ++q) { const int idx = q * 64 + lane; const size_t mr = (size_t)(mrow0 + 4 * (idx >> 3)); const int gcol = h * 128 + HF * 64 + 8 * (idx & 7); \
            const f32x4 a0 = lo[q], a1 = hh[q]; v4u w; \
            w.x = fa::cvtpk(fa::silu_mul(a0[0], fa::bflo(zz[q].x)), fa::silu_mul(a0[1], fa::bfhi(zz[q].x))); w.y = fa::cvtpk(fa::silu_mul(a0[2], fa::bflo(zz[q].y)), fa::silu_mul(a0[3], fa::bfhi(zz[q].y))); \
            w.z = fa::cvtpk(fa::silu_mul(a1[0], fa::bflo(zz[q].z)), fa::silu_mul(a1[1], fa::bfhi(zz[q].z))); w.w = fa::cvtpk(fa::silu_mul(a1[2], fa::bflo(zz[q].w)), fa::silu_mul(a1[3], fa::bfhi(zz[q].w))); \
            *(GAS v4u*)(MIX + mr * DM + 2048 + gcol) = w; } } while (0)
    DIL_HALF(0); DIL_HALF(1);
#undef DIL_HALF
    __syncthreads();
}
__device__ __forceinline__ void p4_dil_mfma(const Args& a, const Ctx& c) {
    for (int it = c.bid; it < 256; it += c.G) {
        const int x = it & 7, y = it >> 3, bh = 8 * x + (y >> 2), r4 = y & 3, b = bh >> 4, h = bh & 15;
#pragma unroll 1
        for (int k = 0; k < 2; ++k) dil_block(a, c, b, h, r4, k);
    }
}

__device__ __forceinline__ void cmp_item(const Args& a, const Ctx& c, int b, int hk, int tb) {
    unsigned char* ws = a.ws;
    const bf16* P = (const bf16*)(ws + WS_P); const bf16* KCB = (const bf16*)(ws + WS_KCB); const bf16* VCB = (const bf16*)(ws + WS_VCB);
    bf16* OC = (bf16*)(ws + WS_OC);
    LAS char* lds = (LAS char*)(c.lds + RING_OFF);
    LAS float* imps = (LAS float*)(lds + 2 * fa::BUFS);
    LAS unsigned* selt = (LAS unsigned*)(lds + fa::A_WS + 2048);
    int lane = c.lane, tid = c.tid; asm volatile("" : "+v"(lane), "+v"(tid));
    const int r32 = lane & 31, hi = lane >> 5, g = c.wave >> 1, h = hk * 4 + g, bh = b * 4 + hk;
    const int tl0 = 32 * (c.wave & 1), tw0 = 64 * tb + tl0, t = tw0 + r32, m0 = b * SEQ + tw0;
    const int nt = tb >= 16 ? 2 : 1;
    LAS char* V_lds = lds + fa::A_V; LAS char* K_lds = lds + fa::A_K;
    {   const int sr = tid >> 4, sc = (tid & 15) * 8; const int kws = FA_KSWZ(sr, sc * 2), vst0 = fa::v_st(sr, sc), vst1 = fa::v_st(32 + sr, sc);
        const bf16* Kg = KCB + (size_t)bh * 128 * 128; const bf16* Vg = VCB + (size_t)bh * 128 * 128; const unsigned lo = (unsigned)(sr * 128 + sc);
        for (int tt = 0; tt < nt; ++tt) {
            const bf16x8 k0 = *(const GAS bf16x8*)(Kg + tt * 8192 + lo), k1 = *(const GAS bf16x8*)(Kg + tt * 8192 + 4096 + lo);
            const bf16x8 v0 = *(const GAS bf16x8*)(Vg + tt * 8192 + lo), v1 = *(const GAS bf16x8*)(Vg + tt * 8192 + 4096 + lo);
            *(LAS bf16x8*)(K_lds + tt * fa::BUFS + kws) = k0; *(LAS bf16x8*)(K_lds + tt * fa::BUFS + kws + 32 * 256) = k1;
            *(LAS bf16x8*)(V_lds + tt * fa::BUFS + vst0) = v0; *(LAS bf16x8*)(V_lds + tt * fa::BUFS + vst1) = v1; } }
    bf16x8 qr[8];
    { const bf16* qb_ = P + (size_t)m0 * LDP + C_QA + h * 128; const unsigned lq = (unsigned)(r32 * LDP + hi * 8);
#pragma unroll
      for (int d0 = 0; d0 < 8; ++d0) qr[d0] = *(const GAS bf16x8*)(qb_ + lq + d0 * 16); }
    __syncthreads();
    const float NEG = -__builtin_inff();
    fa::f32x16 p0, p1, p2, p3;
    fa::qkt<0>(p0, p1, K_lds, r32, hi, qr);
    const int cmax = (t - 31) >> 4;
    fa::mask_tile(p0, p1, cmax - 4 * hi, 0x40000000u);
    if (nt == 2) { fa::qkt<1>(p2, p3, K_lds, r32, hi, qr); fa::mask_tile(p2, p3, cmax - 4 * hi - 64, 0x40000000u); }
    else {
#pragma unroll
        for (int r = 0; r < 16; ++r) { p2[r] = NEG; p3[r] = NEG; } }
    float mx = p0[0];
#pragma unroll
    for (int r = 0; r < 16; ++r) mx = fmaxf(fmaxf(mx, p0[r]), fmaxf(p1[r], fmaxf(p2[r], p3[r])));
    { auto rr = __builtin_amdgcn_permlane32_swap(__float_as_uint(mx), __float_as_uint(mx), false, false); mx = fmaxf(__uint_as_float(rr[0]), __uint_as_float(rr[1])); }
    const float mL = (mx == NEG) ? 0.f : -mx * fa::C2;
    float l = 0.f;
#pragma unroll
    for (int r = 0; r < 16; ++r) { p0[r] = __builtin_amdgcn_exp2f(fmaf(p0[r], fa::C2, mL)); p1[r] = __builtin_amdgcn_exp2f(fmaf(p1[r], fa::C2, mL));
        p2[r] = __builtin_amdgcn_exp2f(fmaf(p2[r], fa::C2, mL)); p3[r] = __builtin_amdgcn_exp2f(fmaf(p3[r], fa::C2, mL)); l += (p0[r] + p1[r]) + (p2[r] + p3[r]); }
    { auto rr = __builtin_amdgcn_permlane32_swap(__float_as_uint(l), __float_as_uint(l), false, false); l = __uint_as_float(rr[0]) + __uint_as_float(rr[1]); }
    const float inv = l > 0.f ? 1.0f / l : 0.f;
    {   fa::f32x16 o[4];
#pragma unroll
        for (int d = 0; d < 4; ++d)
#pragma unroll
            for (int r = 0; r < 16; ++r) o[d][r] = 0.f;
        const int vb0 = (int)(unsigned)(uintptr_t)lds + fa::v_rd_base(lane);
        bf16x8 pa0, pa1, pa2, pa3;
        fa::pack_p(p0, p1, pa0, pa1, pa2, pa3); FA_SBAR(); fa::pv_tile<0>(o, vb0, pa0, pa1, pa2, pa3);
        if (nt == 2) { fa::pack_p(p2, p3, pa0, pa1, pa2, pa3); FA_SBAR(); fa::pv_tile<1>(o, vb0, pa0, pa1, pa2, pa3); }
        float own[16], last[16];
#pragma unroll
        for (int k = 0; k < 16; ++k) { const int q = k & 3; const fa::f32x16& px = (k >> 2) == 0 ? p0 : (k >> 2) == 1 ? p1 : (k >> 2) == 2 ? p2 : p3;
            own[k] = ((px[4 * q] + px[4 * q + 1]) + (px[4 * q + 2] + px[4 * q + 3])) * inv; last[k] = px[4 * q + 3] * inv; }
        LAS float* dst = imps + ((g * 64 + tl0 + r32) * 32 + hi);
#pragma unroll
        for (int k = 0; k < 16; ++k) { const float x = __shfl_xor(last[k], 32); const float xp = (k > 0) ? __shfl_xor(last[k > 0 ? k - 1 : 0], 32) : 0.f;
            dst[2 * k] = own[k] + (hi ? x : xp); }
        const float g0 = sigm(bf2f((P + (size_t)m0 * LDP + C_GA + h * 3)[(unsigned)(r32 * LDP)]) + a.b_gate[h * 3]);
        float rli[16]; fa::row_factors(inv * g0, rli, lds, c.wave, r32, hi);
        __syncthreads();
        LAS float* st = (LAS float*)lds + c.wave * 2048;
#define CMP_HALF(HF) do { f32x4 lo[4], hh[4]; fa::stage_half<HF>(o, rli, st, r32, hi, lane, lo, hh); \
        _Pragma("unroll") for (int q = 0; q < 4; ++q) { const int idx = q * 64 + lane; bf16* ob = OC + (size_t)(m0 + (idx >> 3)) * 2048 + h * 128 + HF * 64 + 8 * (idx & 7); \
            { v4u w_; w_.x = fa::cvtpk(lo[q][0], lo[q][1]); w_.y = fa::cvtpk(lo[q][2], lo[q][3]); w_.z = fa::cvtpk(hh[q][0], hh[q][1]); w_.w = fa::cvtpk(hh[q][2], hh[q][3]); *(GAS v4u*)ob = w_; } } } while (0)
        CMP_HALF(0); CMP_HALF(1);
#undef CMP_HALF
    }
#pragma unroll 1
    for (int tt = 0; tt < 4; ++tt) {
        const int tl = c.wave * 8 + tt * 2 + hi, j = r32, tq = 64 * tb + tl, cur = tq >> 6;
        float imp = (imps[(0 * 64 + tl) * 32 + j] + imps[(1 * 64 + tl) * 32 + j]) + (imps[(2 * 64 + tl) * 32 + j] + imps[(3 * 64 + tl) * 32 + j]);
        const bool forced = (j == 0) || (j == cur) || (j == cur - 1);
        float v = forced ? imp + 1e4f : imp;
        if (j > cur) v = NEG;
        int rank = 0;
        for (int jj = 0; jj < 32; ++jj) { const float vo = __shfl(v, (lane & 32) + jj); rank += (vo > v || (vo == v && jj < j)) ? 1 : 0; }
        const bool sel = (rank < TOPN) && (j <= cur);
        const unsigned long long bal = __ballot(sel);
        if (r32 == 0) selt[tl] = (unsigned)(bal >> (32 * hi));
    }
    __syncthreads();
}
__device__ __forceinline__ void nsa_item(const Args& a, const Ctx& c, int b, int hk, int tb) {
    cmp_item(a, c, b, hk, tb);
    const LAS unsigned* selt = (const LAS unsigned*)((LAS char*)(c.lds + RING_OFF) + fa::A_WS + 2048);
    nsa_passes(a, c, b, hk * 4 + (c.wave >> 1), 64 * tb + 32 * (c.wave & 1), tb + 1, tb - 8 > 0 ? tb - 8 : 0, tb + 1, selt);
}
__device__ __forceinline__ void p4_nsa_mfma(const Args& a, const Ctx& c) {
    for (int it = c.bid; it < 256; it += c.G) {
        const int x = it & 7, y = it >> 3, grp = 2 * x + (y >> 4), pr = y & 15;
#pragma unroll 1
        for (int k = 0; k < 2; ++k) nsa_item(a, c, grp >> 2, grp & 3, k ? 31 - pr : pr);
    }
}

__device__ __forceinline__ void p6_final(const Args& a, const Ctx& c) {
    const bf16* Y = (const bf16*)(a.ws + WS_Y);
    for (int m = c.gw; m < M; m += c.NGW) {
        const GAS v4u* yr = (const GAS v4u*)(Y + (size_t)m * DM) + c.lane;
        v4u yv[8]; float s = 0.f;
#pragma unroll
        for (int j = 0; j < 8; ++j) yv[j] = yr[64 * j];
        const GAS f32x4* xr = (const GAS f32x4*)(a.x + (size_t)m * DM) + 2 * c.lane;
        GAS f32x4* orow = (GAS f32x4*)(a.out + (size_t)m * DM) + 2 * c.lane;
#pragma unroll
        for (int j = 0; j < 8; ++j) { const float y0 = fa::bflo(yv[j].x), y1 = fa::bfhi(yv[j].x), y2 = fa::bflo(yv[j].y), y3 = fa::bfhi(yv[j].y),
                                                  y4 = fa::bflo(yv[j].z), y5 = fa::bfhi(yv[j].z), y6 = fa::bflo(yv[j].w), y7 = fa::bfhi(yv[j].w);
            s += ((y0 * y0 + y1 * y1) + (y2 * y2 + y3 * y3)) + ((y4 * y4 + y5 * y5) + (y6 * y6 + y7 * y7)); }
        const float rstd = 1.0f / sqrtf(wave_sum(s) * (1.0f / DM) + EPS);
#pragma unroll
        for (int j = 0; j < 8; ++j) {
            const f32x4 w0 = ((const GAS f32x4*)a.post_w)[2 * c.lane + 128 * j], w1 = ((const GAS f32x4*)a.post_w)[2 * c.lane + 128 * j + 1];
            const f32x4 x0 = xr[128 * j], x1 = xr[128 * j + 1];
            const f32x4 ya = {fa::bflo(yv[j].x), fa::bfhi(yv[j].x), fa::bflo(yv[j].y), fa::bfhi(yv[j].y)}, yb = {fa::bflo(yv[j].z), fa::bfhi(yv[j].z), fa::bflo(yv[j].w), fa::bfhi(yv[j].w)};
            orow[128 * j] = x0 + ya * rstd * w0; orow[128 * j + 1] = x1 + yb * rstd * w1; }
    }
}


#ifndef MK_SPLIT
#define MK_SPLIT 0
#endif
constexpr int NPHASE = 7;

__global__ void __launch_bounds__(NWAVES * 64, 2) fwd_kernel(Args args) {
    extern __shared__ __attribute__((aligned(16))) unsigned char lds_raw[];
    Ctx c;
    c.lds = (LAS unsigned char*)lds_raw;
    c.tid = threadIdx.x; c.lane = c.tid & 63; c.wave = __builtin_amdgcn_readfirstlane(c.tid >> 6);
    c.G = gridDim.x; c.bid = blockIdx.x; c.gw = c.bid * NWAVES + c.wave; c.NGW = c.G * NWAVES;
    unsigned char* ws = args.ws;
    gu32* ctl = (gu32*)(ws + WS_CTL);
    volatile LAS unsigned* MISC = (volatile LAS unsigned*)(c.lds + MISC_OFF);
    for (int u = c.tid; u < (LDS_BYTES - LDSCTL_OFF) / 4; u += NWAVES * 64) ((LAS unsigned*)(c.lds + LDSCTL_OFF))[u] = 0u;
    __syncthreads();
    XcdBarrier bar; bar.bar = (unsigned*)(ctl + CW_BAR); bar.x = 0; bar.st = nullptr;
    if (!MK_SPLIT) bar = xcd_barrier_post((unsigned*)(ctl + CW_BAR), MISC + 8);
    const int lo = args.ph_lo, hi = args.ph_hi;
#define IN(k) (lo <= (k) && (k) < hi)
#define SEAM(k) do { if (IN(k) && IN((k) + 1)) xcd_barrier(bar); } while (0)

    if (IN(0)) { p0_prologue(args, c); } SEAM(0);
    if (IN(1)) {
        pg8::Gemm g{(const pg8::bf16_t*)(ws + WS_HB), (const pg8::bf16_t*)(ws + WS_WIN), M, NP, DM, DM}; pg8::StaticOrder S; S.init(M, NP, c.G, c.bid);
        pg8::EpiP E{(pg8::bf16_t*)(ws + WS_P), NP, (pg8::bf16_t*)(ws + WS_QR), (pg8::bf16_t*)(ws + WS_XKV), (const float*)(ws + WS_COS), (const float*)(ws + WS_SIN)};
        pg8::gemm_phase<pg8::EpiP, pg8::StaticOrder, true, true>(c.lds + RING_OFF, g, S, E);
        {
            const int rem = ((M / 256) * (NP / 256)) % c.G, nt_ = rem ? c.G - rem : c.G, ti = rem ? c.bid - rem : c.bid;
            if (ti >= 0) p0_transposes(args, c, TI_IN, TI_ALL, ti * NWAVES + c.wave, nt_ * NWAVES);
        }
    } SEAM(1);
    if (IN(2)) {
        pg8::Gemm g{(const pg8::bf16_t*)(ws + WS_XKV), (const pg8::bf16_t*)(ws + WS_WLR), 4096, 1024, 256, 2048}; pg8::CmpOrder S{c.bid, c.G};
        pg8::EpiLR E{(float*)(ws + WS_LR), 1024, (size_t)4096 * 1024};
        pg8::gemm_phase<pg8::EpiLR, pg8::CmpOrder, false, true>(c.lds + RING_OFF, g, S, E);
    } SEAM(2);
    if (IN(3)) { p2c_stage2(args, c); p4_dil_mfma(args, c); } SEAM(3);
    if (IN(4)) { p4_nsa_mfma(args, c); } SEAM(4);
    if (IN(5)) {
        pg8::Gemm g{(const pg8::bf16_t*)(ws + WS_MIX), (const pg8::bf16_t*)(ws + WS_WOUT), M, DM, DM, DM}; pg8::StaticOrder S; S.init(M, DM, c.G, c.bid);
        pg8::EpiBf16<0> E{(pg8::bf16_t*)(ws + WS_Y), DM, nullptr, 0, 0, 1.f};
        pg8::gemm_phase<pg8::EpiBf16<0>, pg8::StaticOrder, true, true>(c.lds + RING_OFF, g, S, E);
    } SEAM(5);
    if (IN(6)) { p6_final(args, c); }
#undef IN
#undef SEAM
}

extern "C" void kernel_launch(void* const* d_in, const int* in_sizes, int n_in, void* d_out, int out_size, void* d_ws, size_t ws_size, hipStream_t stream) {
    static int grid = 0;
    if (grid == 0) {
        if (n_in != 13 || out_size != M * DM || ws_size < WS_END) { fprintf(stderr, "kernel_launch: unexpected shapes (n_in %d out %d ws %zu)\n", n_in, out_size, ws_size); grid = -1; return; }
        int dev = 0, cus = 0, per_cu = 0;
        if (hipGetDevice(&dev) != hipSuccess || hipDeviceGetAttribute(&cus, hipDeviceAttributeMultiprocessorCount, dev) != hipSuccess) { grid = -1; return; }
        if (hipFuncSetAttribute((const void*)fwd_kernel, hipFuncAttributeMaxDynamicSharedMemorySize, LDS_BYTES) != hipSuccess) { fprintf(stderr, "kernel_launch: hipFuncSetAttribute failed\n"); grid = -1; return; }
        if (hipOccupancyMaxActiveBlocksPerMultiprocessor(&per_cu, (const void*)fwd_kernel, NWAVES * 64, LDS_BYTES) != hipSuccess || per_cu < 1)
            fprintf(stderr, "kernel_launch: occupancy query reports %d\n", per_cu);
        (void)hipGetLastError();
        grid = cus;
    }
    if (grid < 0) return;
    if (hipMemsetAsync((char*)d_ws + WS_CTL, 0, CTL_ZERO_BYTES, stream) != hipSuccess) return;
    Args a{};
    a.x = (const float*)d_in[0]; a.pos = (const int*)d_in[1]; a.pre_w = (const float*)d_in[2]; a.post_w = (const float*)d_in[3];
    a.w_in = (const float*)d_in[4]; a.b_gate = (const float*)d_in[5]; a.pe_k = (const float*)d_in[6]; a.pe_v = (const float*)d_in[7];
    a.wk1 = (const float*)d_in[8]; a.wk2 = (const float*)d_in[9]; a.wv1 = (const float*)d_in[10]; a.wv2 = (const float*)d_in[11]; a.w_out = (const float*)d_in[12];
    a.out = (float*)d_out; a.ws = (unsigned char*)d_ws;
#if MK_SPLIT
    for (int p = 0; p < NPHASE; ++p) { a.ph_lo = p; a.ph_hi = p + 1; hipLaunchKernelGGL(fwd_kernel, dim3(grid), dim3(NWAVES * 64), LDS_BYTES, stream, a); }
#else
    a.ph_lo = 0; a.ph_hi = NPHASE;
    hipLaunchKernelGGL(fwd_kernel, dim3(grid), dim3(NWAVES * 64), LDS_BYTES, stream, a);
#endif
}
```
